# Optimizing an MI355X kernel written in HIP

```python
import math
import jax, jax.numpy as jnp
from jax import lax
import numpy as np

D_MODEL = 2048
BATCH = 2
SEQ = 16384
DEPTH = 1

MLA_HEADS = 16
MLA_Q_RANK = 512
MLA_KV_RANK = 256
MLA_NOPE_DIM = 128
MLA_ROPE_DIM = 64
MLA_V_DIM = 128
ROPE_THETA = 10000.0
SWA_Q_HEADS = 32
SWA_KV_HEADS = 4
SWA_HEAD_DIM = 64
SWA_GROUP = SWA_Q_HEADS // SWA_KV_HEADS
WINDOW = 128
BLOCK = 128
REL_BUCKETS = 32
REL_MAX_DIST = 128
D_FF = 5632
CONV_WIDTH = 3
N_BRANCHES = 2
EPS = 1e-6

MLA_WIDTH = MLA_HEADS * MLA_V_DIM
SWA_WIDTH = SWA_Q_HEADS * SWA_HEAD_DIM
SWA_KV_WIDTH = SWA_KV_HEADS * SWA_HEAD_DIM
IN_SPLITS = (MLA_Q_RANK, MLA_KV_RANK, MLA_ROPE_DIM, SWA_WIDTH, SWA_KV_WIDTH, SWA_KV_WIDTH, N_BRANCHES * D_MODEL)
IN_COLS = MLA_Q_RANK + MLA_KV_RANK + MLA_ROPE_DIM + SWA_WIDTH + 2 * SWA_KV_WIDTH + N_BRANCHES * D_MODEL

kernel_name = "hybrid_mla_swa_gated_convffn"


def rms_norm(x, g):
    xf = x.astype(jnp.float32)
    y = xf * lax.rsqrt(jnp.mean(xf * xf, axis=-1, keepdims=True) + EPS)
    return (y * g.astype(jnp.float32)).astype(x.dtype)


def rope_angles(pos, dim):
    inv = ROPE_THETA ** (-jnp.arange(0, dim, 2, dtype=jnp.float32) / dim)
    ang = pos.astype(jnp.float32)[:, None] * inv[None, :]
    return jnp.cos(ang), jnp.sin(ang)


def apply_rope(x, cos, sin):
    half = x.shape[-1] // 2
    x1, x2 = x[..., :half], x[..., half:]
    cos = cos.astype(x.dtype)
    sin = sin.astype(x.dtype)
    return jnp.concatenate([x1 * cos - x2 * sin, x2 * cos + x1 * sin], axis=-1)


def t5_bucket(dist):
    n = jnp.maximum(dist, 0)
    max_exact = REL_BUCKETS // 2
    large = max_exact + (jnp.log(jnp.maximum(n, 1).astype(jnp.float32) / max_exact)
                         / math.log(REL_MAX_DIST / max_exact)
                         * (REL_BUCKETS - max_exact)).astype(jnp.int32)
    large = jnp.minimum(large, REL_BUCKETS - 1)
    return jnp.where(n < max_exact, n, large)


def mla_attention(q_nope, q_rope, k_nope, k_rope, v):
    B, S, H, _ = q_nope.shape
    nb = S // BLOCK
    scale = (MLA_NOPE_DIM + MLA_ROPE_DIM) ** -0.5
    qn = q_nope.reshape(B, nb, BLOCK, H, MLA_NOPE_DIM).transpose(1, 0, 2, 3, 4)
    qr = q_rope.reshape(B, nb, BLOCK, H, MLA_ROPE_DIM).transpose(1, 0, 2, 3, 4)
    k_pos = jnp.arange(S)

    def one_block(args):
        qn_b, qr_b, i = args
        s = (jnp.einsum('bqhd,bkhd->bhqk', qn_b, k_nope)
             + jnp.einsum('bqhr,bkr->bhqk', qr_b, k_rope)).astype(jnp.float32) * scale
        q_pos = i * BLOCK + jnp.arange(BLOCK)
        causal = k_pos[None, :] <= q_pos[:, None]
        s = jnp.where(causal, s, -jnp.inf)
        p = jax.nn.softmax(s, axis=-1).astype(v.dtype)
        return jnp.einsum('bhqk,bkhd->bqhd', p, v)

    out = lax.map(one_block, (qn, qr, jnp.arange(nb)))
    return out.transpose(1, 0, 2, 3, 4).reshape(B, S, H * MLA_V_DIM)


def swa_attention(q, k, v, sinks, rel_table):
    B, S, _ = q.shape
    nb = S // BLOCK
    q = q.reshape(B, nb, BLOCK, SWA_KV_HEADS, SWA_GROUP, SWA_HEAD_DIM)
    k = k.reshape(B, nb, BLOCK, SWA_KV_HEADS, SWA_HEAD_DIM)
    v = v.reshape(B, nb, BLOCK, SWA_KV_HEADS, SWA_HEAD_DIM)

    def band(t):
        prev = jnp.pad(t[:, :-1], ((0, 0), (1, 0), (0, 0), (0, 0), (0, 0)))
        return jnp.concatenate([prev, t], axis=2)

    kb, vb = band(k), band(v)
    s = jnp.einsum('bnqhgd,bnkhd->bhgnqk', q, kb).astype(jnp.float32) * SWA_HEAD_DIM ** -0.5
    qi = jnp.arange(BLOCK)[:, None]
    kj = jnp.arange(2 * BLOCK)[None, :]
    dist = qi + BLOCK - kj
    in_window = (dist >= 0) & (dist < WINDOW)
    has_prev = (jnp.arange(nb)[:, None, None] > 0) | (kj >= BLOCK)[None]
    mask = in_window[None] & has_prev
    bias = rel_table.astype(jnp.float32)[t5_bucket(dist)]
    bias = bias.transpose(2, 0, 1).reshape(SWA_KV_HEADS, SWA_GROUP, 1, BLOCK, 2 * BLOCK)
    s = jnp.where(mask[None, None, None], s + bias[None], -jnp.inf)
    sink = sinks.astype(jnp.float32).reshape(SWA_KV_HEADS, SWA_GROUP)[None, :, :, None, None]
    m = jnp.maximum(jnp.max(s, axis=-1), sink)
    p = jnp.exp(s - m[..., None])
    denom = jnp.sum(p, axis=-1) + jnp.exp(sink - m)
    p = (p / denom[..., None]).astype(vb.dtype)
    out = jnp.einsum('bhgnqk,bnkhd->bnqhgd', p, vb)
    return out.reshape(B, S, SWA_WIDTH)


def hybrid_mixer(h, w_in, mla_q_norm, mla_w_q_up, mla_kv_norm, mla_w_kv_up,
                 swa_sinks, rel_table, w_o_mla, w_o_swa, w_out):
    B, S, _ = h.shape
    offsets = [int(o) for o in np.cumsum(IN_SPLITS)[:-1]]
    c_q, c_kv, k_r, q_s, k_s, v_s, gates = jnp.split(h @ w_in, offsets, axis=-1)
    pos = jnp.arange(S)
    q = (rms_norm(c_q, mla_q_norm) @ mla_w_q_up).reshape(B, S, MLA_HEADS, MLA_NOPE_DIM + MLA_ROPE_DIM)
    kv = (rms_norm(c_kv, mla_kv_norm) @ mla_w_kv_up).reshape(B, S, MLA_HEADS, MLA_NOPE_DIM + MLA_V_DIM)
    cos, sin = rope_angles(pos, MLA_ROPE_DIM)
    q_rope = apply_rope(q[..., MLA_NOPE_DIM:], cos[:, None, :], sin[:, None, :])
    k_rope = apply_rope(k_r, cos, sin)
    o_a = mla_attention(q[..., :MLA_NOPE_DIM], q_rope, kv[..., :MLA_NOPE_DIM], k_rope, kv[..., MLA_NOPE_DIM:])
    o_b = swa_attention(q_s, k_s, v_s, swa_sinks, rel_table)
    g = jax.nn.sigmoid(gates.astype(jnp.float32)).reshape(B, S, N_BRANCHES, D_MODEL)
    merged = g[:, :, 0] * (o_a @ w_o_mla).astype(jnp.float32) + g[:, :, 1] * (o_b @ w_o_swa).astype(jnp.float32)
    return merged.astype(h.dtype) @ w_out


def conv_ffn(h, w_up, conv_w, conv_b, w_down):
    S = h.shape[1]
    a, b = jnp.split(h @ w_up, 2, axis=-1)
    ap = jnp.pad(a, ((0, 0), (CONV_WIDTH - 1, 0), (0, 0)))
    c = conv_b
    for j in range(CONV_WIDTH):
        c = c + conv_w[j] * ap[:, j:j + S]
    return (jax.nn.gelu(c, approximate=True) * b) @ w_down


def setup_inputs(seed: int = 0) -> dict:
    key = jax.random.key(seed)
    ks = jax.random.split(key, 24)
    L = DEPTH
    f32 = jnp.float32

    def w(k, shape, fan_in):
        return jax.random.normal(k, shape, f32) * fan_in ** -0.5

    def gain(k, shape):
        return 1.0 + 0.05 * jax.random.normal(k, shape, f32)

    return {
        "x": jax.random.normal(ks[0], (BATCH, SEQ, D_MODEL), f32),
        "norm_mix_pre": gain(ks[1], (L, D_MODEL)),
        "norm_mix_post": gain(ks[2], (L, D_MODEL)),
        "norm_ffn_pre": gain(ks[3], (L, D_MODEL)),
        "norm_ffn_post": gain(ks[4], (L, D_MODEL)),
        "w_in": w(ks[5], (L, D_MODEL, IN_COLS), D_MODEL),
        "mla_q_norm": gain(ks[6], (L, MLA_Q_RANK)),
        "mla_w_q_up": w(ks[7], (L, MLA_Q_RANK, MLA_HEADS * (MLA_NOPE_DIM + MLA_ROPE_DIM)), MLA_Q_RANK),
        "mla_kv_norm": gain(ks[8], (L, MLA_KV_RANK)),
        "mla_w_kv_up": w(ks[9], (L, MLA_KV_RANK, MLA_HEADS * (MLA_NOPE_DIM + MLA_V_DIM)), MLA_KV_RANK),
        "swa_sinks": jax.random.normal(ks[10], (L, SWA_Q_HEADS), f32),
        "rel_bias_table": 0.5 * jax.random.normal(ks[11], (REL_BUCKETS, SWA_Q_HEADS), f32),
        "w_o_mla": w(ks[12], (L, MLA_WIDTH, D_MODEL), MLA_WIDTH),
        "w_o_swa": w(ks[13], (L, SWA_WIDTH, D_MODEL), SWA_WIDTH),
        "w_out": w(ks[14], (L, D_MODEL, D_MODEL), D_MODEL),
        "ffn_w_up": w(ks[15], (L, D_MODEL, 2 * D_FF), D_MODEL),
        "ffn_conv_w": w(ks[16], (L, CONV_WIDTH, D_FF), CONV_WIDTH),
        "ffn_conv_b": 0.01 * jax.random.normal(ks[17], (L, D_FF), f32),
        "ffn_w_down": w(ks[18], (L, D_FF, D_MODEL), D_FF),
    }


def reference(x, norm_mix_pre, norm_mix_post, norm_ffn_pre, norm_ffn_post, w_in,
              mla_q_norm, mla_w_q_up, mla_kv_norm, mla_w_kv_up, swa_sinks, rel_bias_table,
              w_o_mla, w_o_swa, w_out, ffn_w_up, ffn_conv_w, ffn_conv_b, ffn_w_down):
    for l in range(DEPTH):
        h = rms_norm(x, norm_mix_pre[l])
        y = hybrid_mixer(h, w_in[l], mla_q_norm[l], mla_w_q_up[l], mla_kv_norm[l], mla_w_kv_up[l],
                         swa_sinks[l], rel_bias_table, w_o_mla[l], w_o_swa[l], w_out[l])
        x = x + rms_norm(y, norm_mix_post[l])
        h = rms_norm(x, norm_ffn_pre[l])
        y = conv_ffn(h, ffn_w_up[l], ffn_conv_w[l], ffn_conv_b[l], ffn_w_down[l])
        x = x + rms_norm(y, norm_ffn_post[l])
    return x
```

```cpp
#include <hip/hip_runtime.h>
#include <hip/hip_cooperative_groups.h>
#include <cstdio>
#include <cstdint>
namespace cg = cooperative_groups;
namespace pg8 {
#define PG8_LAS __attribute__((address_space(3)))
typedef unsigned short bf16_t;
typedef short bf16x8 __attribute__((ext_vector_type(8)));
typedef float f32x4 __attribute__((ext_vector_type(4)));
typedef unsigned u32x4 __attribute__((ext_vector_type(4)));
constexpr int BM = 256, BK = 64, HALF = 128, HTB = HALF * BK * 2  , STAGE_BYTES = 8 * HTB, NXCD = 8, WGM = 8;

__host__ __device__ __forceinline__ int lds_byte(int r, int c) { const int st = (r >> 4) * 2 + (c >> 5), rr = r & 15, cc = c & 31, ob = rr * 64 + cc * 2; return st * 1024 + (ob ^ (((ob >> 9) & 1) << 5)); }
__host__ __device__ __forceinline__ void stage_rc(int b, int& R, int& C) { const int st = b / 1024, sb = b % 1024, swz = sb ^ (((sb >> 9) & 1) << 5); R = (st >> 1) * 16 + swz / 64; C = (st & 1) * 32 + (swz % 64) / 2; }
__host__ __device__ __forceinline__ int perm32(int rho) { const int n = rho >> 4, i = rho & 15; return 8 * (i >> 2) + 4 * n + (i & 3); }

struct Unit { int pm, pn; };
struct Gemm { const bf16_t* A; const bf16_t* Bt; int M, N, K; };

struct StaticOrder {
    int nM, nN, nwg, G, c;
    __host__ __device__ void init(int M, int N, int G_, int c_) { nM = M / BM; nN = N / BM; nwg = nM * nN; G = G_; c = c_; }
    __host__ __device__ bool next(int i, Unit& u) const {
        const long L = (long)i * G + c; if (L >= nwg) return false;
        int wgid = (int)L; { const int q = nwg / NXCD, r = nwg % NXCD, xcd = wgid % NXCD, off = wgid / NXCD; wgid = (xcd < r ? xcd * (q + 1) : r * (q + 1) + (xcd - r) * q) + off; }
        const int nig = WGM * nN, gid = wgid / nig, fm = gid * WGM, gsz = (nM - fm) < WGM ? (nM - fm) : WGM;
        u.pm = fm + ((wgid % nig) % gsz); u.pn = (wgid % nig) / gsz; return true;
    }
    __device__ __forceinline__ void a_ready(const Unit&) const {}
    __device__ __forceinline__ void done(const Unit&) const {}
};

typedef float f32x2_cv __attribute__((ext_vector_type(2))); typedef __bf16 bf16x2_cv __attribute__((ext_vector_type(2)));
__device__ __forceinline__ unsigned cvt_pk_bf16(float lo, float hi) { f32x2_cv v = {lo, hi}; bf16x2_cv b = __builtin_convertvector(v, bf16x2_cv); return __builtin_bit_cast(unsigned, b); }
template <class Epi, class Sched, bool ALIGN_EPI = false, bool SP2 = false>
__device__ __forceinline__ void gemm_phase(PG8_LAS unsigned char* lds, const Gemm g, const Sched& S, const Epi& E) {
    const int tid = threadIdx.x, wid = __builtin_amdgcn_readfirstlane(tid >> 6), lane = tid & 63, wr = wid >> 2, wc = wid & 3, fr = lane & 15, fq = lane >> 4;
    const int K = g.K, nt = K / BK;
    unsigned voffA[2], voffB[2];
#pragma unroll
    for (int i = 0; i < 2; ++i) { int R, C; stage_rc(tid * 16 + i * 8192, R, C); const int Rb = Epi::PERM ? ((R & ~31) + perm32(R & 31)) : R;
        voffA[i] = (unsigned)(R * K + C) * 2u; voffB[i] = (unsigned)(Rb * K + C) * 2u; }
    const size_t kstep = (size_t)(BK * 2);
    const size_t hstep = (size_t)HALF * K * 2;
    const size_t tstep = 2 * hstep;
    const unsigned ldsw = (unsigned)wid * 1024u;
    const int aoff = lds_byte(wr * 64 + fr, fq * 8), boff = lds_byte(wc * 32 + fr, fq * 8);
#define PG8_SA(b, h) (((b) * 2 + (h)) * HTB)
#define PG8_SB(b, h) ((4 + (b) * 2 + (h)) * HTB)
#define PG8_STAGE(bufoff, gbase, voff) do { _Pragma("unroll") for (int _i = 0; _i < 2; ++_i) \
        __builtin_amdgcn_global_load_lds((const unsigned*)((const char*)(gbase) + (voff)[_i]), (PG8_LAS unsigned*)(lds + (bufoff) + ldsw + _i * 8192), 16, 0, 0); } while (0)
#define PG8_LDA(dst, b, h) do { _Pragma("unroll") for (int m = 0; m < 4; ++m) _Pragma("unroll") for (int k = 0; k < 2; ++k) dst[m][k] = *(const PG8_LAS bf16x8*)(lds + PG8_SA(b, h) + aoff + m * 2048 + k * 1024); } while (0)
#define PG8_LDB(dst, b, h) do { _Pragma("unroll") for (int n = 0; n < 2; ++n) _Pragma("unroll") for (int k = 0; k < 2; ++k) dst[n][k] = *(const PG8_LAS bf16x8*)(lds + PG8_SB(b, h) + boff + n * 2048 + k * 1024); } while (0)
#define PG8_MMA(ai, bj, At, Bt) do { __builtin_amdgcn_s_setprio(1); _Pragma("unroll") for (int m = 0; m < 4; ++m) _Pragma("unroll") for (int n = 0; n < 2; ++n) _Pragma("unroll") for (int k = 0; k < 2; ++k) \
        acc[ai][bj][m][n] = __builtin_amdgcn_mfma_f32_16x16x32_bf16(Bt[n][k], At[m][k], acc[ai][bj][m][n], 0, 0, 0); __builtin_amdgcn_s_setprio(0); } while (0)
#define PG8_WAIT_V(n) asm volatile("s_waitcnt vmcnt(" #n ")" ::: "memory")
#define PG8_WAIT_L(n) asm volatile("s_waitcnt lgkmcnt(" #n ")" ::: "memory")
#define PG8_BAR __builtin_amdgcn_s_barrier()
#define PG8_SCHED __builtin_amdgcn_sched_barrier(0)
    Unit cur, nxt; int ui = 0;
    if (!S.next(0, cur)) return;
    f32x4 acc[2][2][4][2];
#pragma unroll
    for (int a = 0; a < 2; ++a)
#pragma unroll
        for (int b = 0; b < 2; ++b)
#pragma unroll
            for (int m = 0; m < 4; ++m)
#pragma unroll
                for (int n = 0; n < 2; ++n) acc[a][b][m][n] = (f32x4){0.f, 0.f, 0.f, 0.f};
    bf16x8 At[4][2], B0[2][2], B1[2][2];
    const char* cA = (const char*)g.A + (size_t)cur.pm * tstep; const char* cB = (const char*)g.Bt + (size_t)cur.pn * tstep;
    S.a_ready(cur);
    if constexpr (SP2) {
        PG8_STAGE(PG8_SB(0, 0), cB, voffB); PG8_STAGE(PG8_SB(0, 1), cB + hstep, voffB); PG8_STAGE(PG8_SA(0, 0), cA, voffA); PG8_STAGE(PG8_SA(0, 1), cA + hstep, voffA);
        PG8_STAGE(PG8_SB(1, 0), cB + kstep, voffB); PG8_STAGE(PG8_SA(1, 0), cA + kstep, voffA); PG8_STAGE(PG8_SB(1, 1), cB + hstep + kstep, voffB);
        PG8_WAIT_V(0); PG8_WAIT_L(0); PG8_BAR;
        if (wr == 1) PG8_BAR;
    } else {
        PG8_STAGE(PG8_SB(0, 0), cB, voffB); PG8_STAGE(PG8_SA(0, 0), cA, voffA); PG8_STAGE(PG8_SB(0, 1), cB + hstep, voffB); PG8_STAGE(PG8_SA(0, 1), cA + hstep, voffA);
        if (wr == 1) PG8_BAR;
        PG8_WAIT_V(4); PG8_BAR;
        PG8_STAGE(PG8_SB(1, 0), cB + kstep, voffB); PG8_STAGE(PG8_SA(1, 0), cA + kstep, voffA); PG8_STAGE(PG8_SB(1, 1), cB + hstep + kstep, voffB);
        PG8_WAIT_V(6); PG8_BAR;
    }
    for (;;) {
        const bool has_next = S.next(ui + 1, nxt);
        const char* nA = has_next ? (const char*)g.A + (size_t)nxt.pm * tstep : cA; const char* nB = has_next ? (const char*)g.Bt + (size_t)nxt.pn * tstep : cB;
        for (int t = 0; t < nt; t += 2) {
            const bool last = (t == nt - 2);
            const char* a1 = cA + (size_t)(t + 1) * kstep;
            const char* a2 = last ? nA : cA + (size_t)(t + 2) * kstep; const char* b2 = last ? nB : cB + (size_t)(t + 2) * kstep;
            const char* a3 = a2 + kstep; const char* b3 = b2 + kstep;
            if (last && has_next) S.a_ready(nxt);
            if constexpr (SP2) {
            PG8_LDB(B0, 0, 0); PG8_LDB(B1, 0, 1); PG8_SCHED; PG8_LDA(At, 0, 0); PG8_STAGE(PG8_SA(1, 1), a1 + hstep, voffA);
            PG8_WAIT_V(8); PG8_WAIT_L(0); PG8_BAR; PG8_MMA(0, 0, At, B0); PG8_MMA(0, 1, At, B1); PG8_BAR; PG8_SCHED;
            PG8_LDA(At, 0, 1); PG8_STAGE(PG8_SB(0, 0), b2, voffB); PG8_STAGE(PG8_SB(0, 1), b2 + hstep, voffB); PG8_STAGE(PG8_SA(0, 0), a2, voffA);
            PG8_WAIT_V(8); PG8_WAIT_L(0); PG8_BAR; PG8_MMA(1, 0, At, B0); PG8_MMA(1, 1, At, B1); PG8_BAR; PG8_SCHED;
            PG8_LDB(B0, 1, 0); PG8_LDB(B1, 1, 1); PG8_SCHED; PG8_LDA(At, 1, 0); PG8_STAGE(PG8_SA(0, 1), a2 + hstep, voffA);
            PG8_WAIT_V(8); PG8_WAIT_L(0); PG8_BAR; PG8_MMA(0, 0, At, B0); PG8_MMA(0, 1, At, B1); PG8_BAR; PG8_SCHED;
            PG8_LDA(At, 1, 1); PG8_STAGE(PG8_SB(1, 0), b3, voffB); PG8_STAGE(PG8_SB(1, 1), b3 + hstep, voffB); PG8_STAGE(PG8_SA(1, 0), a3, voffA);
            PG8_WAIT_V(8); PG8_WAIT_L(0); PG8_BAR; PG8_MMA(1, 0, At, B0); PG8_MMA(1, 1, At, B1); PG8_BAR; PG8_SCHED;
            } else {
            PG8_LDB(B0, 0, 0); PG8_SCHED; PG8_LDA(At, 0, 0); PG8_STAGE(PG8_SA(1, 1), a1 + hstep, voffA);
            PG8_WAIT_L(8); PG8_BAR; PG8_WAIT_L(0); PG8_MMA(0, 0, At, B0); PG8_BAR; PG8_SCHED;
            PG8_LDB(B1, 0, 1); PG8_STAGE(PG8_SB(0, 0), b2, voffB);
            PG8_BAR; PG8_WAIT_L(0); PG8_MMA(0, 1, At, B1); PG8_BAR;
            PG8_LDA(At, 0, 1); PG8_STAGE(PG8_SA(0, 0), a2, voffA);
            PG8_BAR; PG8_WAIT_L(0); PG8_MMA(1, 0, At, B0); PG8_BAR; PG8_SCHED;
            PG8_STAGE(PG8_SB(0, 1), b2 + hstep, voffB);
            PG8_WAIT_V(6); PG8_BAR; PG8_MMA(1, 1, At, B1); PG8_BAR;
            PG8_LDB(B0, 1, 0); PG8_SCHED; PG8_LDA(At, 1, 0); PG8_STAGE(PG8_SA(0, 1), a2 + hstep, voffA);
            PG8_WAIT_L(8); PG8_BAR; PG8_WAIT_L(0); PG8_MMA(0, 0, At, B0); PG8_BAR; PG8_SCHED;
            PG8_LDB(B1, 1, 1); PG8_STAGE(PG8_SB(1, 0), b3, voffB);
            PG8_BAR; PG8_WAIT_L(0); PG8_MMA(0, 1, At, B1); PG8_BAR;
            PG8_LDA(At, 1, 1); PG8_STAGE(PG8_SA(1, 0), a3, voffA);
            PG8_BAR; PG8_WAIT_L(0); PG8_MMA(1, 0, At, B0); PG8_BAR; PG8_SCHED;
            PG8_STAGE(PG8_SB(1, 1), b3 + hstep, voffB);
            PG8_WAIT_V(6); PG8_BAR; PG8_MMA(1, 1, At, B1); PG8_BAR;
            }
        }
        if constexpr (ALIGN_EPI) { if (wr == 0) PG8_BAR; }
        if constexpr (!Epi::AFTER_DRAIN) { E(acc, cur, wr, wc, fr, fq); S.done(cur); }
        if (!has_next) break;
#pragma unroll
        for (int a = 0; a < 2; ++a)
#pragma unroll
            for (int b = 0; b < 2; ++b)
#pragma unroll
                for (int m = 0; m < 4; ++m)
#pragma unroll
                    for (int n = 0; n < 2; ++n) acc[a][b][m][n] = (f32x4){0.f, 0.f, 0.f, 0.f};
        cur = nxt; cA = nA; cB = nB; ++ui;
        if constexpr (ALIGN_EPI) { if (wr == 1) PG8_BAR; }
    }
    PG8_WAIT_V(0);
    if constexpr (!ALIGN_EPI) { if (wr == 0) PG8_BAR; }
    PG8_BAR;
    if constexpr (Epi::AFTER_DRAIN) { E.fused(acc, cur, wr, wc, fr, fq, lds, wid, lane); S.done(cur); }
#undef PG8_SA
#undef PG8_SB
#undef PG8_STAGE
#undef PG8_LDA
#undef PG8_LDB
#undef PG8_MMA
#undef PG8_WAIT_V
#undef PG8_WAIT_L
#undef PG8_BAR
#undef PG8_SCHED
}
}
constexpr int SEQ = 16384, NTOK = 32768, DM = 2048, DFF = 5632;
constexpr float EPS = 1e-6f;
#define GAS __attribute__((address_space(1)))
#define LAS __attribute__((address_space(3)))

namespace ep {
using namespace pg8;
typedef float f32x2 __attribute__((ext_vector_type(2)));
__device__ __forceinline__ u32x4 pack8(const f32x4 a, const f32x4 b) { u32x4 w; w.x = cvt_pk_bf16(a[0], a[1]); w.y = cvt_pk_bf16(a[2], a[3]); w.z = cvt_pk_bf16(b[0], b[1]); w.w = cvt_pk_bf16(b[2], b[3]); return w; }
__device__ __forceinline__ float bflo(unsigned u) { return __uint_as_float(u << 16); }
__device__ __forceinline__ float bfhi(unsigned u) { return __uint_as_float(u & 0xffff0000u); }
__device__ __forceinline__ void unpack8(const u32x4 w, f32x4& a, f32x4& b) { a = (f32x4){bflo(w.x), bfhi(w.x), bflo(w.y), bfhi(w.y)}; b = (f32x4){bflo(w.z), bfhi(w.z), bflo(w.w), bfhi(w.w)}; }
__device__ __forceinline__ float sigmoidf_(float x) { return __builtin_amdgcn_rcpf(1.f + __builtin_amdgcn_exp2f(-1.4426950408889634f * x)); }
__device__ __forceinline__ float ssq4(const f32x4 x) { return (x[0] * x[0] + x[1] * x[1]) + (x[2] * x[2] + x[3] * x[3]); }
__device__ __forceinline__ void rope8(f32x4& v0, f32x4& v1, const f32x4 csA, const f32x4 csB) {
    const float a0 = v0[0] * csA[0] - v0[1] * csA[1], b0 = v0[1] * csA[0] + v0[0] * csA[1];
    const float a1 = v0[2] * csA[2] - v0[3] * csA[3], b1 = v0[3] * csA[2] + v0[2] * csA[3];
    const float a2 = v1[0] * csB[0] - v1[1] * csB[1], b2 = v1[1] * csB[0] + v1[0] * csB[1];
    const float a3 = v1[2] * csB[2] - v1[3] * csB[3], b3 = v1[3] * csB[2] + v1[2] * csB[3];
    v0 = (f32x4){a0, b0, a1, b1}; v1 = (f32x4){a2, b2, a3, b3};
}

struct EpiIn {
    static constexpr bool PERM = true, AFTER_DRAIN = false;
    bf16_t *CQ, *CKV, *KR, *QS, *KS, *VS; float *ssqQ, *ssqKV; const float* rope;
    __device__ __forceinline__ void operator()(const f32x4 (&acc)[2][2][4][2], const Unit& u, int wr, int wc, int fr, int fq) const {
        const int pn = u.pn, row0 = u.pm * BM + wr * 64 + fr, cw = wc * 32 + 8 * fq;
        if (pn < 3) {
            float* sq = pn < 2 ? ssqQ : ssqKV; const int nslot = pn < 2 ? 8 : 4, slot = (pn < 2 ? pn * 4 : 0) + wc, ldc = pn < 2 ? 512 : 256;
            bf16_t* base = pn < 2 ? CQ + pn * 256 : CKV;
#pragma unroll
            for (int ai = 0; ai < 2; ++ai)
#pragma unroll
                for (int m = 0; m < 4; ++m) { const int row = row0 + ai * HALF + m * 16;
                    float s = (ssq4(acc[ai][0][m][0]) + ssq4(acc[ai][0][m][1])) + (ssq4(acc[ai][1][m][0]) + ssq4(acc[ai][1][m][1]));
                    s += __shfl_xor(s, 16); s += __shfl_xor(s, 32);
                    if (fq == 0) sq[(size_t)row * nslot + slot] = s;
#pragma unroll
                    for (int bj = 0; bj < 2; ++bj) *(u32x4*)(base + (size_t)row * ldc + bj * HALF + cw) = pack8(acc[ai][bj][m][0], acc[ai][bj][m][1]); }
        } else if (pn == 3) {
            if (wc < 2) {
#pragma unroll
                for (int ai = 0; ai < 2; ++ai)
#pragma unroll
                    for (int m = 0; m < 4; ++m) { const int row = row0 + ai * HALF + m * 16; const int pos = row & (SEQ - 1);
                        const float* cs = rope + ((size_t)pos * 32 + 16 * wc + 4 * fq) * 2;
                        const f32x4 csA = *(const f32x4*)cs, csB = *(const f32x4*)(cs + 4);
                        f32x4 v0 = acc[ai][0][m][0], v1 = acc[ai][0][m][1]; rope8(v0, v1, csA, csB);
                        *(u32x4*)(KR + (size_t)row * 64 + cw) = pack8(v0, v1); }
            }
        } else if (pn < 14) {
            bf16_t* base; int ldc;
            if (pn < 12) { base = QS + (pn - 4) * 256; ldc = 2048; } else if (pn == 12) { base = KS; ldc = 256; } else { base = VS; ldc = 256; }
#pragma unroll
            for (int ai = 0; ai < 2; ++ai)
#pragma unroll
                for (int m = 0; m < 4; ++m) { const int row = row0 + ai * HALF + m * 16;
#pragma unroll
                    for (int bj = 0; bj < 2; ++bj) *(u32x4*)(base + (size_t)row * ldc + bj * HALF + cw) = pack8(acc[ai][bj][m][0], acc[ai][bj][m][1]); }
        }
    }
};

struct EpiSig {
    static constexpr bool PERM = true, AFTER_DRAIN = false;
    bf16_t* GT;
    __device__ __forceinline__ void operator()(const f32x4 (&acc)[2][2][4][2], const Unit& u, int wr, int wc, int fr, int fq) const {
        const int row0 = u.pm * BM + wr * 64 + fr, cw = wc * 32 + 8 * fq; bf16_t* base = GT + u.pn * 256;
#pragma unroll
        for (int ai = 0; ai < 2; ++ai)
#pragma unroll
            for (int m = 0; m < 4; ++m) { const int row = row0 + ai * HALF + m * 16;
#pragma unroll
                for (int bj = 0; bj < 2; ++bj) { f32x4 v0 = acc[ai][bj][m][0], v1 = acc[ai][bj][m][1];
#pragma unroll
                    for (int e = 0; e < 4; ++e) { v0[e] = sigmoidf_(v0[e]); v1[e] = sigmoidf_(v1[e]); }
                    *(u32x4*)(base + (size_t)row * 4096 + bj * HALF + cw) = pack8(v0, v1); } }
    }
};

struct EpiUp {
    static constexpr bool PERM = true, AFTER_DRAIN = false;
    const float* ssq; int nslot; float invK; bf16_t* O0; bf16_t* O1; int ld0, ld1, split; int rope1; const float* rope;
    __device__ __forceinline__ void operator()(const f32x4 (&acc)[2][2][4][2], const Unit& u, int wr, int wc, int fr, int fq) const {
        const int pn = u.pn, row0 = u.pm * BM + wr * 64 + fr, cw = wc * 32 + 8 * fq;
        const int t = pn < split ? 0 : 1; bf16_t* base = t ? O1 + (pn - split) * 256 : O0 + pn * 256; const int ld = t ? ld1 : ld0;
        const bool dorope = (t == 1) && rope1;
#pragma unroll
        for (int ai = 0; ai < 2; ++ai)
#pragma unroll
            for (int m = 0; m < 4; ++m) { const int row = row0 + ai * HALF + m * 16;
                float s;
                if (nslot == 8) { const f32x4 a = *(const f32x4*)(ssq + (size_t)row * 8), b = *(const f32x4*)(ssq + (size_t)row * 8 + 4); s = ((a[0] + a[1]) + (a[2] + a[3])) + ((b[0] + b[1]) + (b[2] + b[3])); }
                else { const f32x4 a = *(const f32x4*)(ssq + (size_t)row * 4); s = (a[0] + a[1]) + (a[2] + a[3]); }
                const float rs = 1.0f / sqrtf(s * invK + EPS);
                f32x4 csA = {1.f, 0.f, 1.f, 0.f}, csB = {1.f, 0.f, 1.f, 0.f};
                if (dorope) { const int pos = row & (SEQ - 1); const float* cs = rope + ((size_t)pos * 32 + 16 * (wc & 1) + 4 * fq) * 2; csA = *(const f32x4*)cs; csB = *(const f32x4*)(cs + 4); }
#pragma unroll
                for (int bj = 0; bj < 2; ++bj) { f32x4 v0 = acc[ai][bj][m][0] * rs, v1 = acc[ai][bj][m][1] * rs;
                    if (dorope) rope8(v0, v1, csA, csB);
                    *(u32x4*)(base + (size_t)row * ld + bj * HALF + cw) = pack8(v0, v1); } }
    }
};

template <bool SECOND> struct EpiGate {
    static constexpr bool PERM = true, AFTER_DRAIN = false;
    const bf16_t* GT; bf16_t* MG;
    __device__ __forceinline__ void operator()(const f32x4 (&acc)[2][2][4][2], const Unit& u, int wr, int wc, int fr, int fq) const {
        const int row0 = u.pm * BM + wr * 64 + fr, col0 = u.pn * BM + wc * 32 + 8 * fq;
#pragma unroll
        for (int ai = 0; ai < 2; ++ai)
#pragma unroll
            for (int m = 0; m < 4; ++m) { const int row = row0 + ai * HALF + m * 16;
#pragma unroll
                for (int bj = 0; bj < 2; ++bj) { const int col = col0 + bj * HALF;
                    const u32x4 gw = *(const u32x4*)(GT + (size_t)row * 4096 + (SECOND ? 2048 : 0) + col); f32x4 g0, g1; unpack8(gw, g0, g1);
                    f32x4 v0 = acc[ai][bj][m][0] * g0, v1 = acc[ai][bj][m][1] * g1;
                    bf16_t* p = MG + (size_t)row * DM + col;
                    if (SECOND) { const u32x4 pw = *(const u32x4*)p; f32x4 p0, p1; unpack8(pw, p0, p1); v0 += p0; v1 += p1; }
                    *(u32x4*)p = pack8(v0, v1); } }
    }
};

struct EpiBfSsq {
    static constexpr bool PERM = true, AFTER_DRAIN = false;
    bf16_t* Y; float* ssq;
    __device__ __forceinline__ void operator()(const f32x4 (&acc)[2][2][4][2], const Unit& u, int wr, int wc, int fr, int fq) const {
        const int row0 = u.pm * BM + wr * 64 + fr, col0 = u.pn * BM + wc * 32 + 8 * fq;
#pragma unroll
        for (int ai = 0; ai < 2; ++ai)
#pragma unroll
            for (int m = 0; m < 4; ++m) { const int row = row0 + ai * HALF + m * 16;
                float s = (ssq4(acc[ai][0][m][0]) + ssq4(acc[ai][0][m][1])) + (ssq4(acc[ai][1][m][0]) + ssq4(acc[ai][1][m][1]));
                s += __shfl_xor(s, 16); s += __shfl_xor(s, 32);
                if (fq == 0) ssq[(size_t)row * 32 + u.pn * 4 + wc] = s;
#pragma unroll
                for (int bj = 0; bj < 2; ++bj) *(u32x4*)(Y + (size_t)row * DM + col0 + bj * HALF) = pack8(acc[ai][bj][m][0], acc[ai][bj][m][1]); }
    }
};

struct EpiFfn {
    static constexpr bool PERM = true, AFTER_DRAIN = false;
    bf16_t* G; float* AH; float* BH; const float* cw; const float* cb;
    __device__ __forceinline__ void operator()(const f32x4 (&acc)[2][2][4][2], const Unit& u, int wr, int wc, int fr, int fq) const {
        const int lane = threadIdx.x & 63;
        const int f0 = u.pn * 128 + wc * 32 + 8 * fq;
        f32x4 w0[2], w1[2], w2[2], bb[2];
#pragma unroll
        for (int n = 0; n < 2; ++n) { w0[n] = *(const f32x4*)(cw + f0 + 4 * n); w1[n] = *(const f32x4*)(cw + DFF + f0 + 4 * n); w2[n] = *(const f32x4*)(cw + 2 * DFF + f0 + 4 * n); bb[n] = *(const f32x4*)(cb + f0 + 4 * n); }
        const int src1 = (lane & 48) | ((fr - 1) & 15), src2 = (lane & 48) | ((fr - 2) & 15);
#pragma unroll
        for (int ai = 0; ai < 2; ++ai) {
            const int jb = u.pm * 4 + ai * 2 + wr;
            f32x4 p1[2], p2[2];
#pragma unroll
            for (int n = 0; n < 2; ++n) { p1[n] = (f32x4){0.f, 0.f, 0.f, 0.f}; p2[n] = p1[n]; }
#pragma unroll
            for (int m = 0; m < 4; ++m) {
                f32x4 o[2];
#pragma unroll
                for (int n = 0; n < 2; ++n) { f32x4 r1, r2;
#pragma unroll
                    for (int e = 0; e < 4; ++e) { const float a0 = acc[ai][0][m][n][e]; r1[e] = __shfl(a0, src1); r2[e] = __shfl(a0, src2); }
                    f32x4 a1, a2;
#pragma unroll
                    for (int e = 0; e < 4; ++e) { a1[e] = fr >= 1 ? r1[e] : p1[n][e]; a2[e] = fr >= 2 ? r2[e] : p2[n][e]; }
                    p1[n] = r1; p2[n] = r2;
                    const f32x4 c = bb[n] + w0[n] * a2 + w1[n] * a1 + w2[n] * acc[ai][0][m][n];
#pragma unroll
                    for (int e = 0; e < 4; ++e) { const float x = c[e]; const float uu = 0.7978845608028654f * (x + 0.044715f * x * x * x);
                        const float gl = x * __builtin_amdgcn_rcpf(1.f + __builtin_amdgcn_exp2f(-2.885390081777927f * uu)); o[n][e] = gl * acc[ai][1][m][n][e]; } }
                const int row = u.pm * BM + ai * HALF + wr * 64 + m * 16 + fr;
                if (!(m == 0 && fr < 2)) *(u32x4*)(G + (size_t)row * DFF + f0) = pack8(o[0], o[1]);
                if (m == 0 && fr < 2) { float* ah = AH + ((size_t)jb * 4 + 2 + fr) * DFF + f0; *(f32x4*)ah = acc[ai][0][0][0]; *(f32x4*)(ah + 4) = acc[ai][0][0][1];
                    float* bh = BH + ((size_t)jb * 2 + fr) * DFF + f0; *(f32x4*)bh = acc[ai][1][0][0]; *(f32x4*)(bh + 4) = acc[ai][1][0][1]; }
                if (m == 3 && fr >= 14) { float* ah = AH + ((size_t)jb * 4 + (fr - 14)) * DFF + f0; *(f32x4*)ah = acc[ai][0][3][0]; *(f32x4*)(ah + 4) = acc[ai][0][3][1]; }
            }
        }
    }
};
}
namespace att {
typedef short bf16x8 __attribute__((ext_vector_type(8)));
typedef short s16x4 __attribute__((ext_vector_type(4)));
typedef float f32x16 __attribute__((ext_vector_type(16)));
typedef float f32x4 __attribute__((ext_vector_type(4)));
typedef unsigned u32x4 __attribute__((ext_vector_type(4)));
typedef unsigned short bf16_t;
#define SBAR() __builtin_amdgcn_sched_barrier(0)
#define KSWZ(row, colB) ((row) * 256 + ((colB) ^ (((row) & 7) << 4)))
#define KSWZ64(row, chunk) ((row) * 128 + ((((chunk) ^ ((row) & 7))) << 4))
template <int NCB> __device__ __forceinline__ int v_st(int k, int c) { const int kk = (k & ~0xC) | ((k & 4) << 1) | ((k & 8) >> 1); return ((kk >> 3) * NCB + (c >> 5)) * 512 + ((kk & 7) * 32 + (c & 31)) * 2; }
__device__ __forceinline__ int v_rd_base(int lane) { return ((lane & 3) << 3) | (((lane >> 2) & 3) << 6) | (((lane >> 4) & 1) << 5) | (((lane >> 5) & 1) << 8); }
__device__ __forceinline__ int crow(int r, int hi) { return (r & 3) + 8 * (r >> 2) + 4 * hi; }
typedef float f32x2_cv __attribute__((ext_vector_type(2))); typedef __bf16 bf16x2_cv __attribute__((ext_vector_type(2)));
__device__ __forceinline__ unsigned cvtpk(float lo, float hi) { f32x2_cv v = {lo, hi}; bf16x2_cv b = __builtin_convertvector(v, bf16x2_cv); return __builtin_bit_cast(unsigned, b); }
__device__ __forceinline__ void mask_tile(f32x16& p0, f32x16& p1, int dq, unsigned W) {
    const float NEG = -__builtin_inff();
#pragma unroll
    for (int r = 0; r < 16; ++r) { const int c = (r & 3) + 8 * (r >> 2);
        if ((unsigned)(dq - c) >= W) p0[r] = NEG;
        if ((unsigned)(dq - c - 32) >= W) p1[r] = NEG; }
}
constexpr float THR = 8.f;
template <int SCALE_E6> __device__ __forceinline__ void partialSM(f32x16& p0, f32x16& p1, float& m_reg, float& mn, float& alpha) {
    constexpr float SCALE = SCALE_E6 * 1e-9f; constexpr float C2 = 1.4426950408889634f * SCALE;
    float pmax = p0[0];
#pragma unroll
    for (int r = 1; r < 16; ++r) pmax = fmaxf(pmax, p0[r]);
#pragma unroll
    for (int r = 0; r < 16; ++r) pmax = fmaxf(pmax, p1[r]);
    { auto rr = __builtin_amdgcn_permlane32_swap(__float_as_uint(pmax), __float_as_uint(pmax), false, false);
      pmax = fmaxf(__uint_as_float(rr[0]), __uint_as_float(rr[1])); }
    if (__builtin_expect(__all((pmax - m_reg) * SCALE <= THR), 1)) { mn = m_reg; alpha = 1.f; }
    else { mn = fmaxf(m_reg, pmax); alpha = __builtin_amdgcn_exp2f((m_reg - mn) * C2); m_reg = mn; }
    const float mnL = -mn * C2;
#pragma unroll
    for (int r = 0; r < 16; ++r) p0[r] = fmaf(p0[r], C2, mnL);
#pragma unroll
    for (int r = 0; r < 16; ++r) p1[r] = fmaf(p1[r], C2, mnL);
#pragma unroll
    for (int r = 0; r < 16; ++r) p0[r] = __builtin_amdgcn_exp2f(p0[r]);
}
__device__ __forceinline__ void finishSM(f32x16& p0, f32x16& p1, float alpha, float& l_reg, bf16x8& pa0, bf16x8& pa1, bf16x8& pa2, bf16x8& pa3) {
#pragma unroll
    for (int r = 0; r < 16; ++r) p1[r] = __builtin_amdgcn_exp2f(p1[r]);
    float ps = 0;
#pragma unroll
    for (int r = 0; r < 16; ++r) ps += p0[r];
#pragma unroll
    for (int r = 0; r < 16; ++r) ps += p1[r];
    { auto rr = __builtin_amdgcn_permlane32_swap(__float_as_uint(ps), __float_as_uint(ps), false, false);
      ps = __uint_as_float(rr[0]) + __uint_as_float(rr[1]); }
    l_reg = l_reg * alpha + ps;
#define PK4(P, B_, OUT) do { unsigned a0 = cvtpk(P[B_+0], P[B_+1]), a1 = cvtpk(P[B_+2], P[B_+3]);                          \
        unsigned b0 = cvtpk(P[B_+4], P[B_+5]), b1 = cvtpk(P[B_+6], P[B_+7]);                                             \
        auto r0 = __builtin_amdgcn_permlane32_swap(a0, b0, false, false); auto r1 = __builtin_amdgcn_permlane32_swap(a1, b1, false, false); \
        u32x4 w = {r0[0], r1[0], r0[1], r1[1]}; OUT = *reinterpret_cast<bf16x8*>(&w); } while (0)
    PK4(p0, 0, pa0); PK4(p0, 8, pa1); PK4(p1, 0, pa2); PK4(p1, 8, pa3);
#undef PK4
}
__device__ __forceinline__ void qk128(f32x16& p0, f32x16& p1, const LAS char* kl, int r32, int hi, const bf16x8* qr) {
    const LAS char* kb[4];
#pragma unroll
    for (int dd = 0; dd < 4; ++dd) kb[dd] = kl + KSWZ(r32, (dd * 16 + hi * 8) * 2);
#pragma unroll
    for (int d0 = 0; d0 < 8; ++d0) { const LAS char* a = kb[d0 & 3] + (d0 >> 2) * 128;
        const bf16x8 b0 = *reinterpret_cast<const LAS bf16x8*>(a);
        const bf16x8 b1 = *reinterpret_cast<const LAS bf16x8*>(a + 32 * 256);
        p0 = __builtin_amdgcn_mfma_f32_32x32x16_bf16(b0, qr[d0], p0, 0, 0, 0);
        p1 = __builtin_amdgcn_mfma_f32_32x32x16_bf16(b1, qr[d0], p1, 0, 0, 0); }
}
__device__ __forceinline__ void qk64(f32x16& p0, f32x16& p1, const LAS char* kl, int r32, int hi, const bf16x8* qr) {
#pragma unroll
    for (int ks = 0; ks < 4; ++ks) { const LAS char* a = kl + KSWZ64(r32, 2 * ks + hi);
        const bf16x8 b0 = *reinterpret_cast<const LAS bf16x8*>(a);
        const bf16x8 b1 = *reinterpret_cast<const LAS bf16x8*>(a + 32 * 128);
        p0 = __builtin_amdgcn_mfma_f32_32x32x16_bf16(b0, qr[ks], p0, 0, 0, 0);
        p1 = __builtin_amdgcn_mfma_f32_32x32x16_bf16(b1, qr[ks], p1, 0, 0, 0); }
}
template <int NCB> __device__ __forceinline__ void pv_tile(f32x16* o, int vb, bf16x8 pa0, bf16x8 pa1, bf16x8 pa2, bf16x8 pa3) {
#define TRRD(dst, off) asm volatile("ds_read_b64_tr_b16 %0, %1 offset:%2" : "=&v"(dst) : "v"(vb), "i"(off) : "memory")
#define PV_D0(d0) do { s16x4 l0, l1, l2, l3, h0, h1, h2, h3; constexpr int b_ = (d0) * 512; constexpr int KS_ = NCB * 1024;     \
        TRRD(l0, b_); TRRD(h0, b_ + KS_ / 2); TRRD(l1, b_ + KS_); TRRD(h1, b_ + KS_ + KS_ / 2); TRRD(l2, b_ + 2 * KS_); TRRD(h2, b_ + 2 * KS_ + KS_ / 2); TRRD(l3, b_ + 3 * KS_); TRRD(h3, b_ + 3 * KS_ + KS_ / 2); \
        asm volatile("s_waitcnt lgkmcnt(0)" ::: "memory"); SBAR();   \
        o[d0] = __builtin_amdgcn_mfma_f32_32x32x16_bf16(pa0, (bf16x8){l0[0], l0[1], l0[2], l0[3], h0[0], h0[1], h0[2], h0[3]}, o[d0], 0, 0, 0);   \
        o[d0] = __builtin_amdgcn_mfma_f32_32x32x16_bf16(pa1, (bf16x8){l1[0], l1[1], l1[2], l1[3], h1[0], h1[1], h1[2], h1[3]}, o[d0], 0, 0, 0);   \
        o[d0] = __builtin_amdgcn_mfma_f32_32x32x16_bf16(pa2, (bf16x8){l2[0], l2[1], l2[2], l2[3], h2[0], h2[1], h2[2], h2[3]}, o[d0], 0, 0, 0);   \
        o[d0] = __builtin_amdgcn_mfma_f32_32x32x16_bf16(pa3, (bf16x8){l3[0], l3[1], l3[2], l3[3], h3[0], h3[1], h3[2], h3[3]}, o[d0], 0, 0, 0); } while (0)
    PV_D0(0); PV_D0(1);
    if constexpr (NCB == 4) { PV_D0(2); PV_D0(3); }
#undef PV_D0
#undef TRRD
}

struct AttnP {
    bf16_t* QN; const bf16_t* QR; const bf16_t* KN; const bf16_t* KR; const bf16_t* V;
    bf16_t* QS; const bf16_t* KS; const bf16_t* VS;
    const float* sinks; const float* rel;
};
__device__ const unsigned char T5B[128] = {0, 1, 2, 3, 4, 5, 6, 7, 8, 9, 10, 11, 12, 13, 14, 15, 16, 16, 16, 17, 17, 18, 18, 18, 19, 19, 19, 20, 20, 20, 20, 21, 21, 21, 21, 22, 22, 22, 22, 22, 23, 23, 23, 23, 23, 23, 24, 24, 24, 24, 24, 24, 25, 25, 25, 25, 25, 25, 25, 26, 26, 26, 26, 26, 26, 26, 26, 27, 27, 27, 27, 27, 27, 27, 27, 27, 27, 28, 28, 28, 28, 28, 28, 28, 28, 28, 28, 29, 29, 29, 29, 29, 29, 29, 29, 29, 29, 29, 29, 30, 30, 30, 30, 30, 30, 30, 30, 30, 30, 30, 30, 30, 30, 31, 31, 31, 31, 31, 31, 31, 31, 31, 31, 31, 31, 31, 31, 31};

template <bool MLA> __device__ __forceinline__ void attn_unit(const AttnP& P, int b, int hh, int qb, LAS char* lds) {
    constexpr int DV = MLA ? 128 : 64, NCB = DV / 32, NQF = MLA ? 12 : 4;
    constexpr int KBYTES = MLA ? 24576 : 8192, VBYTES = 64 * DV * 2;
    constexpr int SC9 = MLA ? 72168784 : 125000000;
    constexpr float SCALE = SC9 * 1e-9f;
    constexpr int W = MLA ? (1 << 30) : 128;
    const int tid = threadIdx.x, wid = __builtin_amdgcn_readfirstlane(tid >> 6), lane = tid & 63, r32 = lane & 31, hi = lane >> 5;
    LAS char* V_lds = lds; LAS char* K_lds = lds + 2 * VBYTES;
    LAS float* ws = (LAS float*)(lds + 2 * VBYTES + 2 * KBYTES) + wid * 64; LAS float* li_l = ws; LAS float* al_l = ws + 32;
    LAS float* bias_l = (LAS float*)(lds + 2 * VBYTES + 2 * KBYTES + 2048);
    const int q0 = qb * 256; const size_t rowbase = (size_t)b * SEQ;
    const int jt0 = MLA ? 0 : (q0 == 0 ? 0 : -2);
    const int NT = MLA ? 4 * qb + 4 : 4 - jt0;
    const int kbase0 = MLA ? 0 : q0 + 64 * jt0;
    const int qlo = q0 + wid * 32, qm = qlo + r32 - 4 * hi;
    bf16x8 qr[NQF];
    const size_t qrow = rowbase + qlo + r32;
    if constexpr (MLA) {
#pragma unroll
        for (int d0 = 0; d0 < 8; ++d0) qr[d0] = *(const bf16x8*)(P.QN + qrow * 2048 + hh * 128 + d0 * 16 + hi * 8);
#pragma unroll
        for (int d0 = 0; d0 < 4; ++d0) qr[8 + d0] = *(const bf16x8*)(P.QR + qrow * 1024 + hh * 64 + d0 * 16 + hi * 8);
    } else {
#pragma unroll
        for (int d0 = 0; d0 < 4; ++d0) qr[d0] = *(const bf16x8*)(P.QS + qrow * 2048 + hh * 64 + d0 * 16 + hi * 8);
        if (tid < 128) bias_l[tid] = P.rel[(int)T5B[tid] * 32 + hh] * (1.0f / SCALE);
    }
    bf16x8 sk0, sv0;
    const int sr8 = tid >> 3, ch8 = tid & 7;
    const bf16_t* Kg; const bf16_t* Vg; const bf16_t* Rg = nullptr;
    unsigned okA = 0, okB = 0, orp = 0, ovA = 0, ovB = 0;
    if constexpr (MLA) {
        Kg = P.KN + rowbase * 2048 + hh * 128; Vg = P.V + rowbase * 2048 + hh * 128; Rg = P.KR + rowbase * 64;
        { const int rA = 4 * wid + (lane >> 4), rB = rA + 32, cp = lane & 15; okA = (unsigned)(rA * 2048 + ((cp ^ (rA & 7)) << 3)); okB = (unsigned)(rB * 2048 + ((cp ^ (rB & 7)) << 3)); }
        { const int rr = 8 * wid + (lane >> 3), cp = lane & 7; orp = (unsigned)(rr * 64 + ((cp ^ (rr & 7)) << 3)); }
        { const int stA = 2 * wid + (lane >> 5), stB = stA + 16; const int kl = (lane & 31) >> 2, c8 = 8 * (lane & 3);
          const int kkA = (stA >> 2) * 8 + kl, kkB = (stB >> 2) * 8 + kl;
          const int kA = (kkA & ~0xC) | ((kkA & 4) << 1) | ((kkA & 8) >> 1), kB = (kkB & ~0xC) | ((kkB & 4) << 1) | ((kkB & 8) >> 1);
          ovA = (unsigned)(kA * 2048 + 32 * (stA & 3) + c8); ovB = (unsigned)(kB * 2048 + 32 * (stB & 3) + c8); }
    } else { Kg = P.KS + (rowbase + sr8) * 256 + (hh >> 3) * 64 + ch8 * 8; Vg = P.VS + (rowbase + sr8) * 256 + (hh >> 3) * 64 + ch8 * 8; }
    const int kws = KSWZ64(sr8, ch8), vst0 = v_st<NCB>(sr8, ch8 * 8);
#define GLDS(gp, lp) __builtin_amdgcn_global_load_lds((const unsigned*)(gp), (LAS unsigned*)(lp), 16, 0, 0)
#define LOADT(t, bf) do { const size_t k0_ = (size_t)(kbase0 + 64 * (t)); \
        if constexpr (MLA) { LAS char* kd_ = K_lds + (bf) * KBYTES + wid * 1024; LAS char* vd_ = V_lds + (bf) * VBYTES + wid * 1024; \
            const bf16_t* kp_ = Kg + k0_ * 2048; const bf16_t* vp_ = Vg + k0_ * 2048; const bf16_t* rp_ = Rg + k0_ * 64; \
            GLDS(kp_ + okA, kd_); GLDS(kp_ + okB, kd_ + 8192); GLDS(rp_ + orp, kd_ + 16384); GLDS(vp_ + ovA, vd_); GLDS(vp_ + ovB, vd_ + 8192); } \
        else { sk0 = *(const bf16x8*)(Kg + k0_ * 256); sv0 = *(const bf16x8*)(Vg + k0_ * 256); } } while (0)
#define WRITET(bf) do { if constexpr (!MLA) { *(LAS bf16x8*)(K_lds + (bf) * KBYTES + kws) = sk0; *(LAS bf16x8*)(V_lds + (bf) * VBYTES + vst0) = sv0; } } while (0)
    float m_reg = MLA ? -1e30f : P.sinks[hh] * (1.0f / SCALE), l_reg = MLA ? 0.f : 1.f;
    f32x16 o[NCB];
#pragma unroll
    for (int d = 0; d < NCB; ++d) o[d] = f32x16{};
    const int vb0 = (int)(uintptr_t)V_lds + v_rd_base(lane);
    LOADT(0, 0); asm volatile("s_waitcnt vmcnt(0)" ::: "memory"); WRITET(0); __syncthreads();
    for (int t = 0; t < NT; ++t) {
        const int buf = t & 1;
        if (t + 1 < NT) LOADT(t + 1, buf ^ 1);
        const int kb = kbase0 + 64 * t;
        const bool act = (kb <= qlo + 31) && (MLA || kb + 63 >= qlo - (W - 1));
        if (act) {
            f32x16 p0 = f32x16{}, p1 = f32x16{};
            if constexpr (MLA) { qk128(p0, p1, K_lds + buf * KBYTES, r32, hi, qr); qk64(p0, p1, K_lds + buf * KBYTES + 16384, r32, hi, qr + 8); }
            else { qk64(p0, p1, K_lds + buf * KBYTES, r32, hi, qr); }
            const int dq = qm - kb;
            if constexpr (!MLA) {
#pragma unroll
                for (int r = 0; r < 16; ++r) { const int c = (r & 3) + 8 * (r >> 2); p0[r] += bias_l[(dq - c) & 127]; p1[r] += bias_l[(dq - c - 32) & 127]; }
            }
            if (kb + 63 > qlo || (!MLA && kb <= qlo + 31 - W)) mask_tile(p0, p1, dq, (unsigned)W);
            float mn, alpha; bf16x8 pa0, pa1, pa2, pa3;
            partialSM<SC9>(p0, p1, m_reg, mn, alpha);
            finishSM(p0, p1, alpha, l_reg, pa0, pa1, pa2, pa3);
            if (__any(alpha < 1.f)) { if (hi == 0) al_l[r32] = alpha; asm volatile("s_waitcnt lgkmcnt(0)" ::: "memory");
#pragma unroll
                for (int d_ = 0; d_ < NCB; ++d_)
#pragma unroll
                    for (int r = 0; r < 16; ++r) o[d_][r] *= al_l[crow(r, hi)]; }
            SBAR();
            pv_tile<NCB>(o, vb0 + buf * VBYTES, pa0, pa1, pa2, pa3);
        }
        if (t + 1 < NT) { asm volatile("s_waitcnt vmcnt(0)" ::: "memory"); WRITET(buf ^ 1); }
        __syncthreads();
    }
    if (hi == 0) li_l[r32] = l_reg; asm volatile("s_waitcnt lgkmcnt(0)" ::: "memory");
    bf16_t* Ow = (MLA ? P.QN + (rowbase + qlo) * 2048 + hh * 128 : P.QS + (rowbase + qlo) * 2048 + hh * 64);
#pragma unroll
    for (int r = 0; r < 16; ++r) { const int orow = crow(r, hi); const float rl = __builtin_amdgcn_rcpf(li_l[orow]);
#pragma unroll
        for (int d0 = 0; d0 < NCB; ++d0) { const float v = o[d0][r] * rl; const float vn = __shfl_xor(v, 1);
            if ((r32 & 1) == 0) *(unsigned*)(Ow + (size_t)orow * 2048 + d0 * 32 + r32) = cvtpk(v, vn); } }
    __syncthreads();
#undef LOADT
#undef WRITET
#undef GLDS
}
#undef SBAR
}
typedef unsigned short bf16;
typedef unsigned v4u __attribute__((ext_vector_type(4)));
typedef float f32x4 __attribute__((ext_vector_type(4)));
constexpr size_t MiB = 1u << 20;
constexpr size_t WS_WIN = 1 * MiB, WS_WQ = 31 * MiB, WS_WKV = 34 * MiB, WS_WOA = 36 * MiB, WS_WOB = 44 * MiB, WS_WOUT = 52 * MiB, WS_WUP = 60 * MiB, WS_WDN = 104 * MiB;
constexpr size_t WS_ROPE = 126 * MiB;
constexpr size_t WS_SSQQ = 130 * MiB, WS_SSQKV = 131 * MiB, WS_SSQY = 132 * MiB, WS_SSQY2 = 136 * MiB;
constexpr size_t WS_XN = 140 * MiB;
constexpr size_t WS_CQ = 268 * MiB, WS_CKV = 300 * MiB, WS_KR = 316 * MiB, WS_KS = 320 * MiB, WS_VS = 336 * MiB, WS_QS = 352 * MiB;
constexpr size_t WS_QN = 480 * MiB, WS_QR = 608 * MiB, WS_KN = 672 * MiB, WS_V = 800 * MiB;
constexpr size_t WS_GT = 608 * MiB, WS_MG = 864 * MiB;
constexpr size_t WS_Y = 140 * MiB, WS_X1 = 768 * MiB, WS_H2 = 640 * MiB;
constexpr size_t WS_G = 140 * MiB, WS_AH = 492 * MiB, WS_BH = 536 * MiB;
constexpr size_t WS_Y2 = 640 * MiB, WS_END = 1024 * MiB;

struct Args {
    const float *x, *g_mix_pre, *g_mix_post, *g_ffn_pre, *g_ffn_post, *w_in, *q_norm, *w_q_up, *kv_norm, *w_kv_up, *sinks, *rel, *w_o_mla, *w_o_swa, *w_out, *w_up, *conv_w, *conv_b, *w_down;
    float* out; unsigned char* ws; int ph_lo, ph_hi;
};

__device__ __forceinline__ unsigned f2bf(float f) { unsigned u = __builtin_bit_cast(unsigned, f); return (u + 0x7fffu + ((u >> 16) & 1u)) >> 16; }
__device__ __forceinline__ unsigned pk2(float lo, float hi) { return f2bf(lo) | (f2bf(hi) << 16); }
__device__ __forceinline__ float wave_sum(float v) {
#pragma unroll
    for (int o = 1; o < 64; o <<= 1) v += __shfl_xor(v, o);
    return v;
}
__device__ __forceinline__ void tr_item(const float* W, int K, int Nsrc, int k0, int nsrc0, bf16* WT, int drow0, int dstride, const float* gain, LAS float* scr, int lane) {
#pragma unroll 8
    for (int i = 0; i < 32; ++i) { const int kk = 2 * i + (lane >> 5); float v = W[(size_t)(k0 + kk) * Nsrc + nsrc0 + (lane & 31)]; if (gain) v *= gain[k0 + kk]; scr[kk * 33 + (lane & 31)] = v; }
    asm volatile("s_waitcnt lgkmcnt(0)" ::: "memory");
    const int c = lane & 7;
#pragma unroll
    for (int j = 0; j < 4; ++j) { const int n = (lane >> 3) + 8 * j; const LAS float* s = scr + (8 * c) * 33 + n;
        v4u o; o.x = pk2(s[0 * 33], s[1 * 33]); o.y = pk2(s[2 * 33], s[3 * 33]); o.z = pk2(s[4 * 33], s[5 * 33]); o.w = pk2(s[6 * 33], s[7 * 33]);
        *(v4u*)(WT + (size_t)(drow0 + n * dstride) * K + k0 + 8 * c) = o; }
    asm volatile("s_waitcnt lgkmcnt(0)" ::: "memory");
}

__global__ void __launch_bounds__(512) fwd_mega(Args a) {
    extern __shared__ __attribute__((aligned(16))) unsigned char lds_raw[];
    LAS unsigned char* lds = (LAS unsigned char*)lds_raw;
    cg::grid_group grid = cg::this_grid();
    const int tid = threadIdx.x, lane = tid & 63, wave = __builtin_amdgcn_readfirstlane(tid >> 6);
    const int G = gridDim.x, bx = blockIdx.x;
    const int vcu = (G % 8 == 0) ? (bx % 8) * (G / 8) + bx / 8 : bx;
    unsigned char* ws = a.ws;
    bf16 *Win_t = (bf16*)(ws + WS_WIN), *Wq_t = (bf16*)(ws + WS_WQ), *Wkv_t = (bf16*)(ws + WS_WKV), *WoA_t = (bf16*)(ws + WS_WOA), *WoB_t = (bf16*)(ws + WS_WOB),
         *Wout_t = (bf16*)(ws + WS_WOUT), *Wup_t = (bf16*)(ws + WS_WUP), *Wdn_t = (bf16*)(ws + WS_WDN);
    float* rope = (float*)(ws + WS_ROPE);
    float *ssqQ = (float*)(ws + WS_SSQQ), *ssqKV = (float*)(ws + WS_SSQKV), *ssqY = (float*)(ws + WS_SSQY), *ssqY2 = (float*)(ws + WS_SSQY2);
    bf16 *XN = (bf16*)(ws + WS_XN), *CQ = (bf16*)(ws + WS_CQ), *CKV = (bf16*)(ws + WS_CKV), *KR = (bf16*)(ws + WS_KR), *KS = (bf16*)(ws + WS_KS), *VS = (bf16*)(ws + WS_VS), *QS = (bf16*)(ws + WS_QS);
    bf16 *QN = (bf16*)(ws + WS_QN), *QR = (bf16*)(ws + WS_QR), *KN = (bf16*)(ws + WS_KN), *VV = (bf16*)(ws + WS_V), *MG = (bf16*)(ws + WS_MG), *GG = (bf16*)(ws + WS_G);
    bf16 *GT = (bf16*)(ws + WS_GT), *Y = (bf16*)(ws + WS_Y), *Y2 = (bf16*)(ws + WS_Y2), *H2 = (bf16*)(ws + WS_H2);
    float *X1 = (float*)(ws + WS_X1), *AH = (float*)(ws + WS_AH), *BH = (float*)(ws + WS_BH);
    const int gw = vcu * 8 + wave, NGW = G * 8;
    const int lo = a.ph_lo, hi = a.ph_hi;
#ifndef PHMASK
#define PHMASK 0xFFFF
#endif
#define IN(k) (((PHMASK >> (k)) & 1) && lo <= (k) && (k) < hi)
#define SEAM(k) do { if (IN(k) && IN((k) + 1)) { __threadfence(); grid.sync(); __builtin_amdgcn_fence(__ATOMIC_ACQUIRE, "agent"); asm volatile("s_waitcnt vmcnt(0) lgkmcnt(0)" ::: "memory"); __syncthreads(); } } while (0)

    if (IN(0)) {
        LAS float* scr = (LAS float*)(lds + wave * 16384);
        constexpr int I_IN = 32 * 234, I_Q = 8 * 96, I_KV = 4 * 128, I_O = 32 * 64, I_UP = 32 * 352, I_DN = 88 * 64;
        constexpr int NITEMS = I_IN + I_Q + I_KV + 3 * I_O + I_UP + I_DN;
        for (int it = gw; it < NITEMS; it += NGW) {
            int r = it;
            if (r < I_IN) { const int kb = r / 234, c = (r % 234) * 32; int d0, ds = 1;
                if (c < 768) d0 = c; else if (c < 832) { d0 = 768 + (c - 768) / 32; ds = 2; } else d0 = c + 192;
                tr_item(a.w_in, 2048, 7488, kb * 64, c, Win_t, d0, ds, nullptr, scr, lane); continue; } r -= I_IN;
            if (r < I_Q) { const int kb = r / 96, c = (r % 96) * 32, h = c / 192, w = c % 192; int d0, ds = 1;
                if (w < 128) d0 = 128 * h + w; else { d0 = 2048 + 64 * h + (w - 128) / 32; ds = 2; }
                tr_item(a.w_q_up, 512, 3072, kb * 64, c, Wq_t, d0, ds, a.q_norm, scr, lane); continue; } r -= I_Q;
            if (r < I_KV) { const int kb = r / 128, c = (r % 128) * 32, h = c / 256, w = c % 256;
                const int d0 = w < 128 ? 128 * h + w : 2048 + 128 * h + (w - 128);
                tr_item(a.w_kv_up, 256, 4096, kb * 64, c, Wkv_t, d0, 1, a.kv_norm, scr, lane); continue; } r -= I_KV;
            if (r < 3 * I_O) { const int wsel = r / I_O, q = r % I_O, kb = q / 64, c = (q % 64) * 32;
                tr_item(wsel == 0 ? a.w_o_mla : wsel == 1 ? a.w_o_swa : a.w_out, 2048, 2048, kb * 64, c, wsel == 0 ? WoA_t : wsel == 1 ? WoB_t : Wout_t, c, 1, nullptr, scr, lane); continue; } r -= 3 * I_O;
            if (r < I_UP) { const int kb = r / 352, c = (r % 352) * 32; int d0;
                if (c < DFF) d0 = 256 * (c / 128) + (c % 128); else { const int c2 = c - DFF; d0 = 256 * (c2 / 128) + 128 + (c2 % 128); }
                tr_item(a.w_up, 2048, 11264, kb * 64, c, Wup_t, d0, 1, nullptr, scr, lane); continue; } r -= I_UP;
            { const int kb = r / 64, c = (r % 64) * 32; tr_item(a.w_down, DFF, 2048, kb * 64, c, Wdn_t, c, 1, nullptr, scr, lane); }
        }
        for (int i = bx * 512 + tid; i < 192 * 2048 / 8; i += G * 512) *(v4u*)(Win_t + (size_t)832 * 2048 + (size_t)i * 8) = (v4u){0u, 0u, 0u, 0u};
        for (int i = bx * 512 + tid; i < SEQ * 32; i += G * 512) { const int pos = i >> 5, k = i & 31;
            const float inv = __builtin_amdgcn_exp2f(-(float)(2 * k) * (13.287712379549449f / 64.0f)); const float ang = (float)pos * inv;
            const double rev = (double)ang * 0.15915494309189535; const float fr = (float)(rev - __builtin_rint(rev));
            rope[2 * i] = __builtin_amdgcn_cosf(fr); rope[2 * i + 1] = __builtin_amdgcn_sinf(fr); }
        for (int m = gw; m < NTOK; m += NGW) {
            const f32x4* xr = (const f32x4*)(a.x + (size_t)m * DM) + lane; f32x4 v[8]; float s = 0.f;
#pragma unroll
            for (int j = 0; j < 8; ++j) { v[j] = xr[64 * j]; s += (v[j].x * v[j].x + v[j].y * v[j].y) + (v[j].z * v[j].z + v[j].w * v[j].w); }
            const float rs = 1.0f / sqrtf(wave_sum(s) * (1.f / DM) + EPS);
            unsigned long long* o8 = (unsigned long long*)(XN + (size_t)m * DM) + lane;
#pragma unroll
            for (int j = 0; j < 8; ++j) { const f32x4 g = *((const f32x4*)a.g_mix_pre + lane + 64 * j);
                o8[64 * j] = (unsigned long long)pk2(v[j].x * rs * g.x, v[j].y * rs * g.y) | ((unsigned long long)pk2(v[j].z * rs * g.z, v[j].w * rs * g.w) << 32); }
        }
    }
    SEAM(0);
    if (IN(1)) {
        pg8::Gemm g{XN, Win_t, NTOK, 3584, 2048}; pg8::StaticOrder S; S.init(NTOK, 3584, G, bx);
        ep::EpiIn E{CQ, CKV, KR, QS, KS, VS, ssqQ, ssqKV, rope};
        pg8::gemm_phase<ep::EpiIn, pg8::StaticOrder, true, true>(lds, g, S, E);
    }
    SEAM(1);
    if (IN(2)) {
        { pg8::Gemm g{CQ, Wq_t, NTOK, 3072, 512}; pg8::StaticOrder S; S.init(NTOK, 3072, G, bx);
          ep::EpiUp E{ssqQ, 8, 1.0f / 512.0f, QN, QR, 2048, 1024, 8, 1, rope};
          pg8::gemm_phase<ep::EpiUp, pg8::StaticOrder, true, true>(lds, g, S, E); }
        { pg8::Gemm g{CKV, Wkv_t, NTOK, 4096, 256}; pg8::StaticOrder S; S.init(NTOK, 4096, G, bx);
          ep::EpiUp E{ssqKV, 4, 1.0f / 256.0f, KN, VV, 2048, 2048, 8, 0, rope};
          pg8::gemm_phase<ep::EpiUp, pg8::StaticOrder, true, true>(lds, g, S, E); }
    }
    SEAM(2);
    if (IN(3)) {
        att::AttnP P{QN, QR, KN, KR, VV, QS, KS, VS, a.sinks, a.rel};
#ifndef NO_MLA
        for (int it = vcu; it < 1024; it += G) { const int bh = it >> 5, s = it & 31;
            att::attn_unit<true>(P, bh >> 4, bh & 15, 63 - s, (LAS char*)lds);
            att::attn_unit<true>(P, bh >> 4, bh & 15, s, (LAS char*)lds); }
#endif
#ifndef NO_SWA
        for (int it = vcu; it < 4096; it += G) { const int qb = it & 63, hq = (it >> 6) & 31, b = it >> 11;
            att::attn_unit<false>(P, b, hq, qb, (LAS char*)lds); }
#endif
    }
    SEAM(3);
    if (IN(4)) {
        pg8::Gemm g{XN, Win_t + (size_t)3584 * 2048, NTOK, 4096, 2048}; pg8::StaticOrder S; S.init(NTOK, 4096, G, bx);
        ep::EpiSig E{GT}; pg8::gemm_phase<ep::EpiSig, pg8::StaticOrder, true, true>(lds, g, S, E);
    }
    SEAM(4);
    if (IN(5)) {
        { pg8::Gemm g{QN, WoA_t, NTOK, 2048, 2048}; pg8::StaticOrder S; S.init(NTOK, 2048, G, bx);
          ep::EpiGate<false> E{GT, MG}; pg8::gemm_phase<ep::EpiGate<false>, pg8::StaticOrder, true, true>(lds, g, S, E); }
        { pg8::Gemm g{QS, WoB_t, NTOK, 2048, 2048}; pg8::StaticOrder S; S.init(NTOK, 2048, G, bx);
          ep::EpiGate<true> E{GT, MG}; pg8::gemm_phase<ep::EpiGate<true>, pg8::StaticOrder, true, true>(lds, g, S, E); }
    }
    SEAM(5);
    if (IN(6)) {
        pg8::Gemm g{MG, Wout_t, NTOK, 2048, 2048}; pg8::StaticOrder S; S.init(NTOK, 2048, G, bx);
        ep::EpiBfSsq E{Y, ssqY}; pg8::gemm_phase<ep::EpiBfSsq, pg8::StaticOrder, true, true>(lds, g, S, E);
    }
    SEAM(6);
    if (IN(7)) {
        for (int m = gw; m < NTOK; m += NGW) {
            float sy = ssqY[(size_t)m * 32 + (lane & 31)];
#pragma unroll
            for (int o = 1; o < 32; o <<= 1) sy += __shfl_xor(sy, o);
            const float rsy = 1.0f / sqrtf(sy * (1.f / DM) + EPS);
            const f32x4* xr = (const f32x4*)(a.x + (size_t)m * DM) + lane; const unsigned long long* yr = (const unsigned long long*)(Y + (size_t)m * DM) + lane;
            f32x4* outr = (f32x4*)(X1 + (size_t)m * DM) + lane; f32x4 v[8]; float s = 0.f;
#pragma unroll
            for (int j = 0; j < 8; ++j) { const f32x4 g = *((const f32x4*)a.g_mix_post + lane + 64 * j); const unsigned long long yw = yr[64 * j];
                const f32x4 yv = {__uint_as_float((unsigned)yw << 16), __uint_as_float((unsigned)yw & 0xffff0000u), __uint_as_float((unsigned)(yw >> 32) << 16), __uint_as_float((unsigned)(yw >> 32) & 0xffff0000u)};
                v[j] = xr[64 * j] + yv * rsy * g; outr[64 * j] = v[j];
                s += (v[j].x * v[j].x + v[j].y * v[j].y) + (v[j].z * v[j].z + v[j].w * v[j].w); }
            const float rs = 1.0f / sqrtf(wave_sum(s) * (1.f / DM) + EPS);
            unsigned long long* o8 = (unsigned long long*)(H2 + (size_t)m * DM) + lane;
#pragma unroll
            for (int j = 0; j < 8; ++j) { const f32x4 g = *((const f32x4*)a.g_ffn_pre + lane + 64 * j);
                o8[64 * j] = (unsigned long long)pk2(v[j].x * rs * g.x, v[j].y * rs * g.y) | ((unsigned long long)pk2(v[j].z * rs * g.z, v[j].w * rs * g.w) << 32); }
        }
    }
    SEAM(7);
    if (IN(8)) {
        pg8::Gemm g{H2, Wup_t, NTOK, 11264, 2048}; pg8::StaticOrder S; S.init(NTOK, 11264, G, bx);
        ep::EpiFfn E{GG, AH, BH, a.conv_w, a.conv_b}; pg8::gemm_phase<ep::EpiFfn, pg8::StaticOrder, true, true>(lds, g, S, E);
    }
    SEAM(8);
    if (IN(9)) {
        constexpr int NF4 = DFF / 4;
        for (int i = bx * 512 + tid; i < 1024 * NF4; i += G * 512) { const int f = (i % NF4) * 4, rj = i / NF4, jb = rj >> 1, ii = rj & 1; const bool first = (jb & 255) == 0;
            const f32x4 z = {0.f, 0.f, 0.f, 0.f};
            const f32x4 a0 = *(const f32x4*)(AH + ((size_t)jb * 4 + 2 + ii) * DFF + f);
            const f32x4 pm1 = first ? z : *(const f32x4*)(AH + ((size_t)(jb - 1) * 4 + 1) * DFF + f);
            const f32x4 pm2 = first ? z : *(const f32x4*)(AH + ((size_t)(jb - 1) * 4 + 0) * DFF + f);
            const f32x4 a1 = ii ? *(const f32x4*)(AH + ((size_t)jb * 4 + 2) * DFF + f) : pm1;
            const f32x4 a2 = ii ? pm1 : pm2;
            const f32x4 bv = *(const f32x4*)(BH + ((size_t)jb * 2 + ii) * DFF + f);
            const f32x4 c = *(const f32x4*)(a.conv_b + f) + *(const f32x4*)(a.conv_w + f) * a2 + *(const f32x4*)(a.conv_w + DFF + f) * a1 + *(const f32x4*)(a.conv_w + 2 * DFF + f) * a0;
            float o[4];
#pragma unroll
            for (int e = 0; e < 4; ++e) { const float x = c[e]; const float uu = 0.7978845608028654f * (x + 0.044715f * x * x * x);
                o[e] = x * __builtin_amdgcn_rcpf(1.f + __builtin_amdgcn_exp2f(-2.885390081777927f * uu)) * bv[e]; }
            *(unsigned long long*)(GG + ((size_t)jb * 64 + ii) * DFF + f) = (unsigned long long)pk2(o[0], o[1]) | ((unsigned long long)pk2(o[2], o[3]) << 32); }
    }
    SEAM(9);
    if (IN(10)) {
        pg8::Gemm g{GG, Wdn_t, NTOK, 2048, DFF}; pg8::StaticOrder S; S.init(NTOK, 2048, G, bx);
        ep::EpiBfSsq E{Y2, ssqY2}; pg8::gemm_phase<ep::EpiBfSsq, pg8::StaticOrder, true, true>(lds, g, S, E);
    }
    SEAM(10);
    if (IN(11)) {
        for (int m = gw; m < NTOK; m += NGW) {
            float sy = ssqY2[(size_t)m * 32 + (lane & 31)];
#pragma unroll
            for (int o = 1; o < 32; o <<= 1) sy += __shfl_xor(sy, o);
            const float rsy = 1.0f / sqrtf(sy * (1.f / DM) + EPS);
            const unsigned long long* yr = (const unsigned long long*)(Y2 + (size_t)m * DM) + lane; const f32x4* x1r = (const f32x4*)(X1 + (size_t)m * DM) + lane; f32x4* outr = (f32x4*)(a.out + (size_t)m * DM) + lane;
#pragma unroll
            for (int j = 0; j < 8; ++j) { const f32x4 g = *((const f32x4*)a.g_ffn_post + lane + 64 * j); const unsigned long long yw = yr[64 * j];
                const f32x4 yv = {__uint_as_float((unsigned)yw << 16), __uint_as_float((unsigned)yw & 0xffff0000u), __uint_as_float((unsigned)(yw >> 32) << 16), __uint_as_float((unsigned)(yw >> 32) & 0xffff0000u)};
                outr[64 * j] = x1r[64 * j] + yv * rsy * g; }
        }
    }
#undef IN
#undef SEAM
}

constexpr int LDS_BYTES = 147456;
extern "C" void kernel_launch(void* const* d_in, const int* in_sizes, int n_in, void* d_out, int out_size, void* d_ws, size_t ws_size, hipStream_t stream) {
    static int grid = 0;
    if (grid == 0) {
        if (n_in != 19 || in_sizes[0] != NTOK * DM || out_size != NTOK * DM || ws_size < WS_END) { fprintf(stderr, "kernel_launch: unexpected shapes (n_in %d, in0 %d, out %d, ws %zu)\n", n_in, n_in > 0 ? in_sizes[0] : -1, out_size, ws_size); grid = -1; return; }
        int dev = 0, cus = 0, per_cu = 0;
        hipGetDevice(&dev); hipDeviceGetAttribute(&cus, hipDeviceAttributeMultiprocessorCount, dev);
        if (hipFuncSetAttribute((const void*)fwd_mega, hipFuncAttributeMaxDynamicSharedMemorySize, LDS_BYTES) != hipSuccess) { fprintf(stderr, "kernel_launch: hipFuncSetAttribute failed\n"); grid = -1; return; }
        if (hipOccupancyMaxActiveBlocksPerMultiprocessor(&per_cu, (const void*)fwd_mega, 512, LDS_BYTES) != hipSuccess || per_cu < 1) { fprintf(stderr, "kernel_launch: occupancy query says %d\n", per_cu); per_cu = 1; }
        (void)hipGetLastError();
        grid = cus * 1;
        if (grid % 8 != 0 || grid <= 0) { fprintf(stderr, "kernel_launch: odd CU count %d\n", cus); }
    }
    if (grid < 0) return;
    Args a{};
    a.x = (const float*)d_in[0]; a.g_mix_pre = (const float*)d_in[1]; a.g_mix_post = (const float*)d_in[2]; a.g_ffn_pre = (const float*)d_in[3]; a.g_ffn_post = (const float*)d_in[4];
    a.w_in = (const float*)d_in[5]; a.q_norm = (const float*)d_in[6]; a.w_q_up = (const float*)d_in[7]; a.kv_norm = (const float*)d_in[8]; a.w_kv_up = (const float*)d_in[9];
    a.sinks = (const float*)d_in[10]; a.rel = (const float*)d_in[11]; a.w_o_mla = (const float*)d_in[12]; a.w_o_swa = (const float*)d_in[13]; a.w_out = (const float*)d_in[14];
    a.w_up = (const float*)d_in[15]; a.conv_w = (const float*)d_in[16]; a.conv_b = (const float*)d_in[17]; a.w_down = (const float*)d_in[18];
    a.out = (float*)d_out; a.ws = (unsigned char*)d_ws;
#ifndef NLAUNCH_SPLIT
#define NLAUNCH_SPLIT 0
#endif
    for (int ph = 0; ph < 12; ph += (NLAUNCH_SPLIT ? 1 : 12)) {
        a.ph_lo = ph; a.ph_hi = NLAUNCH_SPLIT ? ph + 1 : 12;
        void* args[] = {&a};
        hipError_t e = hipLaunchCooperativeKernel((const void*)fwd_mega, dim3(grid), dim3(512), args, LDS_BYTES, stream);
        if (e != hipSuccess) fprintf(stderr, "kernel_launch: cooperative launch failed: %s (grid %d)\n", hipGetErrorString(e), grid);
    }
}
```

```cpp
#include <hip/hip_runtime.h>
#include <hip/hip_cooperative_groups.h>
#include <cstdio>
#include <cstdint>
namespace cg = cooperative_groups;
namespace pg8 {
#define PG8_LAS __attribute__((address_space(3)))
typedef unsigned short bf16_t;
typedef short bf16x8 __attribute__((ext_vector_type(8)));
typedef float f32x4 __attribute__((ext_vector_type(4)));
typedef unsigned u32x4 __attribute__((ext_vector_type(4)));
constexpr int BM = 256, BK = 64, HALF = 128, HTB = HALF * BK * 2  , STAGE_BYTES = 8 * HTB, NXCD = 8, WGM = 8;

__host__ __device__ __forceinline__ int lds_byte(int r, int c) { const int st = (r >> 4) * 2 + (c >> 5), rr = r & 15, cc = c & 31, ob = rr * 64 + cc * 2; return st * 1024 + (ob ^ (((ob >> 9) & 1) << 5)); }
__host__ __device__ __forceinline__ void stage_rc(int b, int& R, int& C) { const int st = b / 1024, sb = b % 1024, swz = sb ^ (((sb >> 9) & 1) << 5); R = (st >> 1) * 16 + swz / 64; C = (st & 1) * 32 + (swz % 64) / 2; }
__host__ __device__ __forceinline__ int perm32(int rho) { const int n = rho >> 4, i = rho & 15; return 8 * (i >> 2) + 4 * n + (i & 3); }

struct Unit { int pm, pn; };
struct Gemm { const bf16_t* A; const bf16_t* Bt; int M, N, K; };

struct StaticOrder {
    int nM, nN, nwg, G, c;
    __host__ __device__ void init(int M, int N, int G_, int c_) { nM = M / BM; nN = N / BM; nwg = nM * nN; G = G_; c = c_; }
    __host__ __device__ bool next(int i, Unit& u) const {
        const long L = (long)i * G + c; if (L >= nwg) return false;
        int wgid = (int)L; { const int q = nwg / NXCD, r = nwg % NXCD, xcd = wgid % NXCD, off = wgid / NXCD; wgid = (xcd < r ? xcd * (q + 1) : r * (q + 1) + (xcd - r) * q) + off; }
        const int nig = WGM * nN, gid = wgid / nig, fm = gid * WGM, gsz = (nM - fm) < WGM ? (nM - fm) : WGM;
        u.pm = fm + ((wgid % nig) % gsz); u.pn = (wgid % nig) / gsz; return true;
    }
    __device__ __forceinline__ void a_ready(const Unit&) const {}
    __device__ __forceinline__ void done(const Unit&) const {}
};

typedef float f32x2_cv __attribute__((ext_vector_type(2))); typedef __bf16 bf16x2_cv __attribute__((ext_vector_type(2)));
__device__ __forceinline__ unsigned cvt_pk_bf16(float lo, float hi) { f32x2_cv v = {lo, hi}; bf16x2_cv b = __builtin_convertvector(v, bf16x2_cv); return __builtin_bit_cast(unsigned, b); }
template <class Epi, class Sched, bool ALIGN_EPI = false, bool SP2 = false>
__device__ __forceinline__ void gemm_phase(PG8_LAS unsigned char* lds, const Gemm g, const Sched& S, const Epi& E) {
    const int tid = threadIdx.x, wid = __builtin_amdgcn_readfirstlane(tid >> 6), lane = tid & 63, wr = wid >> 2, wc = wid & 3, fr = lane & 15, fq = lane >> 4;
    const int K = g.K, nt = K / BK;
    unsigned voffA[2], voffB[2];
#pragma unroll
    for (int i = 0; i < 2; ++i) { int R, C; stage_rc(tid * 16 + i * 8192, R, C); const int Rb = Epi::PERM ? ((R & ~31) + perm32(R & 31)) : R;
        voffA[i] = (unsigned)(R * K + C) * 2u; voffB[i] = (unsigned)(Rb * K + C) * 2u; }
    const size_t kstep = (size_t)(BK * 2);
    const size_t hstep = (size_t)HALF * K * 2;
    const size_t tstep = 2 * hstep;
    const unsigned ldsw = (unsigned)wid * 1024u;
    const int aoff = lds_byte(wr * 64 + fr, fq * 8), boff = lds_byte(wc * 32 + fr, fq * 8);
#define PG8_SA(b, h) (((b) * 2 + (h)) * HTB)
#define PG8_SB(b, h) ((4 + (b) * 2 + (h)) * HTB)
#define PG8_STAGE(bufoff, gbase, voff) do { _Pragma("unroll") for (int _i = 0; _i < 2; ++_i) \
        __builtin_amdgcn_global_load_lds((const unsigned*)((const char*)(gbase) + (voff)[_i]), (PG8_LAS unsigned*)(lds + (bufoff) + ldsw + _i * 8192), 16, 0, 0); } while (0)
#define PG8_LDA(dst, b, h) do { _Pragma("unroll") for (int m = 0; m < 4; ++m) _Pragma("unroll") for (int k = 0; k < 2; ++k) dst[m][k] = *(const PG8_LAS bf16x8*)(lds + PG8_SA(b, h) + aoff + m * 2048 + k * 1024); } while (0)
#define PG8_LDB(dst, b, h) do { _Pragma("unroll") for (int n = 0; n < 2; ++n) _Pragma("unroll") for (int k = 0; k < 2; ++k) dst[n][k] = *(const PG8_LAS bf16x8*)(lds + PG8_SB(b, h) + boff + n * 2048 + k * 1024); } while (0)
#define PG8_MMA(ai, bj, At, Bt) do { __builtin_amdgcn_s_setprio(1); _Pragma("unroll") for (int m = 0; m < 4; ++m) _Pragma("unroll") for (int n = 0; n < 2; ++n) _Pragma("unroll") for (int k = 0; k < 2; ++k) \
        acc[ai][bj][m][n] = __builtin_amdgcn_mfma_f32_16x16x32_bf16(Bt[n][k], At[m][k], acc[ai][bj][m][n], 0, 0, 0); __builtin_amdgcn_s_setprio(0); } while (0)
#define PG8_WAIT_V(n) asm volatile("s_waitcnt vmcnt(" #n ")" ::: "memory")
#define PG8_WAIT_L(n) asm volatile("s_waitcnt lgkmcnt(" #n ")" ::: "memory")
#define PG8_BAR __builtin_amdgcn_s_barrier()
#define PG8_SCHED __builtin_amdgcn_sched_barrier(0)
    Unit cur, nxt; int ui = 0;
    if (!S.next(0, cur)) return;
    f32x4 acc[2][2][4][2];
#pragma unroll
    for (int a = 0; a < 2; ++a)
#pragma unroll
        for (int b = 0; b < 2; ++b)
#pragma unroll
            for (int m = 0; m < 4; ++m)
#pragma unroll
                for (int n = 0; n < 2; ++n) acc[a][b][m][n] = (f32x4){0.f, 0.f, 0.f, 0.f};
    bf16x8 At[4][2], B0[2][2], B1[2][2];
    const char* cA = (const char*)g.A + (size_t)cur.pm * tstep; const char* cB = (const char*)g.Bt + (size_t)cur.pn * tstep;
    S.a_ready(cur);
    if constexpr (SP2) {
        PG8_STAGE(PG8_SB(0, 0), cB, voffB); PG8_STAGE(PG8_SB(0, 1), cB + hstep, voffB); PG8_STAGE(PG8_SA(0, 0), cA, voffA); PG8_STAGE(PG8_SA(0, 1), cA + hstep, voffA);
        PG8_STAGE(PG8_SB(1, 0), cB + kstep, voffB); PG8_STAGE(PG8_SA(1, 0), cA + kstep, voffA); PG8_STAGE(PG8_SB(1, 1), cB + hstep + kstep, voffB);
        PG8_WAIT_V(0); PG8_WAIT_L(0); PG8_BAR;
        if (wr == 1) PG8_BAR;
    } else {
        PG8_STAGE(PG8_SB(0, 0), cB, voffB); PG8_STAGE(PG8_SA(0, 0), cA, voffA); PG8_STAGE(PG8_SB(0, 1), cB + hstep, voffB); PG8_STAGE(PG8_SA(0, 1), cA + hstep, voffA);
        if (wr == 1) PG8_BAR;
        PG8_WAIT_V(4); PG8_BAR;
        PG8_STAGE(PG8_SB(1, 0), cB + kstep, voffB); PG8_STAGE(PG8_SA(1, 0), cA + kstep, voffA); PG8_STAGE(PG8_SB(1, 1), cB + hstep + kstep, voffB);
        PG8_WAIT_V(6); PG8_BAR;
    }
    for (;;) {
        const bool has_next = S.next(ui + 1, nxt);
        const char* nA = has_next ? (const char*)g.A + (size_t)nxt.pm * tstep : cA; const char* nB = has_next ? (const char*)g.Bt + (size_t)nxt.pn * tstep : cB;
        for (int t = 0; t < nt; t += 2) {
            const bool last = (t == nt - 2);
            const char* a1 = cA + (size_t)(t + 1) * kstep;
            const char* a2 = last ? nA : cA + (size_t)(t + 2) * kstep; const char* b2 = last ? nB : cB + (size_t)(t + 2) * kstep;
            const char* a3 = a2 + kstep; const char* b3 = b2 + kstep;
            if (last && has_next) S.a_ready(nxt);
            if constexpr (SP2) {
            PG8_LDB(B0, 0, 0); PG8_LDB(B1, 0, 1); PG8_SCHED; PG8_LDA(At, 0, 0); PG8_STAGE(PG8_SA(1, 1), a1 + hstep, voffA);
            PG8_WAIT_V(8); PG8_WAIT_L(0); PG8_BAR; PG8_MMA(0, 0, At, B0); PG8_MMA(0, 1, At, B1); PG8_BAR; PG8_SCHED;
            PG8_LDA(At, 0, 1); PG8_STAGE(PG8_SB(0, 0), b2, voffB); PG8_STAGE(PG8_SB(0, 1), b2 + hstep, voffB); PG8_STAGE(PG8_SA(0, 0), a2, voffA);
            PG8_WAIT_V(8); PG8_WAIT_L(0); PG8_BAR; PG8_MMA(1, 0, At, B0); PG8_MMA(1, 1, At, B1); PG8_BAR; PG8_SCHED;
            PG8_LDB(B0, 1, 0); PG8_LDB(B1, 1, 1); PG8_SCHED; PG8_LDA(At, 1, 0); PG8_STAGE(PG8_SA(0, 1), a2 + hstep, voffA);
            PG8_WAIT_V(8); PG8_WAIT_L(0); PG8_BAR; PG8_MMA(0, 0, At, B0); PG8_MMA(0, 1, At, B1); PG8_BAR; PG8_SCHED;
            PG8_LDA(At, 1, 1); PG8_STAGE(PG8_SB(1, 0), b3, voffB); PG8_STAGE(PG8_SB(1, 1), b3 + hstep, voffB); PG8_STAGE(PG8_SA(1, 0), a3, voffA);
            PG8_WAIT_V(8); PG8_WAIT_L(0); PG8_BAR; PG8_MMA(1, 0, At, B0); PG8_MMA(1, 1, At, B1); PG8_BAR; PG8_SCHED;
            } else {
            PG8_LDB(B0, 0, 0); PG8_SCHED; PG8_LDA(At, 0, 0); PG8_STAGE(PG8_SA(1, 1), a1 + hstep, voffA);
            PG8_WAIT_L(8); PG8_BAR; PG8_WAIT_L(0); PG8_MMA(0, 0, At, B0); PG8_BAR; PG8_SCHED;
            PG8_LDB(B1, 0, 1); PG8_STAGE(PG8_SB(0, 0), b2, voffB);
            PG8_BAR; PG8_WAIT_L(0); PG8_MMA(0, 1, At, B1); PG8_BAR;
            PG8_LDA(At, 0, 1); PG8_STAGE(PG8_SA(0, 0), a2, voffA);
            PG8_BAR; PG8_WAIT_L(0); PG8_MMA(1, 0, At, B0); PG8_BAR; PG8_SCHED;
            PG8_STAGE(PG8_SB(0, 1), b2 + hstep, voffB);
            PG8_WAIT_V(6); PG8_BAR; PG8_MMA(1, 1, At, B1); PG8_BAR;
            PG8_LDB(B0, 1, 0); PG8_SCHED; PG8_LDA(At, 1, 0); PG8_STAGE(PG8_SA(0, 1), a2 + hstep, voffA);
            PG8_WAIT_L(8); PG8_BAR; PG8_WAIT_L(0); PG8_MMA(0, 0, At, B0); PG8_BAR; PG8_SCHED;
            PG8_LDB(B1, 1, 1); PG8_STAGE(PG8_SB(1, 0), b3, voffB);
            PG8_BAR; PG8_WAIT_L(0); PG8_MMA(0, 1, At, B1); PG8_BAR;
            PG8_LDA(At, 1, 1); PG8_STAGE(PG8_SA(1, 0), a3, voffA);
            PG8_BAR; PG8_WAIT_L(0); PG8_MMA(1, 0, At, B0); PG8_BAR; PG8_SCHED;
            PG8_STAGE(PG8_SB(1, 1), b3 + hstep, voffB);
            PG8_WAIT_V(6); PG8_BAR; PG8_MMA(1, 1, At, B1); PG8_BAR;
            }
        }
        if constexpr (ALIGN_EPI) { if (wr == 0) PG8_BAR; }
        if constexpr (!Epi::AFTER_DRAIN) { E(acc, cur, wr, wc, fr, fq); S.done(cur); }
        if (!has_next) break;
#pragma unroll
        for (int a = 0; a < 2; ++a)
#pragma unroll
            for (int b = 0; b < 2; ++b)
#pragma unroll
                for (int m = 0; m < 4; ++m)
#pragma unroll
                    for (int n = 0; n < 2; ++n) acc[a][b][m][n] = (f32x4){0.f, 0.f, 0.f, 0.f};
        cur = nxt; cA = nA; cB = nB; ++ui;
        if constexpr (ALIGN_EPI) { if (wr == 1) PG8_BAR; }
    }
    PG8_WAIT_V(0);
    if constexpr (!ALIGN_EPI) { if (wr == 0) PG8_BAR; }
    PG8_BAR;
    if constexpr (Epi::AFTER_DRAIN) { E.fused(acc, cur, wr, wc, fr, fq, lds, wid, lane); S.done(cur); }
#undef PG8_SA
#undef PG8_SB
#undef PG8_STAGE
#undef PG8_LDA
#undef PG8_LDB
#undef PG8_MMA
#undef PG8_WAIT_V
#undef PG8_WAIT_L
#undef PG8_BAR
#undef PG8_SCHED
}
}
constexpr int SEQ = 16384, NTOK = 32768, DM = 2048, DFF = 5632;
constexpr float EPS = 1e-6f;
#define GAS __attribute__((address_space(1)))
#define LAS __attribute__((address_space(3)))

namespace ep {
using namespace pg8;
typedef float f32x2 __attribute__((ext_vector_type(2)));
__device__ __forceinline__ u32x4 pack8(const f32x4 a, const f32x4 b) { u32x4 w; w.x = cvt_pk_bf16(a[0], a[1]); w.y = cvt_pk_bf16(a[2], a[3]); w.z = cvt_pk_bf16(b[0], b[1]); w.w = cvt_pk_bf16(b[2], b[3]); return w; }
__device__ __forceinline__ float bflo(unsigned u) { return __uint_as_float(u << 16); }
__device__ __forceinline__ float bfhi(unsigned u) { return __uint_as_float(u & 0xffff0000u); }
__device__ __forceinline__ void unpack8(const u32x4 w, f32x4& a, f32x4& b) { a = (f32x4){bflo(w.x), bfhi(w.x), bflo(w.y), bfhi(w.y)}; b = (f32x4){bflo(w.z), bfhi(w.z), bflo(w.w), bfhi(w.w)}; }
__device__ __forceinline__ float sigmoidf_(float x) { return __builtin_amdgcn_rcpf(1.f + __builtin_amdgcn_exp2f(-1.4426950408889634f * x)); }
__device__ __forceinline__ float ssq4(const f32x4 x) { return (x[0] * x[0] + x[1] * x[1]) + (x[2] * x[2] + x[3] * x[3]); }
__device__ __forceinline__ void rope8(f32x4& v0, f32x4& v1, const f32x4 csA, const f32x4 csB) {
    const float a0 = v0[0] * csA[0] - v0[1] * csA[1], b0 = v0[1] * csA[0] + v0[0] * csA[1];
    const float a1 = v0[2] * csA[2] - v0[3] * csA[3], b1 = v0[3] * csA[2] + v0[2] * csA[3];
    const float a2 = v1[0] * csB[0] - v1[1] * csB[1], b2 = v1[1] * csB[0] + v1[0] * csB[1];
    const float a3 = v1[2] * csB[2] - v1[3] * csB[3], b3 = v1[3] * csB[2] + v1[2] * csB[3];
    v0 = (f32x4){a0, b0, a1, b1}; v1 = (f32x4){a2, b2, a3, b3};
}

struct EpiIn {
    static constexpr bool PERM = true, AFTER_DRAIN = false;
    bf16_t *CQ, *CKV, *KR, *QS, *KS, *VS; float *ssqQ, *ssqKV; const float* rope;
    __device__ __forceinline__ void operator()(const f32x4 (&acc)[2][2][4][2], const Unit& u, int wr, int wc, int fr, int fq) const {
        const int pn = u.pn, row0 = u.pm * BM + wr * 64 + fr, cw = wc * 32 + 8 * fq;
        if (pn < 3) {
            float* sq = pn < 2 ? ssqQ : ssqKV; const int nslot = pn < 2 ? 8 : 4, slot = (pn < 2 ? pn * 4 : 0) + wc, ldc = pn < 2 ? 512 : 256;
            bf16_t* base = pn < 2 ? CQ + pn * 256 : CKV;
#pragma unroll
            for (int ai = 0; ai < 2; ++ai)
#pragma unroll
                for (int m = 0; m < 4; ++m) { const int row = row0 + ai * HALF + m * 16;
                    float s = (ssq4(acc[ai][0][m][0]) + ssq4(acc[ai][0][m][1])) + (ssq4(acc[ai][1][m][0]) + ssq4(acc[ai][1][m][1]));
                    s += __shfl_xor(s, 16); s += __shfl_xor(s, 32);
                    if (fq == 0) sq[(size_t)row * nslot + slot] = s;
#pragma unroll
                    for (int bj = 0; bj < 2; ++bj) *(u32x4*)(base + (size_t)row * ldc + bj * HALF + cw) = pack8(acc[ai][bj][m][0], acc[ai][bj][m][1]); }
        } else if (pn == 3) {
            if (wc < 2) {
#pragma unroll
                for (int ai = 0; ai < 2; ++ai)
#pragma unroll
                    for (int m = 0; m < 4; ++m) { const int row = row0 + ai * HALF + m * 16; const int pos = row & (SEQ - 1);
                        const float* cs = rope + ((size_t)pos * 32 + 16 * wc + 4 * fq) * 2;
                        const f32x4 csA = *(const f32x4*)cs, csB = *(const f32x4*)(cs + 4);
                        f32x4 v0 = acc[ai][0][m][0], v1 = acc[ai][0][m][1]; rope8(v0, v1, csA, csB);
                        *(u32x4*)(KR + (size_t)row * 64 + cw) = pack8(v0, v1); }
            }
        } else if (pn < 14) {
            bf16_t* base; int ldc;
            if (pn < 12) { base = QS + (pn - 4) * 256; ldc = 2048; } else if (pn == 12) { base = KS; ldc = 256; } else { base = VS; ldc = 256; }
#pragma unroll
            for (int ai = 0; ai < 2; ++ai)
#pragma unroll
                for (int m = 0; m < 4; ++m) { const int row = row0 + ai * HALF + m * 16;
#pragma unroll
                    for (int bj = 0; bj < 2; ++bj) *(u32x4*)(base + (size_t)row * ldc + bj * HALF + cw) = pack8(acc[ai][bj][m][0], acc[ai][bj][m][1]); }
        }
    }
};

struct EpiSig {
    static constexpr bool PERM = true, AFTER_DRAIN = false;
    bf16_t* GT;
    __device__ __forceinline__ void operator()(const f32x4 (&acc)[2][2][4][2], const Unit& u, int wr, int wc, int fr, int fq) const {
        const int row0 = u.pm * BM + wr * 64 + fr, cw = wc * 32 + 8 * fq; bf16_t* base = GT + u.pn * 256;
#pragma unroll
        for (int ai = 0; ai < 2; ++ai)
#pragma unroll
            for (int m = 0; m < 4; ++m) { const int row = row0 + ai * HALF + m * 16;
#pragma unroll
                for (int bj = 0; bj < 2; ++bj) { f32x4 v0 = acc[ai][bj][m][0], v1 = acc[ai][bj][m][1];
#pragma unroll
                    for (int e = 0; e < 4; ++e) { v0[e] = sigmoidf_(v0[e]); v1[e] = sigmoidf_(v1[e]); }
                    *(u32x4*)(base + (size_t)row * 4096 + bj * HALF + cw) = pack8(v0, v1); } }
    }
};

struct EpiUp {
    static constexpr bool PERM = true, AFTER_DRAIN = false;
    const float* ssq; int nslot; float invK; bf16_t* O0; bf16_t* O1; int ld0, ld1, split; int rope1; const float* rope;
    __device__ __forceinline__ void operator()(const f32x4 (&acc)[2][2][4][2], const Unit& u, int wr, int wc, int fr, int fq) const {
        const int pn = u.pn, row0 = u.pm * BM + wr * 64 + fr, cw = wc * 32 + 8 * fq;
        const int t = pn < split ? 0 : 1; bf16_t* base = t ? O1 + (pn - split) * 256 : O0 + pn * 256; const int ld = t ? ld1 : ld0;
        const bool dorope = (t == 1) && rope1;
#pragma unroll
        for (int ai = 0; ai < 2; ++ai)
#pragma unroll
            for (int m = 0; m < 4; ++m) { const int row = row0 + ai * HALF + m * 16;
                float s;
                if (nslot == 8) { const f32x4 a = *(const f32x4*)(ssq + (size_t)row * 8), b = *(const f32x4*)(ssq + (size_t)row * 8 + 4); s = ((a[0] + a[1]) + (a[2] + a[3])) + ((b[0] + b[1]) + (b[2] + b[3])); }
                else { const f32x4 a = *(const f32x4*)(ssq + (size_t)row * 4); s = (a[0] + a[1]) + (a[2] + a[3]); }
                const float rs = 1.0f / sqrtf(s * invK + EPS);
                f32x4 csA = {1.f, 0.f, 1.f, 0.f}, csB = {1.f, 0.f, 1.f, 0.f};
                if (dorope) { const int pos = row & (SEQ - 1); const float* cs = rope + ((size_t)pos * 32 + 16 * (wc & 1) + 4 * fq) * 2; csA = *(const f32x4*)cs; csB = *(const f32x4*)(cs + 4); }
#pragma unroll
                for (int bj = 0; bj < 2; ++bj) { f32x4 v0 = acc[ai][bj][m][0] * rs, v1 = acc[ai][bj][m][1] * rs;
                    if (dorope) rope8(v0, v1, csA, csB);
                    *(u32x4*)(base + (size_t)row * ld + bj * HALF + cw) = pack8(v0, v1); } }
    }
};

template <bool SECOND> struct EpiGate {
    static constexpr bool PERM = true, AFTER_DRAIN = false;
    const bf16_t* GT; bf16_t* MG;
    __device__ __forceinline__ void operator()(const f32x4 (&acc)[2][2][4][2], const Unit& u, int wr, int wc, int fr, int fq) const {
        const int row0 = u.pm * BM + wr * 64 + fr, col0 = u.pn * BM + wc * 32 + 8 * fq;
#pragma unroll
        for (int ai = 0; ai < 2; ++ai)
#pragma unroll
            for (int m = 0; m < 4; ++m) { const int row = row0 + ai * HALF + m * 16;
#pragma unroll
                for (int bj = 0; bj < 2; ++bj) { const int col = col0 + bj * HALF;
                    const u32x4 gw = *(const u32x4*)(GT + (size_t)row * 4096 + (SECOND ? 2048 : 0) + col); f32x4 g0, g1; unpack8(gw, g0, g1);
                    f32x4 v0 = acc[ai][bj][m][0] * g0, v1 = acc[ai][bj][m][1] * g1;
                    bf16_t* p = MG + (size_t)row * DM + col;
                    if (SECOND) { const u32x4 pw = *(const u32x4*)p; f32x4 p0, p1; unpack8(pw, p0, p1); v0 += p0; v1 += p1; }
                    *(u32x4*)p = pack8(v0, v1); } }
    }
};

struct EpiBfSsq {
    static constexpr bool PERM = true, AFTER_DRAIN = false;
    bf16_t* Y; float* ssq;
    __device__ __forceinline__ void operator()(const f32x4 (&acc)[2][2][4][2], const Unit& u, int wr, int wc, int fr, int fq) const {
        const int row0 = u.pm * BM + wr * 64 + fr, col0 = u.pn * BM + wc * 32 + 8 * fq;
#pragma unroll
        for (int ai = 0; ai < 2; ++ai)
#pragma unroll
            for (int m = 0; m < 4; ++m) { const int row = row0 + ai * HALF + m * 16;
                float s = (ssq4(acc[ai][0][m][0]) + ssq4(acc[ai][0][m][1])) + (ssq4(acc[ai][1][m][0]) + ssq4(acc[ai][1][m][1]));
                s += __shfl_xor(s, 16); s += __shfl_xor(s, 32);
                if (fq == 0) ssq[(size_t)row * 32 + u.pn * 4 + wc] = s;
#pragma unroll
                for (int bj = 0; bj < 2; ++bj) *(u32x4*)(Y + (size_t)row * DM + col0 + bj * HALF) = pack8(acc[ai][bj][m][0], acc[ai][bj][m][1]); }
    }
};

struct EpiFfn {
    static constexpr bool PERM = true, AFTER_DRAIN = false;
    bf16_t* G; float* AH; float* BH; const float* cw; const float* cb;
    __device__ __forceinline__ void operator()(const f32x4 (&acc)[2][2][4][2], const Unit& u, int wr, int wc, int fr, int fq) const {
        const int lane = threadIdx.x & 63;
        const int f0 = u.pn * 128 + wc * 32 + 8 * fq;
        f32x4 w0[2], w1[2], w2[2], bb[2];
#pragma unroll
        for (int n = 0; n < 2; ++n) { w0[n] = *(const f32x4*)(cw + f0 + 4 * n); w1[n] = *(const f32x4*)(cw + DFF + f0 + 4 * n); w2[n] = *(const f32x4*)(cw + 2 * DFF + f0 + 4 * n); bb[n] = *(const f32x4*)(cb + f0 + 4 * n); }
        const int src1 = (lane & 48) | ((fr - 1) & 15), src2 = (lane & 48) | ((fr - 2) & 15);
#pragma unroll
        for (int ai = 0; ai < 2; ++ai) {
            const int jb = u.pm * 4 + ai * 2 + wr;
            f32x4 p1[2], p2[2];
#pragma unroll
            for (int n = 0; n < 2; ++n) { p1[n] = (f32x4){0.f, 0.f, 0.f, 0.f}; p2[n] = p1[n]; }
#pragma unroll
            for (int m = 0; m < 4; ++m) {
                f32x4 o[2];
#pragma unroll
                for (int n = 0; n < 2; ++n) { f32x4 r1, r2;
#pragma unroll
                    for (int e = 0; e < 4; ++e) { const float a0 = acc[ai][0][m][n][e]; r1[e] = __shfl(a0, src1); r2[e] = __shfl(a0, src2); }
                    f32x4 a1, a2;
#pragma unroll
                    for (int e = 0; e < 4; ++e) { a1[e] = fr >= 1 ? r1[e] : p1[n][e]; a2[e] = fr >= 2 ? r2[e] : p2[n][e]; }
                    p1[n] = r1; p2[n] = r2;
                    const f32x4 c = bb[n] + w0[n] * a2 + w1[n] * a1 + w2[n] * acc[ai][0][m][n];
#pragma unroll
                    for (int e = 0; e < 4; ++e) { const float x = c[e]; const float uu = 0.7978845608028654f * (x + 0.044715f * x * x * x);
                        const float gl = x * __builtin_amdgcn_rcpf(1.f + __builtin_amdgcn_exp2f(-2.885390081777927f * uu)); o[n][e] = gl * acc[ai][1][m][n][e]; } }
                const int row = u.pm * BM + ai * HALF + wr * 64 + m * 16 + fr;
                if (!(m == 0 && fr < 2)) *(u32x4*)(G + (size_t)row * DFF + f0) = pack8(o[0], o[1]);
                if (m == 0 && fr < 2) { float* ah = AH + ((size_t)jb * 4 + 2 + fr) * DFF + f0; *(f32x4*)ah = acc[ai][0][0][0]; *(f32x4*)(ah + 4) = acc[ai][0][0][1];
                    float* bh = BH + ((size_t)jb * 2 + fr) * DFF + f0; *(f32x4*)bh = acc[ai][1][0][0]; *(f32x4*)(bh + 4) = acc[ai][1][0][1]; }
                if (m == 3 && fr >= 14) { float* ah = AH + ((size_t)jb * 4 + (fr - 14)) * DFF + f0; *(f32x4*)ah = acc[ai][0][3][0]; *(f32x4*)(ah + 4) = acc[ai][0][3][1]; }
            }
        }
    }
};
}
namespace att {
typedef short bf16x8 __attribute__((ext_vector_type(8)));
typedef short s16x4 __attribute__((ext_vector_type(4)));
typedef float f32x16 __attribute__((ext_vector_type(16)));
typedef float f32x4 __attribute__((ext_vector_type(4)));
typedef unsigned u32x4 __attribute__((ext_vector_type(4)));
typedef unsigned short bf16_t;
#define SBAR() __builtin_amdgcn_sched_barrier(0)
#define KSWZ(row, colB) ((row) * 256 + ((colB) ^ (((row) & 7) << 4)))
#define KSWZ64(row, chunk) ((row) * 128 + ((((chunk) ^ ((row) & 7))) << 4))
template <int NCB> __device__ __forceinline__ int v_st(int k, int c) { const int kk = (k & ~0xC) | ((k & 4) << 1) | ((k & 8) >> 1); return ((kk >> 3) * NCB + (c >> 5)) * 512 + ((kk & 7) * 32 + (c & 31)) * 2; }
__device__ __forceinline__ int v_rd_base(int lane) { return ((lane & 3) << 3) | (((lane >> 2) & 3) << 6) | (((lane >> 4) & 1) << 5) | (((lane >> 5) & 1) << 8); }
__device__ __forceinline__ int crow(int r, int hi) { return (r & 3) + 8 * (r >> 2) + 4 * hi; }
typedef float f32x2_cv __attribute__((ext_vector_type(2))); typedef __bf16 bf16x2_cv __attribute__((ext_vector_type(2)));
__device__ __forceinline__ unsigned cvtpk(float lo, float hi) { f32x2_cv v = {lo, hi}; bf16x2_cv b = __builtin_convertvector(v, bf16x2_cv); return __builtin_bit_cast(unsigned, b); }
__device__ __forceinline__ void mask_tile(f32x16& p0, f32x16& p1, int dq, unsigned W) {
    const float NEG = -__builtin_inff();
#pragma unroll
    for (int r = 0; r < 16; ++r) { const int c = (r & 3) + 8 * (r >> 2);
        if ((unsigned)(dq - c) >= W) p0[r] = NEG;
        if ((unsigned)(dq - c - 32) >= W) p1[r] = NEG; }
}
constexpr float THR = 8.f;
template <int SCALE_E6> __device__ __forceinline__ void partialSM(f32x16& p0, f32x16& p1, float& m_reg, float& mn, float& alpha) {
    constexpr float SCALE = SCALE_E6 * 1e-9f; constexpr float C2 = 1.4426950408889634f * SCALE;
    float pmax = p0[0];
#pragma unroll
    for (int r = 1; r < 16; ++r) pmax = fmaxf(pmax, p0[r]);
#pragma unroll
    for (int r = 0; r < 16; ++r) pmax = fmaxf(pmax, p1[r]);
    { auto rr = __builtin_amdgcn_permlane32_swap(__float_as_uint(pmax), __float_as_uint(pmax), false, false);
      pmax = fmaxf(__uint_as_float(rr[0]), __uint_as_float(rr[1])); }
    if (__builtin_expect(__all((pmax - m_reg) * SCALE <= THR), 1)) { mn = m_reg; alpha = 1.f; }
    else { mn = fmaxf(m_reg, pmax); alpha = __builtin_amdgcn_exp2f((m_reg - mn) * C2); m_reg = mn; }
    const float mnL = -mn * C2;
#pragma unroll
    for (int r = 0; r < 16; ++r) p0[r] = fmaf(p0[r], C2, mnL);
#pragma unroll
    for (int r = 0; r < 16; ++r) p1[r] = fmaf(p1[r], C2, mnL);
#pragma unroll
    for (int r = 0; r < 16; ++r) p0[r] = __builtin_amdgcn_exp2f(p0[r]);
}
__device__ __forceinline__ void finishSM(f32x16& p0, f32x16& p1, float alpha, float& l_reg, bf16x8& pa0, bf16x8& pa1, bf16x8& pa2, bf16x8& pa3) {
#pragma unroll
    for (int r = 0; r < 16; ++r) p1[r] = __builtin_amdgcn_exp2f(p1[r]);
    float ps = 0;
#pragma unroll
    for (int r = 0; r < 16; ++r) ps += p0[r];
#pragma unroll
    for (int r = 0; r < 16; ++r) ps += p1[r];
    { auto rr = __builtin_amdgcn_permlane32_swap(__float_as_uint(ps), __float_as_uint(ps), false, false);
      ps = __uint_as_float(rr[0]) + __uint_as_float(rr[1]); }
    l_reg = l_reg * alpha + ps;
#define PK4(P, B_, OUT) do { unsigned a0 = cvtpk(P[B_+0], P[B_+1]), a1 = cvtpk(P[B_+2], P[B_+3]);                          \
        unsigned b0 = cvtpk(P[B_+4], P[B_+5]), b1 = cvtpk(P[B_+6], P[B_+7]);                                             \
        auto r0 = __builtin_amdgcn_permlane32_swap(a0, b0, false, false); auto r1 = __builtin_amdgcn_permlane32_swap(a1, b1, false, false); \
        u32x4 w = {r0[0], r1[0], r0[1], r1[1]}; OUT = *reinterpret_cast<bf16x8*>(&w); } while (0)
    PK4(p0, 0, pa0); PK4(p0, 8, pa1); PK4(p1, 0, pa2); PK4(p1, 8, pa3);
#undef PK4
}
__device__ __forceinline__ void qk128(f32x16& p0, f32x16& p1, const LAS char* kl, int r32, int hi, const bf16x8* qr) {
    const LAS char* kb[4];
#pragma unroll
    for (int dd = 0; dd < 4; ++dd) kb[dd] = kl + KSWZ(r32, (dd * 16 + hi * 8) * 2);
#pragma unroll
    for (int d0 = 0; d0 < 8; ++d0) { const LAS char* a = kb[d0 & 3] + (d0 >> 2) * 128;
        const bf16x8 b0 = *reinterpret_cast<const LAS bf16x8*>(a);
        const bf16x8 b1 = *reinterpret_cast<const LAS bf16x8*>(a + 32 * 256);
        p0 = __builtin_amdgcn_mfma_f32_32x32x16_bf16(b0, qr[d0], p0, 0, 0, 0);
        p1 = __builtin_amdgcn_mfma_f32_32x32x16_bf16(b1, qr[d0], p1, 0, 0, 0); }
}
__device__ __forceinline__ void qk64(f32x16& p0, f32x16& p1, const LAS char* kl, int r32, int hi, const bf16x8* qr) {
#pragma unroll
    for (int ks = 0; ks < 4; ++ks) { const LAS char* a = kl + KSWZ64(r32, 2 * ks + hi);
        const bf16x8 b0 = *reinterpret_cast<const LAS bf16x8*>(a);
        const bf16x8 b1 = *reinterpret_cast<const LAS bf16x8*>(a + 32 * 128);
        p0 = __builtin_amdgcn_mfma_f32_32x32x16_bf16(b0, qr[ks], p0, 0, 0, 0);
        p1 = __builtin_amdgcn_mfma_f32_32x32x16_bf16(b1, qr[ks], p1, 0, 0, 0); }
}
template <int NCB> __device__ __forceinline__ void pv_tile(f32x16* o, int vb, bf16x8 pa0, bf16x8 pa1, bf16x8 pa2, bf16x8 pa3) {
#define TRRD(dst, off) asm volatile("ds_read_b64_tr_b16 %0, %1 offset:%2" : "=&v"(dst) : "v"(vb), "i"(off) : "memory")
    constexpr int KS_ = NCB * 1024;
#define PV_RD(S, d0) do { constexpr int b_ = (d0) * 512; TRRD(S##l0, b_); TRRD(S##h0, b_ + KS_ / 2); TRRD(S##l1, b_ + KS_); TRRD(S##h1, b_ + KS_ + KS_ / 2); TRRD(S##l2, b_ + 2 * KS_); TRRD(S##h2, b_ + 2 * KS_ + KS_ / 2); TRRD(S##l3, b_ + 3 * KS_); TRRD(S##h3, b_ + 3 * KS_ + KS_ / 2); } while (0)
#define PV_MM(S, d0) do { \
        o[d0] = __builtin_amdgcn_mfma_f32_32x32x16_bf16(pa0, (bf16x8){S##l0[0], S##l0[1], S##l0[2], S##l0[3], S##h0[0], S##h0[1], S##h0[2], S##h0[3]}, o[d0], 0, 0, 0);   \
        o[d0] = __builtin_amdgcn_mfma_f32_32x32x16_bf16(pa1, (bf16x8){S##l1[0], S##l1[1], S##l1[2], S##l1[3], S##h1[0], S##h1[1], S##h1[2], S##h1[3]}, o[d0], 0, 0, 0);   \
        o[d0] = __builtin_amdgcn_mfma_f32_32x32x16_bf16(pa2, (bf16x8){S##l2[0], S##l2[1], S##l2[2], S##l2[3], S##h2[0], S##h2[1], S##h2[2], S##h2[3]}, o[d0], 0, 0, 0);   \
        o[d0] = __builtin_amdgcn_mfma_f32_32x32x16_bf16(pa3, (bf16x8){S##l3[0], S##l3[1], S##l3[2], S##l3[3], S##h3[0], S##h3[1], S##h3[2], S##h3[3]}, o[d0], 0, 0, 0); } while (0)
#define WL(n) do { asm volatile("s_waitcnt lgkmcnt(" #n ")" ::: "memory"); SBAR(); } while (0)
    s16x4 Al0, Al1, Al2, Al3, Ah0, Ah1, Ah2, Ah3, Bl0, Bl1, Bl2, Bl3, Bh0, Bh1, Bh2, Bh3;
    PV_RD(A, 0); PV_RD(B, 1); WL(8); PV_MM(A, 0);
    if constexpr (NCB == 4) { PV_RD(A, 2); WL(8); PV_MM(B, 1); PV_RD(B, 3); WL(8); PV_MM(A, 2); WL(0); PV_MM(B, 3); }
    else { WL(0); PV_MM(B, 1); }
#undef WL
#undef PV_MM
#undef PV_RD
#undef TRRD
}

struct AttnP {
    bf16_t* QN; const bf16_t* QR; const bf16_t* KN; const bf16_t* KR; const bf16_t* V;
    bf16_t* QS; const bf16_t* KS; const bf16_t* VS;
    const float* sinks; const float* rel;
};
__device__ const unsigned char T5B[128] = {0, 1, 2, 3, 4, 5, 6, 7, 8, 9, 10, 11, 12, 13, 14, 15, 16, 16, 16, 17, 17, 18, 18, 18, 19, 19, 19, 20, 20, 20, 20, 21, 21, 21, 21, 22, 22, 22, 22, 22, 23, 23, 23, 23, 23, 23, 24, 24, 24, 24, 24, 24, 25, 25, 25, 25, 25, 25, 25, 26, 26, 26, 26, 26, 26, 26, 26, 27, 27, 27, 27, 27, 27, 27, 27, 27, 27, 28, 28, 28, 28, 28, 28, 28, 28, 28, 28, 29, 29, 29, 29, 29, 29, 29, 29, 29, 29, 29, 29, 30, 30, 30, 30, 30, 30, 30, 30, 30, 30, 30, 30, 30, 30, 31, 31, 31, 31, 31, 31, 31, 31, 31, 31, 31, 31, 31, 31, 31};

template <bool MLA> __device__ __forceinline__ void attn_unit(const AttnP& P, int b, int hh, int qb, LAS char* lds) {
    constexpr int DV = MLA ? 128 : 64, NCB = DV / 32, NQF = MLA ? 12 : 4;
    constexpr int KBYTES = MLA ? 24576 : 8192, VBYTES = 64 * DV * 2;
    constexpr int SC9 = MLA ? 72168784 : 125000000;
    constexpr float SCALE = SC9 * 1e-9f;
    constexpr int W = MLA ? (1 << 30) : 128;
    const int tid = threadIdx.x, wid = __builtin_amdgcn_readfirstlane(tid >> 6), lane = tid & 63, r32 = lane & 31, hi = lane >> 5;
    LAS char* V_lds = lds; LAS char* K_lds = lds + 2 * VBYTES;
    LAS float* ws = (LAS float*)(lds + 2 * VBYTES + 2 * KBYTES) + wid * 64; LAS float* li_l = ws; LAS float* al_l = ws + 32;
    LAS float* bias_l = (LAS float*)(lds + 2 * VBYTES + 2 * KBYTES + 2048);
    const int q0 = qb * 256; const size_t rowbase = (size_t)b * SEQ;
    const int jt0 = MLA ? 0 : (q0 == 0 ? 0 : -2);
    const int NT = MLA ? 4 * qb + 4 : 4 - jt0;
    const int kbase0 = MLA ? 0 : q0 + 64 * jt0;
    const int qlo = q0 + wid * 32, qm = qlo + r32 - 4 * hi;
    bf16x8 qr[NQF];
    const size_t qrow = rowbase + qlo + r32;
    if constexpr (MLA) {
#pragma unroll
        for (int d0 = 0; d0 < 8; ++d0) qr[d0] = *(const bf16x8*)(P.QN + qrow * 2048 + hh * 128 + d0 * 16 + hi * 8);
#pragma unroll
        for (int d0 = 0; d0 < 4; ++d0) qr[8 + d0] = *(const bf16x8*)(P.QR + qrow * 1024 + hh * 64 + d0 * 16 + hi * 8);
    } else {
#pragma unroll
        for (int d0 = 0; d0 < 4; ++d0) qr[d0] = *(const bf16x8*)(P.QS + qrow * 2048 + hh * 64 + d0 * 16 + hi * 8);
        if (tid < 128) bias_l[tid] = P.rel[(int)T5B[tid] * 32 + hh] * (1.0f / SCALE);
    }
    bf16x8 sk0, sv0;
    const int sr8 = tid >> 3, ch8 = tid & 7;
    const bf16_t* Kg; const bf16_t* Vg; const bf16_t* Rg = nullptr;
    unsigned okA = 0, okB = 0, orp = 0, ovA = 0, ovB = 0;
    if constexpr (MLA) {
        Kg = P.KN + rowbase * 2048 + hh * 128; Vg = P.V + rowbase * 2048 + hh * 128; Rg = P.KR + rowbase * 64;
        { const int rA = 4 * wid + (lane >> 4), rB = rA + 32, cp = lane & 15; okA = (unsigned)(rA * 2048 + ((cp ^ (rA & 7)) << 3)); okB = (unsigned)(rB * 2048 + ((cp ^ (rB & 7)) << 3)); }
        { const int rr = 8 * wid + (lane >> 3), cp = lane & 7; orp = (unsigned)(rr * 64 + ((cp ^ (rr & 7)) << 3)); }
        { const int stA = 2 * wid + (lane >> 5), stB = stA + 16; const int kl = (lane & 31) >> 2, c8 = 8 * (lane & 3);
          const int kkA = (stA >> 2) * 8 + kl, kkB = (stB >> 2) * 8 + kl;
          const int kA = (kkA & ~0xC) | ((kkA & 4) << 1) | ((kkA & 8) >> 1), kB = (kkB & ~0xC) | ((kkB & 4) << 1) | ((kkB & 8) >> 1);
          ovA = (unsigned)(kA * 2048 + 32 * (stA & 3) + c8); ovB = (unsigned)(kB * 2048 + 32 * (stB & 3) + c8); }
    } else { Kg = P.KS + (rowbase + sr8) * 256 + (hh >> 3) * 64 + ch8 * 8; Vg = P.VS + (rowbase + sr8) * 256 + (hh >> 3) * 64 + ch8 * 8; }
    const int kws = KSWZ64(sr8, ch8), vst0 = v_st<NCB>(sr8, ch8 * 8);
#define GLDS(gp, lp) __builtin_amdgcn_global_load_lds((const unsigned*)(gp), (LAS unsigned*)(lp), 16, 0, 0)
#define LOADT(t, bf) do { const size_t k0_ = (size_t)(kbase0 + 64 * (t)); \
        if constexpr (MLA) { LAS char* kd_ = K_lds + (bf) * KBYTES + wid * 1024; LAS char* vd_ = V_lds + (bf) * VBYTES + wid * 1024; \
            const bf16_t* kp_ = Kg + k0_ * 2048; const bf16_t* vp_ = Vg + k0_ * 2048; const bf16_t* rp_ = Rg + k0_ * 64; \
            GLDS(kp_ + okA, kd_); GLDS(kp_ + okB, kd_ + 8192); GLDS(rp_ + orp, kd_ + 16384); GLDS(vp_ + ovA, vd_); GLDS(vp_ + ovB, vd_ + 8192); } \
        else { sk0 = *(const bf16x8*)(Kg + k0_ * 256); sv0 = *(const bf16x8*)(Vg + k0_ * 256); } } while (0)
#define WRITET(bf) do { if constexpr (!MLA) { *(LAS bf16x8*)(K_lds + (bf) * KBYTES + kws) = sk0; *(LAS bf16x8*)(V_lds + (bf) * VBYTES + vst0) = sv0; } } while (0)
    float m_reg = MLA ? -1e30f : P.sinks[hh] * (1.0f / SCALE), l_reg = MLA ? 0.f : 1.f;
    f32x16 o[NCB];
#pragma unroll
    for (int d = 0; d < NCB; ++d) o[d] = f32x16{};
    const int vb0 = (int)(uintptr_t)V_lds + v_rd_base(lane);
    LOADT(0, 0); asm volatile("s_waitcnt vmcnt(0)" ::: "memory"); WRITET(0); __syncthreads();
    for (int t = 0; t < NT; ++t) {
        const int buf = t & 1;
        if (t + 1 < NT) LOADT(t + 1, buf ^ 1);
        const int kb = kbase0 + 64 * t;
        const bool act = (kb <= qlo + 31) && (MLA || kb + 63 >= qlo - (W - 1));
        if (act) {
            f32x16 p0 = f32x16{}, p1 = f32x16{};
            if constexpr (MLA) { qk128(p0, p1, K_lds + buf * KBYTES, r32, hi, qr); qk64(p0, p1, K_lds + buf * KBYTES + 16384, r32, hi, qr + 8); }
            else { qk64(p0, p1, K_lds + buf * KBYTES, r32, hi, qr); }
            const int dq = qm - kb;
            if constexpr (!MLA) {
#pragma unroll
                for (int r = 0; r < 16; ++r) { const int c = (r & 3) + 8 * (r >> 2); p0[r] += bias_l[(dq - c) & 127]; p1[r] += bias_l[(dq - c - 32) & 127]; }
            }
            if (kb + 63 > qlo || (!MLA && kb <= qlo + 31 - W)) mask_tile(p0, p1, dq, (unsigned)W);
            float mn, alpha; bf16x8 pa0, pa1, pa2, pa3;
            partialSM<SC9>(p0, p1, m_reg, mn, alpha);
            finishSM(p0, p1, alpha, l_reg, pa0, pa1, pa2, pa3);
            if (__any(alpha < 1.f)) { if (hi == 0) al_l[r32] = alpha; asm volatile("s_waitcnt lgkmcnt(0)" ::: "memory");
#pragma unroll
                for (int d_ = 0; d_ < NCB; ++d_)
#pragma unroll
                    for (int r = 0; r < 16; ++r) o[d_][r] *= al_l[crow(r, hi)]; }
            SBAR();
            pv_tile<NCB>(o, vb0 + buf * VBYTES, pa0, pa1, pa2, pa3);
        }
        if (t + 1 < NT) { asm volatile("s_waitcnt vmcnt(0)" ::: "memory"); WRITET(buf ^ 1); }
        __syncthreads();
    }
    if (hi == 0) li_l[r32] = l_reg; asm volatile("s_waitcnt lgkmcnt(0)" ::: "memory");
    bf16_t* Ow = (MLA ? P.QN + (rowbase + qlo) * 2048 + hh * 128 : P.QS + (rowbase + qlo) * 2048 + hh * 64);
#pragma unroll
    for (int r = 0; r < 16; ++r) { const int orow = crow(r, hi); const float rl = __builtin_amdgcn_rcpf(li_l[orow]);
#pragma unroll
        for (int d0 = 0; d0 < NCB; ++d0) { const float v = o[d0][r] * rl; const float vn = __shfl_xor(v, 1);
            if ((r32 & 1) == 0) *(unsigned*)(Ow + (size_t)orow * 2048 + d0 * 32 + r32) = cvtpk(v, vn); } }
    __syncthreads();
#undef LOADT
#undef WRITET
#undef GLDS
}
#undef SBAR
}
typedef unsigned short bf16;
typedef unsigned v4u __attribute__((ext_vector_type(4)));
typedef float f32x4 __attribute__((ext_vector_type(4)));
constexpr size_t MiB = 1u << 20;
constexpr size_t WS_WIN = 1 * MiB, WS_WQ = 31 * MiB, WS_WKV = 34 * MiB, WS_WOA = 36 * MiB, WS_WOB = 44 * MiB, WS_WOUT = 52 * MiB, WS_WUP = 60 * MiB, WS_WDN = 104 * MiB;
constexpr size_t WS_ROPE = 126 * MiB;
constexpr size_t WS_SSQQ = 130 * MiB, WS_SSQKV = 131 * MiB, WS_SSQY = 132 * MiB, WS_SSQY2 = 136 * MiB;
constexpr size_t WS_XN = 140 * MiB;
constexpr size_t WS_CQ = 268 * MiB, WS_CKV = 300 * MiB, WS_KR = 316 * MiB, WS_KS = 320 * MiB, WS_VS = 336 * MiB, WS_QS = 352 * MiB;
constexpr size_t WS_QN = 480 * MiB, WS_QR = 608 * MiB, WS_KN = 672 * MiB, WS_V = 800 * MiB;
constexpr size_t WS_GT = 608 * MiB, WS_MG = 864 * MiB;
constexpr size_t WS_Y = 140 * MiB, WS_X1 = 768 * MiB, WS_H2 = 640 * MiB;
constexpr size_t WS_G = 140 * MiB, WS_AH = 492 * MiB, WS_BH = 536 * MiB;
constexpr size_t WS_Y2 = 640 * MiB, WS_END = 1024 * MiB;

struct Args {
    const float *x, *g_mix_pre, *g_mix_post, *g_ffn_pre, *g_ffn_post, *w_in, *q_norm, *w_q_up, *kv_norm, *w_kv_up, *sinks, *rel, *w_o_mla, *w_o_swa, *w_out, *w_up, *conv_w, *conv_b, *w_down;
    float* out; unsigned char* ws; int ph_lo, ph_hi;
};

__device__ __forceinline__ unsigned f2bf(float f) { unsigned u = __builtin_bit_cast(unsigned, f); return (u + 0x7fffu + ((u >> 16) & 1u)) >> 16; }
__device__ __forceinline__ unsigned pk2(float lo, float hi) { return f2bf(lo) | (f2bf(hi) << 16); }
__device__ __forceinline__ float wave_sum(float v) {
#pragma unroll
    for (int o = 1; o < 64; o <<= 1) v += __shfl_xor(v, o);
    return v;
}
__device__ __forceinline__ void tr_item(const float* W, int K, int Nsrc, int k0, int nsrc0, bf16* WT, int drow0, int dstride, const float* gain, LAS float* scr, int lane) {
#pragma unroll 8
    for (int i = 0; i < 32; ++i) { const int kk = 2 * i + (lane >> 5); float v = W[(size_t)(k0 + kk) * Nsrc + nsrc0 + (lane & 31)]; if (gain) v *= gain[k0 + kk]; scr[kk * 33 + (lane & 31)] = v; }
    asm volatile("s_waitcnt lgkmcnt(0)" ::: "memory");
    const int c = lane & 7;
#pragma unroll
    for (int j = 0; j < 4; ++j) { const int n = (lane >> 3) + 8 * j; const LAS float* s = scr + (8 * c) * 33 + n;
        v4u o; o.x = pk2(s[0 * 33], s[1 * 33]); o.y = pk2(s[2 * 33], s[3 * 33]); o.z = pk2(s[4 * 33], s[5 * 33]); o.w = pk2(s[6 * 33], s[7 * 33]);
        *(v4u*)(WT + (size_t)(drow0 + n * dstride) * K + k0 + 8 * c) = o; }
    asm volatile("s_waitcnt lgkmcnt(0)" ::: "memory");
}

__global__ void __launch_bounds__(512) fwd_mega(Args a) {
    extern __shared__ __attribute__((aligned(16))) unsigned char lds_raw[];
    LAS unsigned char* lds = (LAS unsigned char*)lds_raw;
    cg::grid_group grid = cg::this_grid();
    const int tid = threadIdx.x, lane = tid & 63, wave = __builtin_amdgcn_readfirstlane(tid >> 6);
    const int G = gridDim.x, bx = blockIdx.x;
    const int vcu = (G % 8 == 0) ? (bx % 8) * (G / 8) + bx / 8 : bx;
    unsigned char* ws = a.ws;
    bf16 *Win_t = (bf16*)(ws + WS_WIN), *Wq_t = (bf16*)(ws + WS_WQ), *Wkv_t = (bf16*)(ws + WS_WKV), *WoA_t = (bf16*)(ws + WS_WOA), *WoB_t = (bf16*)(ws + WS_WOB),
         *Wout_t = (bf16*)(ws + WS_WOUT), *Wup_t = (bf16*)(ws + WS_WUP), *Wdn_t = (bf16*)(ws + WS_WDN);
    float* rope = (float*)(ws + WS_ROPE);
    float *ssqQ = (float*)(ws + WS_SSQQ), *ssqKV = (float*)(ws + WS_SSQKV), *ssqY = (float*)(ws + WS_SSQY), *ssqY2 = (float*)(ws + WS_SSQY2);
    bf16 *XN = (bf16*)(ws + WS_XN), *CQ = (bf16*)(ws + WS_CQ), *CKV = (bf16*)(ws + WS_CKV), *KR = (bf16*)(ws + WS_KR), *KS = (bf16*)(ws + WS_KS), *VS = (bf16*)(ws + WS_VS), *QS = (bf16*)(ws + WS_QS);
    bf16 *QN = (bf16*)(ws + WS_QN), *QR = (bf16*)(ws + WS_QR), *KN = (bf16*)(ws + WS_KN), *VV = (bf16*)(ws + WS_V), *MG = (bf16*)(ws + WS_MG), *GG = (bf16*)(ws + WS_G);
    bf16 *GT = (bf16*)(ws + WS_GT), *Y = (bf16*)(ws + WS_Y), *Y2 = (bf16*)(ws + WS_Y2), *H2 = (bf16*)(ws + WS_H2);
    float *X1 = (float*)(ws + WS_X1), *AH = (float*)(ws + WS_AH), *BH = (float*)(ws + WS_BH);
    const int gw = vcu * 8 + wave, NGW = G * 8;
    const int lo = a.ph_lo, hi = a.ph_hi;
#ifndef PHMASK
#define PHMASK 0xFFFF
#endif
#define IN(k) (((PHMASK >> (k)) & 1) && lo <= (k) && (k) < hi)
#define SEAM(k) do { if (IN(k) && IN((k) + 1)) { __threadfence(); grid.sync(); __builtin_amdgcn_fence(__ATOMIC_ACQUIRE, "agent"); asm volatile("s_waitcnt vmcnt(0) lgkmcnt(0)" ::: "memory"); __syncthreads(); } } while (0)

    if (IN(0)) {
        LAS float* scr = (LAS float*)(lds + wave * 16384);
        constexpr int I_IN = 32 * 234, I_Q = 8 * 96, I_KV = 4 * 128, I_O = 32 * 64, I_UP = 32 * 352, I_DN = 88 * 64;
        constexpr int NITEMS = I_IN + I_Q + I_KV + 3 * I_O + I_UP + I_DN;
        for (int it = gw; it < NITEMS; it += NGW) {
            int r = it;
            if (r < I_IN) { const int kb = r / 234, c = (r % 234) * 32; int d0, ds = 1;
                if (c < 768) d0 = c; else if (c < 832) { d0 = 768 + (c - 768) / 32; ds = 2; } else d0 = c + 192;
                tr_item(a.w_in, 2048, 7488, kb * 64, c, Win_t, d0, ds, nullptr, scr, lane); continue; } r -= I_IN;
            if (r < I_Q) { const int kb = r / 96, c = (r % 96) * 32, h = c / 192, w = c % 192; int d0, ds = 1;
                if (w < 128) d0 = 128 * h + w; else { d0 = 2048 + 64 * h + (w - 128) / 32; ds = 2; }
                tr_item(a.w_q_up, 512, 3072, kb * 64, c, Wq_t, d0, ds, a.q_norm, scr, lane); continue; } r -= I_Q;
            if (r < I_KV) { const int kb = r / 128, c = (r % 128) * 32, h = c / 256, w = c % 256;
                const int d0 = w < 128 ? 128 * h + w : 2048 + 128 * h + (w - 128);
                tr_item(a.w_kv_up, 256, 4096, kb * 64, c, Wkv_t, d0, 1, a.kv_norm, scr, lane); continue; } r -= I_KV;
            if (r < 3 * I_O) { const int wsel = r / I_O, q = r % I_O, kb = q / 64, c = (q % 64) * 32;
                tr_item(wsel == 0 ? a.w_o_mla : wsel == 1 ? a.w_o_swa : a.w_out, 2048, 2048, kb * 64, c, wsel == 0 ? WoA_t : wsel == 1 ? WoB_t : Wout_t, c, 1, nullptr, scr, lane); continue; } r -= 3 * I_O;
            if (r < I_UP) { const int kb = r / 352, c = (r % 352) * 32; int d0;
                if (c < DFF) d0 = 256 * (c / 128) + (c % 128); else { const int c2 = c - DFF; d0 = 256 * (c2 / 128) + 128 + (c2 % 128); }
                tr_item(a.w_up, 2048, 11264, kb * 64, c, Wup_t, d0, 1, nullptr, scr, lane); continue; } r -= I_UP;
            { const int kb = r / 64, c = (r % 64) * 32; tr_item(a.w_down, DFF, 2048, kb * 64, c, Wdn_t, c, 1, nullptr, scr, lane); }
        }
        for (int i = bx * 512 + tid; i < 192 * 2048 / 8; i += G * 512) *(v4u*)(Win_t + (size_t)832 * 2048 + (size_t)i * 8) = (v4u){0u, 0u, 0u, 0u};
        for (int i = bx * 512 + tid; i < SEQ * 32; i += G * 512) { const int pos = i >> 5, k = i & 31;
            const float inv = __builtin_amdgcn_exp2f(-(float)(2 * k) * (13.287712379549449f / 64.0f)); const float ang = (float)pos * inv;
            const double rev = (double)ang * 0.15915494309189535; const float fr = (float)(rev - __builtin_rint(rev));
            rope[2 * i] = __builtin_amdgcn_cosf(fr); rope[2 * i + 1] = __builtin_amdgcn_sinf(fr); }
        for (int m = gw; m < NTOK; m += NGW) {
            const f32x4* xr = (const f32x4*)(a.x + (size_t)m * DM) + lane; f32x4 v[8]; float s = 0.f;
#pragma unroll
            for (int j = 0; j < 8; ++j) { v[j] = xr[64 * j]; s += (v[j].x * v[j].x + v[j].y * v[j].y) + (v[j].z * v[j].z + v[j].w * v[j].w); }
            const float rs = 1.0f / sqrtf(wave_sum(s) * (1.f / DM) + EPS);
            unsigned long long* o8 = (unsigned long long*)(XN + (size_t)m * DM) + lane;
#pragma unroll
            for (int j = 0; j < 8; ++j) { const f32x4 g = *((const f32x4*)a.g_mix_pre + lane + 64 * j);
                o8[64 * j] = (unsigned long long)pk2(v[j].x * rs * g.x, v[j].y * rs * g.y) | ((unsigned long long)pk2(v[j].z * rs * g.z, v[j].w * rs * g.w) << 32); }
        }
    }
    SEAM(0);
    if (IN(1)) {
        pg8::Gemm g{XN, Win_t, NTOK, 3584, 2048}; pg8::StaticOrder S; S.init(NTOK, 3584, G, bx);
        ep::EpiIn E{CQ, CKV, KR, QS, KS, VS, ssqQ, ssqKV, rope};
        pg8::gemm_phase<ep::EpiIn, pg8::StaticOrder, true, true>(lds, g, S, E);
    }
    SEAM(1);
    if (IN(2)) {
        { pg8::Gemm g{CQ, Wq_t, NTOK, 3072, 512}; pg8::StaticOrder S; S.init(NTOK, 3072, G, bx);
          ep::EpiUp E{ssqQ, 8, 1.0f / 512.0f, QN, QR, 2048, 1024, 8, 1, rope};
          pg8::gemm_phase<ep::EpiUp, pg8::StaticOrder, true, true>(lds, g, S, E); }
        { pg8::Gemm g{CKV, Wkv_t, NTOK, 4096, 256}; pg8::StaticOrder S; S.init(NTOK, 4096, G, bx);
          ep::EpiUp E{ssqKV, 4, 1.0f / 256.0f, KN, VV, 2048, 2048, 8, 0, rope};
          pg8::gemm_phase<ep::EpiUp, pg8::StaticOrder, true, true>(lds, g, S, E); }
    }
    SEAM(2);
    if (IN(3)) {
        att::AttnP P{QN, QR, KN, KR, VV, QS, KS, VS, a.sinks, a.rel};
#ifndef NO_MLA
        for (int it = vcu; it < 1024; it += G) { const int bh = it >> 5, s = it & 31;
            att::attn_unit<true>(P, bh >> 4, bh & 15, 63 - s, (LAS char*)lds);
            att::attn_unit<true>(P, bh >> 4, bh & 15, s, (LAS char*)lds); }
#endif
#ifndef NO_SWA
        for (int it = vcu; it < 4096; it += G) { const int qb = it & 63, hq = (it >> 6) & 31, b = it >> 11;
            att::attn_unit<false>(P, b, hq, qb, (LAS char*)lds); }
#endif
    }
    SEAM(3);
    if (IN(4)) {
        pg8::Gemm g{XN, Win_t + (size_t)3584 * 2048, NTOK, 4096, 2048}; pg8::StaticOrder S; S.init(NTOK, 4096, G, bx);
        ep::EpiSig E{GT}; pg8::gemm_phase<ep::EpiSig, pg8::StaticOrder, true, true>(lds, g, S, E);
    }
    SEAM(4);
    if (IN(5)) {
        { pg8::Gemm g{QN, WoA_t, NTOK, 2048, 2048}; pg8::StaticOrder S; S.init(NTOK, 2048, G, bx);
          ep::EpiGate<false> E{GT, MG}; pg8::gemm_phase<ep::EpiGate<false>, pg8::StaticOrder, true, true>(lds, g, S, E); }
        { pg8::Gemm g{QS, WoB_t, NTOK, 2048, 2048}; pg8::StaticOrder S; S.init(NTOK, 2048, G, bx);
          ep::EpiGate<true> E{GT, MG}; pg8::gemm_phase<ep::EpiGate<true>, pg8::StaticOrder, true, true>(lds, g, S, E); }
    }
    SEAM(5);
    if (IN(6)) {
        pg8::Gemm g{MG, Wout_t, NTOK, 2048, 2048}; pg8::StaticOrder S; S.init(NTOK, 2048, G, bx);
        ep::EpiBfSsq E{Y, ssqY}; pg8::gemm_phase<ep::EpiBfSsq, pg8::StaticOrder, true, true>(lds, g, S, E);
    }
    SEAM(6);
    if (IN(7)) {
        for (int m = gw; m < NTOK; m += NGW) {
            float sy = ssqY[(size_t)m * 32 + (lane & 31)];
#pragma unroll
            for (int o = 1; o < 32; o <<= 1) sy += __shfl_xor(sy, o);
            const float rsy = 1.0f / sqrtf(sy * (1.f / DM) + EPS);
            const f32x4* xr = (const f32x4*)(a.x + (size_t)m * DM) + lane; const unsigned long long* yr = (const unsigned long long*)(Y + (size_t)m * DM) + lane;
            f32x4* outr = (f32x4*)(X1 + (size_t)m * DM) + lane; f32x4 v[8]; float s = 0.f;
#pragma unroll
            for (int j = 0; j < 8; ++j) { const f32x4 g = *((const f32x4*)a.g_mix_post + lane + 64 * j); const unsigned long long yw = yr[64 * j];
                const f32x4 yv = {__uint_as_float((unsigned)yw << 16), __uint_as_float((unsigned)yw & 0xffff0000u), __uint_as_float((unsigned)(yw >> 32) << 16), __uint_as_float((unsigned)(yw >> 32) & 0xffff0000u)};
                v[j] = xr[64 * j] + yv * rsy * g; outr[64 * j] = v[j];
                s += (v[j].x * v[j].x + v[j].y * v[j].y) + (v[j].z * v[j].z + v[j].w * v[j].w); }
            const float rs = 1.0f / sqrtf(wave_sum(s) * (1.f / DM) + EPS);
            unsigned long long* o8 = (unsigned long long*)(H2 + (size_t)m * DM) + lane;
#pragma unroll
            for (int j = 0; j < 8; ++j) { const f32x4 g = *((const f32x4*)a.g_ffn_pre + lane + 64 * j);
                o8[64 * j] = (unsigned long long)pk2(v[j].x * rs * g.x, v[j].y * rs * g.y) | ((unsigned long long)pk2(v[j].z * rs * g.z, v[j].w * rs * g.w) << 32); }
        }
    }
    SEAM(7);
    if (IN(8)) {
        pg8::Gemm g{H2, Wup_t, NTOK, 11264, 2048}; pg8::StaticOrder S; S.init(NTOK, 11264, G, bx);
        ep::EpiFfn E{GG, AH, BH, a.conv_w, a.conv_b}; pg8::gemm_phase<ep::EpiFfn, pg8::StaticOrder, true, true>(lds, g, S, E);
    }
    SEAM(8);
    if (IN(9)) {
        constexpr int NF4 = DFF / 4;
        for (int i = bx * 512 + tid; i < 1024 * NF4; i += G * 512) { const int f = (i % NF4) * 4, rj = i / NF4, jb = rj >> 1, ii = rj & 1; const bool first = (jb & 255) == 0;
            const f32x4 z = {0.f, 0.f, 0.f, 0.f};
            const f32x4 a0 = *(const f32x4*)(AH + ((size_t)jb * 4 + 2 + ii) * DFF + f);
            const f32x4 pm1 = first ? z : *(const f32x4*)(AH + ((size_t)(jb - 1) * 4 + 1) * DFF + f);
            const f32x4 pm2 = first ? z : *(const f32x4*)(AH + ((size_t)(jb - 1) * 4 + 0) * DFF + f);
            const f32x4 a1 = ii ? *(const f32x4*)(AH + ((size_t)jb * 4 + 2) * DFF + f) : pm1;
            const f32x4 a2 = ii ? pm1 : pm2;
            const f32x4 bv = *(const f32x4*)(BH + ((size_t)jb * 2 + ii) * DFF + f);
            const f32x4 c = *(const f32x4*)(a.conv_b + f) + *(const f32x4*)(a.conv_w + f) * a2 + *(const f32x4*)(a.conv_w + DFF + f) * a1 + *(const f32x4*)(a.conv_w + 2 * DFF + f) * a0;
            float o[4];
#pragma unroll
            for (int e = 0; e < 4; ++e) { const float x = c[e]; const float uu = 0.7978845608028654f * (x + 0.044715f * x * x * x);
                o[e] = x * __builtin_amdgcn_rcpf(1.f + __builtin_amdgcn_exp2f(-2.885390081777927f * uu)) * bv[e]; }
            *(unsigned long long*)(GG + ((size_t)jb * 64 + ii) * DFF + f) = (unsigned long long)pk2(o[0], o[1]) | ((unsigned long long)pk2(o[2], o[3]) << 32); }
    }
    SEAM(9);
    if (IN(10)) {
        pg8::Gemm g{GG, Wdn_t, NTOK, 2048, DFF}; pg8::StaticOrder S; S.init(NTOK, 2048, G, bx);
        ep::EpiBfSsq E{Y2, ssqY2}; pg8::gemm_phase<ep::EpiBfSsq, pg8::StaticOrder, true, true>(lds, g, S, E);
    }
    SEAM(10);
    if (IN(11)) {
        for (int m = gw; m < NTOK; m += NGW) {
            float sy = ssqY2[(size_t)m * 32 + (lane & 31)];
#pragma unroll
            for (int o = 1; o < 32; o <<= 1) sy += __shfl_xor(sy, o);
            const float rsy = 1.0f / sqrtf(sy * (1.f / DM) + EPS);
            const unsigned long long* yr = (const unsigned long long*)(Y2 + (size_t)m * DM) + lane; const f32x4* x1r = (const f32x4*)(X1 + (size_t)m * DM) + lane; f32x4* outr = (f32x4*)(a.out + (size_t)m * DM) + lane;
#pragma unroll
            for (int j = 0; j < 8; ++j) { const f32x4 g = *((const f32x4*)a.g_ffn_post + lane + 64 * j); const unsigned long long yw = yr[64 * j];
                const f32x4 yv = {__uint_as_float((unsigned)yw << 16), __uint_as_float((unsigned)yw & 0xffff0000u), __uint_as_float((unsigned)(yw >> 32) << 16), __uint_as_float((unsigned)(yw >> 32) & 0xffff0000u)};
                outr[64 * j] = x1r[64 * j] + yv * rsy * g; }
        }
    }
#undef IN
#undef SEAM
}

constexpr int LDS_BYTES = 147456;
extern "C" void kernel_launch(void* const* d_in, const int* in_sizes, int n_in, void* d_out, int out_size, void* d_ws, size_t ws_size, hipStream_t stream) {
    static int grid = 0;
    if (grid == 0) {
        if (n_in != 19 || in_sizes[0] != NTOK * DM || out_size != NTOK * DM || ws_size < WS_END) { fprintf(stderr, "kernel_launch: unexpected shapes (n_in %d, in0 %d, out %d, ws %zu)\n", n_in, n_in > 0 ? in_sizes[0] : -1, out_size, ws_size); grid = -1; return; }
        int dev = 0, cus = 0, per_cu = 0;
        hipGetDevice(&dev); hipDeviceGetAttribute(&cus, hipDeviceAttributeMultiprocessorCount, dev);
        if (hipFuncSetAttribute((const void*)fwd_mega, hipFuncAttributeMaxDynamicSharedMemorySize, LDS_BYTES) != hipSuccess) { fprintf(stderr, "kernel_launch: hipFuncSetAttribute failed\n"); grid = -1; return; }
        if (hipOccupancyMaxActiveBlocksPerMultiprocessor(&per_cu, (const void*)fwd_mega, 512, LDS_BYTES) != hipSuccess || per_cu < 1) { fprintf(stderr, "kernel_launch: occupancy query says %d\n", per_cu); per_cu = 1; }
        (void)hipGetLastError();
        grid = cus * 1;
        if (grid % 8 != 0 || grid <= 0) { fprintf(stderr, "kernel_launch: odd CU count %d\n", cus); }
    }
    if (grid < 0) return;
    Args a{};
    a.x = (const float*)d_in[0]; a.g_mix_pre = (const float*)d_in[1]; a.g_mix_post = (const float*)d_in[2]; a.g_ffn_pre = (const float*)d_in[3]; a.g_ffn_post = (const float*)d_in[4];
    a.w_in = (const float*)d_in[5]; a.q_norm = (const float*)d_in[6]; a.w_q_up = (const float*)d_in[7]; a.kv_norm = (const float*)d_in[8]; a.w_kv_up = (const float*)d_in[9];
    a.sinks = (const float*)d_in[10]; a.rel = (const float*)d_in[11]; a.w_o_mla = (const float*)d_in[12]; a.w_o_swa = (const float*)d_in[13]; a.w_out = (const float*)d_in[14];
    a.w_up = (const float*)d_in[15]; a.conv_w = (const float*)d_in[16]; a.conv_b = (const float*)d_in[17]; a.w_down = (const float*)d_in[18];
    a.out = (float*)d_out; a.ws = (unsigned char*)d_ws;
#ifndef NLAUNCH_SPLIT
#define NLAUNCH_SPLIT 0
#endif
    for (int ph = 0; ph < 12; ph += (NLAUNCH_SPLIT ? 1 : 12)) {
        a.ph_lo = ph; a.ph_hi = NLAUNCH_SPLIT ? ph + 1 : 12;
        void* args[] = {&a};
        hipError_t e = hipLaunchCooperativeKernel((const void*)fwd_mega, dim3(grid), dim3(512), args, LDS_BYTES, stream);
        if (e != hipSuccess) fprintf(stderr, "kernel_launch: cooperative launch failed: %s (grid %d)\n", hipGetErrorString(e), grid);
    }
}
```

```cpp
#include <hip/hip_runtime.h>
#include <hip/hip_cooperative_groups.h>
#include <cstdio>
#include <cstdint>
namespace cg = cooperative_groups;
namespace pg8 {
#define PG8_LAS __attribute__((address_space(3)))
typedef unsigned short bf16_t;
typedef short bf16x8 __attribute__((ext_vector_type(8)));
typedef float f32x4 __attribute__((ext_vector_type(4)));
typedef unsigned u32x4 __attribute__((ext_vector_type(4)));
constexpr int BM = 256, BK = 64, HALF = 128, HTB = HALF * BK * 2  , STAGE_BYTES = 8 * HTB, NXCD = 8, WGM = 8;

__host__ __device__ __forceinline__ int lds_byte(int r, int c) { const int st = (r >> 4) * 2 + (c >> 5), rr = r & 15, cc = c & 31, ob = rr * 64 + cc * 2; return st * 1024 + (ob ^ (((ob >> 9) & 1) << 5)); }
__host__ __device__ __forceinline__ void stage_rc(int b, int& R, int& C) { const int st = b / 1024, sb = b % 1024, swz = sb ^ (((sb >> 9) & 1) << 5); R = (st >> 1) * 16 + swz / 64; C = (st & 1) * 32 + (swz % 64) / 2; }
__host__ __device__ __forceinline__ int perm32(int rho) { const int n = rho >> 4, i = rho & 15; return 8 * (i >> 2) + 4 * n + (i & 3); }

struct Unit { int pm, pn; };
struct Gemm { const bf16_t* A; const bf16_t* Bt; int M, N, K; };

struct StaticOrder {
    int nM, nN, nwg, G, c;
    __host__ __device__ void init(int M, int N, int G_, int c_) { nM = M / BM; nN = N / BM; nwg = nM * nN; G = G_; c = c_; }
    __host__ __device__ bool next(int i, Unit& u) const {
        const long L = (long)i * G + c; if (L >= nwg) return false;
        int wgid = (int)L; { const int q = nwg / NXCD, r = nwg % NXCD, xcd = wgid % NXCD, off = wgid / NXCD; wgid = (xcd < r ? xcd * (q + 1) : r * (q + 1) + (xcd - r) * q) + off; }
        const int nig = WGM * nN, gid = wgid / nig, fm = gid * WGM, gsz = (nM - fm) < WGM ? (nM - fm) : WGM;
        u.pm = fm + ((wgid % nig) % gsz); u.pn = (wgid % nig) / gsz; return true;
    }
    __device__ __forceinline__ void a_ready(const Unit&) const {}
    __device__ __forceinline__ void done(const Unit&) const {}
};

typedef float f32x2_cv __attribute__((ext_vector_type(2))); typedef __bf16 bf16x2_cv __attribute__((ext_vector_type(2)));
__device__ __forceinline__ unsigned cvt_pk_bf16(float lo, float hi) { f32x2_cv v = {lo, hi}; bf16x2_cv b = __builtin_convertvector(v, bf16x2_cv); return __builtin_bit_cast(unsigned, b); }
template <class Epi, class Sched, bool ALIGN_EPI = false, bool SP2 = false>
__device__ __forceinline__ void gemm_phase(PG8_LAS unsigned char* lds, const Gemm g, const Sched& S, const Epi& E) {
    const int tid = threadIdx.x, wid = __builtin_amdgcn_readfirstlane(tid >> 6), lane = tid & 63, wr = wid >> 2, wc = wid & 3, fr = lane & 15, fq = lane >> 4;
    const int K = g.K, nt = K / BK;
    unsigned voffA[2], voffB[2];
#pragma unroll
    for (int i = 0; i < 2; ++i) { int R, C; stage_rc(tid * 16 + i * 8192, R, C); const int Rb = Epi::PERM ? ((R & ~31) + perm32(R & 31)) : R;
        voffA[i] = (unsigned)(R * K + C) * 2u; voffB[i] = (unsigned)(Rb * K + C) * 2u; }
    const size_t kstep = (size_t)(BK * 2);
    const size_t hstep = (size_t)HALF * K * 2;
    const size_t tstep = 2 * hstep;
    const unsigned ldsw = (unsigned)wid * 1024u;
    const int aoff = lds_byte(wr * 64 + fr, fq * 8), boff = lds_byte(wc * 32 + fr, fq * 8);
#define PG8_SA(b, h) (((b) * 2 + (h)) * HTB)
#define PG8_SB(b, h) ((4 + (b) * 2 + (h)) * HTB)
#define PG8_STAGE(bufoff, gbase, voff) do { _Pragma("unroll") for (int _i = 0; _i < 2; ++_i) \
        __builtin_amdgcn_global_load_lds((const unsigned*)((const char*)(gbase) + (voff)[_i]), (PG8_LAS unsigned*)(lds + (bufoff) + ldsw + _i * 8192), 16, 0, 0); } while (0)
#define PG8_LDA(dst, b, h) do { _Pragma("unroll") for (int m = 0; m < 4; ++m) _Pragma("unroll") for (int k = 0; k < 2; ++k) dst[m][k] = *(const PG8_LAS bf16x8*)(lds + PG8_SA(b, h) + aoff + m * 2048 + k * 1024); } while (0)
#define PG8_LDB(dst, b, h) do { _Pragma("unroll") for (int n = 0; n < 2; ++n) _Pragma("unroll") for (int k = 0; k < 2; ++k) dst[n][k] = *(const PG8_LAS bf16x8*)(lds + PG8_SB(b, h) + boff + n * 2048 + k * 1024); } while (0)
#define PG8_MMA(ai, bj, At, Bt) do { __builtin_amdgcn_s_setprio(1); _Pragma("unroll") for (int m = 0; m < 4; ++m) _Pragma("unroll") for (int n = 0; n < 2; ++n) _Pragma("unroll") for (int k = 0; k < 2; ++k) \
        acc[ai][bj][m][n] = __builtin_amdgcn_mfma_f32_16x16x32_bf16(Bt[n][k], At[m][k], acc[ai][bj][m][n], 0, 0, 0); __builtin_amdgcn_s_setprio(0); } while (0)
#define PG8_WAIT_V(n) asm volatile("s_waitcnt vmcnt(" #n ")" ::: "memory")
#define PG8_WAIT_L(n) asm volatile("s_waitcnt lgkmcnt(" #n ")" ::: "memory")
#define PG8_BAR __builtin_amdgcn_s_barrier()
#define PG8_SCHED __builtin_amdgcn_sched_barrier(0)
    Unit cur, nxt; int ui = 0;
    if (!S.next(0, cur)) return;
    f32x4 acc[2][2][4][2];
#pragma unroll
    for (int a = 0; a < 2; ++a)
#pragma unroll
        for (int b = 0; b < 2; ++b)
#pragma unroll
            for (int m = 0; m < 4; ++m)
#pragma unroll
                for (int n = 0; n < 2; ++n) acc[a][b][m][n] = (f32x4){0.f, 0.f, 0.f, 0.f};
    bf16x8 At[4][2], B0[2][2], B1[2][2];
    const char* cA = (const char*)g.A + (size_t)cur.pm * tstep; const char* cB = (const char*)g.Bt + (size_t)cur.pn * tstep;
    S.a_ready(cur);
    if constexpr (SP2) {
        PG8_STAGE(PG8_SB(0, 0), cB, voffB); PG8_STAGE(PG8_SB(0, 1), cB + hstep, voffB); PG8_STAGE(PG8_SA(0, 0), cA, voffA); PG8_STAGE(PG8_SA(0, 1), cA + hstep, voffA);
        PG8_STAGE(PG8_SB(1, 0), cB + kstep, voffB); PG8_STAGE(PG8_SA(1, 0), cA + kstep, voffA); PG8_STAGE(PG8_SB(1, 1), cB + hstep + kstep, voffB);
        PG8_WAIT_V(0); PG8_WAIT_L(0); PG8_BAR;
        if (wr == 1) PG8_BAR;
    } else {
        PG8_STAGE(PG8_SB(0, 0), cB, voffB); PG8_STAGE(PG8_SA(0, 0), cA, voffA); PG8_STAGE(PG8_SB(0, 1), cB + hstep, voffB); PG8_STAGE(PG8_SA(0, 1), cA + hstep, voffA);
        if (wr == 1) PG8_BAR;
        PG8_WAIT_V(4); PG8_BAR;
        PG8_STAGE(PG8_SB(1, 0), cB + kstep, voffB); PG8_STAGE(PG8_SA(1, 0), cA + kstep, voffA); PG8_STAGE(PG8_SB(1, 1), cB + hstep + kstep, voffB);
        PG8_WAIT_V(6); PG8_BAR;
    }
    for (;;) {
        const bool has_next = S.next(ui + 1, nxt);
        const char* nA = has_next ? (const char*)g.A + (size_t)nxt.pm * tstep : cA; const char* nB = has_next ? (const char*)g.Bt + (size_t)nxt.pn * tstep : cB;
        for (int t = 0; t < nt; t += 2) {
            const bool last = (t == nt - 2);
            const char* a1 = cA + (size_t)(t + 1) * kstep;
            const char* a2 = last ? nA : cA + (size_t)(t + 2) * kstep; const char* b2 = last ? nB : cB + (size_t)(t + 2) * kstep;
            const char* a3 = a2 + kstep; const char* b3 = b2 + kstep;
            if (last && has_next) S.a_ready(nxt);
            if constexpr (SP2) {
            PG8_LDB(B0, 0, 0); PG8_LDB(B1, 0, 1); PG8_SCHED; PG8_LDA(At, 0, 0); PG8_STAGE(PG8_SA(1, 1), a1 + hstep, voffA);
            PG8_WAIT_V(8); PG8_WAIT_L(0); PG8_BAR; PG8_MMA(0, 0, At, B0); PG8_MMA(0, 1, At, B1); PG8_BAR; PG8_SCHED;
            PG8_LDA(At, 0, 1); PG8_STAGE(PG8_SB(0, 0), b2, voffB); PG8_STAGE(PG8_SB(0, 1), b2 + hstep, voffB); PG8_STAGE(PG8_SA(0, 0), a2, voffA);
            PG8_WAIT_V(8); PG8_WAIT_L(0); PG8_BAR; PG8_MMA(1, 0, At, B0); PG8_MMA(1, 1, At, B1); PG8_BAR; PG8_SCHED;
            PG8_LDB(B0, 1, 0); PG8_LDB(B1, 1, 1); PG8_SCHED; PG8_LDA(At, 1, 0); PG8_STAGE(PG8_SA(0, 1), a2 + hstep, voffA);
            PG8_WAIT_V(8); PG8_WAIT_L(0); PG8_BAR; PG8_MMA(0, 0, At, B0); PG8_MMA(0, 1, At, B1); PG8_BAR; PG8_SCHED;
            PG8_LDA(At, 1, 1); PG8_STAGE(PG8_SB(1, 0), b3, voffB); PG8_STAGE(PG8_SB(1, 1), b3 + hstep, voffB); PG8_STAGE(PG8_SA(1, 0), a3, voffA);
            PG8_WAIT_V(8); PG8_WAIT_L(0); PG8_BAR; PG8_MMA(1, 0, At, B0); PG8_MMA(1, 1, At, B1); PG8_BAR; PG8_SCHED;
            } else {
            PG8_LDB(B0, 0, 0); PG8_SCHED; PG8_LDA(At, 0, 0); PG8_STAGE(PG8_SA(1, 1), a1 + hstep, voffA);
            PG8_WAIT_L(8); PG8_BAR; PG8_WAIT_L(0); PG8_MMA(0, 0, At, B0); PG8_BAR; PG8_SCHED;
            PG8_LDB(B1, 0, 1); PG8_STAGE(PG8_SB(0, 0), b2, voffB);
            PG8_BAR; PG8_WAIT_L(0); PG8_MMA(0, 1, At, B1); PG8_BAR;
            PG8_LDA(At, 0, 1); PG8_STAGE(PG8_SA(0, 0), a2, voffA);
            PG8_BAR; PG8_WAIT_L(0); PG8_MMA(1, 0, At, B0); PG8_BAR; PG8_SCHED;
            PG8_STAGE(PG8_SB(0, 1), b2 + hstep, voffB);
            PG8_WAIT_V(6); PG8_BAR; PG8_MMA(1, 1, At, B1); PG8_BAR;
            PG8_LDB(B0, 1, 0); PG8_SCHED; PG8_LDA(At, 1, 0); PG8_STAGE(PG8_SA(0, 1), a2 + hstep, voffA);
            PG8_WAIT_L(8); PG8_BAR; PG8_WAIT_L(0); PG8_MMA(0, 0, At, B0); PG8_BAR; PG8_SCHED;
            PG8_LDB(B1, 1, 1); PG8_STAGE(PG8_SB(1, 0), b3, voffB);
            PG8_BAR; PG8_WAIT_L(0); PG8_MMA(0, 1, At, B1); PG8_BAR;
            PG8_LDA(At, 1, 1); PG8_STAGE(PG8_SA(1, 0), a3, voffA);
            PG8_BAR; PG8_WAIT_L(0); PG8_MMA(1, 0, At, B0); PG8_BAR; PG8_SCHED;
            PG8_STAGE(PG8_SB(1, 1), b3 + hstep, voffB);
            PG8_WAIT_V(6); PG8_BAR; PG8_MMA(1, 1, At, B1); PG8_BAR;
            }
        }
        if constexpr (ALIGN_EPI) { if (wr == 0) PG8_BAR; }
        if constexpr (!Epi::AFTER_DRAIN) { E(acc, cur, wr, wc, fr, fq); S.done(cur); }
        if (!has_next) break;
#pragma unroll
        for (int a = 0; a < 2; ++a)
#pragma unroll
            for (int b = 0; b < 2; ++b)
#pragma unroll
                for (int m = 0; m < 4; ++m)
#pragma unroll
                    for (int n = 0; n < 2; ++n) acc[a][b][m][n] = (f32x4){0.f, 0.f, 0.f, 0.f};
        cur = nxt; cA = nA; cB = nB; ++ui;
        if constexpr (ALIGN_EPI) { if (wr == 1) PG8_BAR; }
    }
    PG8_WAIT_V(0);
    if constexpr (!ALIGN_EPI) { if (wr == 0) PG8_BAR; }
    PG8_BAR;
    if constexpr (Epi::AFTER_DRAIN) { E.fused(acc, cur, wr, wc, fr, fq, lds, wid, lane); S.done(cur); }
#undef PG8_SA
#undef PG8_SB
#undef PG8_STAGE
#undef PG8_LDA
#undef PG8_LDB
#undef PG8_MMA
#undef PG8_WAIT_V
#undef PG8_WAIT_L
#undef PG8_BAR
#undef PG8_SCHED
}
}
constexpr int SEQ = 16384, NTOK = 32768, DM = 2048, DFF = 5632;
constexpr float EPS = 1e-6f;
#define GAS __attribute__((address_space(1)))
#define LAS __attribute__((address_space(3)))

namespace ep {
using namespace pg8;
typedef float f32x2 __attribute__((ext_vector_type(2)));
__device__ __forceinline__ u32x4 pack8(const f32x4 a, const f32x4 b) { u32x4 w; w.x = cvt_pk_bf16(a[0], a[1]); w.y = cvt_pk_bf16(a[2], a[3]); w.z = cvt_pk_bf16(b[0], b[1]); w.w = cvt_pk_bf16(b[2], b[3]); return w; }
__device__ __forceinline__ float bflo(unsigned u) { return __uint_as_float(u << 16); }
__device__ __forceinline__ float bfhi(unsigned u) { return __uint_as_float(u & 0xffff0000u); }
__device__ __forceinline__ void unpack8(const u32x4 w, f32x4& a, f32x4& b) { a = (f32x4){bflo(w.x), bfhi(w.x), bflo(w.y), bfhi(w.y)}; b = (f32x4){bflo(w.z), bfhi(w.z), bflo(w.w), bfhi(w.w)}; }
__device__ __forceinline__ float sigmoidf_(float x) { return __builtin_amdgcn_rcpf(1.f + __builtin_amdgcn_exp2f(-1.4426950408889634f * x)); }
__device__ __forceinline__ float ssq4(const f32x4 x) { return (x[0] * x[0] + x[1] * x[1]) + (x[2] * x[2] + x[3] * x[3]); }
__device__ __forceinline__ void rope8(f32x4& v0, f32x4& v1, const f32x4 csA, const f32x4 csB) {
    const float a0 = v0[0] * csA[0] - v0[1] * csA[1], b0 = v0[1] * csA[0] + v0[0] * csA[1];
    const float a1 = v0[2] * csA[2] - v0[3] * csA[3], b1 = v0[3] * csA[2] + v0[2] * csA[3];
    const float a2 = v1[0] * csB[0] - v1[1] * csB[1], b2 = v1[1] * csB[0] + v1[0] * csB[1];
    const float a3 = v1[2] * csB[2] - v1[3] * csB[3], b3 = v1[3] * csB[2] + v1[2] * csB[3];
    v0 = (f32x4){a0, b0, a1, b1}; v1 = (f32x4){a2, b2, a3, b3};
}

struct EpiIn {
    static constexpr bool PERM = true, AFTER_DRAIN = false;
    bf16_t *CQ, *CKV, *KR, *QS, *KS, *VS; float *ssqQ, *ssqKV; const float* rope;
    __device__ __forceinline__ void operator()(const f32x4 (&acc)[2][2][4][2], const Unit& u, int wr, int wc, int fr, int fq) const {
        const int pn = u.pn, row0 = u.pm * BM + wr * 64 + fr, cw = wc * 32 + 8 * fq;
        if (pn < 3) {
            float* sq = pn < 2 ? ssqQ : ssqKV; const int nslot = pn < 2 ? 8 : 4, slot = (pn < 2 ? pn * 4 : 0) + wc, ldc = pn < 2 ? 512 : 256;
            bf16_t* base = pn < 2 ? CQ + pn * 256 : CKV;
#pragma unroll
            for (int ai = 0; ai < 2; ++ai)
#pragma unroll
                for (int m = 0; m < 4; ++m) { const int row = row0 + ai * HALF + m * 16;
                    float s = (ssq4(acc[ai][0][m][0]) + ssq4(acc[ai][0][m][1])) + (ssq4(acc[ai][1][m][0]) + ssq4(acc[ai][1][m][1]));
                    s += __shfl_xor(s, 16); s += __shfl_xor(s, 32);
                    if (fq == 0) sq[(size_t)row * nslot + slot] = s;
#pragma unroll
                    for (int bj = 0; bj < 2; ++bj) *(u32x4*)(base + (size_t)row * ldc + bj * HALF + cw) = pack8(acc[ai][bj][m][0], acc[ai][bj][m][1]); }
        } else if (pn == 3) {
            if (wc < 2) {
#pragma unroll
                for (int ai = 0; ai < 2; ++ai)
#pragma unroll
                    for (int m = 0; m < 4; ++m) { const int row = row0 + ai * HALF + m * 16; const int pos = row & (SEQ - 1);
                        const float* cs = rope + ((size_t)pos * 32 + 16 * wc + 4 * fq) * 2;
                        const f32x4 csA = *(const f32x4*)cs, csB = *(const f32x4*)(cs + 4);
                        f32x4 v0 = acc[ai][0][m][0], v1 = acc[ai][0][m][1]; rope8(v0, v1, csA, csB);
                        *(u32x4*)(KR + (size_t)row * 64 + cw) = pack8(v0, v1); }
            }
        } else if (pn < 14) {
            bf16_t* base; int ldc;
            if (pn < 12) { base = QS + (pn - 4) * 256; ldc = 2048; } else if (pn == 12) { base = KS; ldc = 256; } else { base = VS; ldc = 256; }
#pragma unroll
            for (int ai = 0; ai < 2; ++ai)
#pragma unroll
                for (int m = 0; m < 4; ++m) { const int row = row0 + ai * HALF + m * 16;
#pragma unroll
                    for (int bj = 0; bj < 2; ++bj) *(u32x4*)(base + (size_t)row * ldc + bj * HALF + cw) = pack8(acc[ai][bj][m][0], acc[ai][bj][m][1]); }
        }
    }
};

struct EpiSig {
    static constexpr bool PERM = true, AFTER_DRAIN = false;
    bf16_t* GT;
    __device__ __forceinline__ void operator()(const f32x4 (&acc)[2][2][4][2], const Unit& u, int wr, int wc, int fr, int fq) const {
        const int row0 = u.pm * BM + wr * 64 + fr, cw = wc * 32 + 8 * fq; bf16_t* base = GT + u.pn * 256;
#pragma unroll
        for (int ai = 0; ai < 2; ++ai)
#pragma unroll
            for (int m = 0; m < 4; ++m) { const int row = row0 + ai * HALF + m * 16;
#pragma unroll
                for (int bj = 0; bj < 2; ++bj) { f32x4 v0 = acc[ai][bj][m][0], v1 = acc[ai][bj][m][1];
#pragma unroll
                    for (int e = 0; e < 4; ++e) { v0[e] = sigmoidf_(v0[e]); v1[e] = sigmoidf_(v1[e]); }
                    *(u32x4*)(base + (size_t)row * 4096 + bj * HALF + cw) = pack8(v0, v1); } }
    }
};

struct EpiUp {
    static constexpr bool PERM = true, AFTER_DRAIN = false;
    const float* ssq; int nslot; float invK; bf16_t* O0; bf16_t* O1; int ld0, ld1, split; int rope1; const float* rope;
    __device__ __forceinline__ void operator()(const f32x4 (&acc)[2][2][4][2], const Unit& u, int wr, int wc, int fr, int fq) const {
        const int pn = u.pn, row0 = u.pm * BM + wr * 64 + fr, cw = wc * 32 + 8 * fq;
        const int t = pn < split ? 0 : 1; bf16_t* base = t ? O1 + (pn - split) * 256 : O0 + pn * 256; const int ld = t ? ld1 : ld0;
        const bool dorope = (t == 1) && rope1;
#pragma unroll
        for (int ai = 0; ai < 2; ++ai)
#pragma unroll
            for (int m = 0; m < 4; ++m) { const int row = row0 + ai * HALF + m * 16;
                float s;
                if (nslot == 8) { const f32x4 a = *(const f32x4*)(ssq + (size_t)row * 8), b = *(const f32x4*)(ssq + (size_t)row * 8 + 4); s = ((a[0] + a[1]) + (a[2] + a[3])) + ((b[0] + b[1]) + (b[2] + b[3])); }
                else { const f32x4 a = *(const f32x4*)(ssq + (size_t)row * 4); s = (a[0] + a[1]) + (a[2] + a[3]); }
                const float rs = 1.0f / sqrtf(s * invK + EPS);
                f32x4 csA = {1.f, 0.f, 1.f, 0.f}, csB = {1.f, 0.f, 1.f, 0.f};
                if (dorope) { const int pos = row & (SEQ - 1); const float* cs = rope + ((size_t)pos * 32 + 16 * (wc & 1) + 4 * fq) * 2; csA = *(const f32x4*)cs; csB = *(const f32x4*)(cs + 4); }
#pragma unroll
                for (int bj = 0; bj < 2; ++bj) { f32x4 v0 = acc[ai][bj][m][0] * rs, v1 = acc[ai][bj][m][1] * rs;
                    if (dorope) rope8(v0, v1, csA, csB);
                    *(u32x4*)(base + (size_t)row * ld + bj * HALF + cw) = pack8(v0, v1); } }
    }
};

template <bool SECOND> struct EpiGate {
    static constexpr bool PERM = true, AFTER_DRAIN = false;
    const bf16_t* GT; bf16_t* MG;
    __device__ __forceinline__ void operator()(const f32x4 (&acc)[2][2][4][2], const Unit& u, int wr, int wc, int fr, int fq) const {
        const int row0 = u.pm * BM + wr * 64 + fr, col0 = u.pn * BM + wc * 32 + 8 * fq;
#pragma unroll
        for (int ai = 0; ai < 2; ++ai)
#pragma unroll
            for (int m = 0; m < 4; ++m) { const int row = row0 + ai * HALF + m * 16;
#pragma unroll
                for (int bj = 0; bj < 2; ++bj) { const int col = col0 + bj * HALF;
                    const u32x4 gw = *(const u32x4*)(GT + (size_t)row * 4096 + (SECOND ? 2048 : 0) + col); f32x4 g0, g1; unpack8(gw, g0, g1);
                    f32x4 v0 = acc[ai][bj][m][0] * g0, v1 = acc[ai][bj][m][1] * g1;
                    bf16_t* p = MG + (size_t)row * DM + col;
                    if (SECOND) { const u32x4 pw = *(const u32x4*)p; f32x4 p0, p1; unpack8(pw, p0, p1); v0 += p0; v1 += p1; }
                    *(u32x4*)p = pack8(v0, v1); } }
    }
};

struct EpiBfSsq {
    static constexpr bool PERM = true, AFTER_DRAIN = false;
    bf16_t* Y; float* ssq;
    __device__ __forceinline__ void operator()(const f32x4 (&acc)[2][2][4][2], const Unit& u, int wr, int wc, int fr, int fq) const {
        const int row0 = u.pm * BM + wr * 64 + fr, col0 = u.pn * BM + wc * 32 + 8 * fq;
#pragma unroll
        for (int ai = 0; ai < 2; ++ai)
#pragma unroll
            for (int m = 0; m < 4; ++m) { const int row = row0 + ai * HALF + m * 16;
                float s = (ssq4(acc[ai][0][m][0]) + ssq4(acc[ai][0][m][1])) + (ssq4(acc[ai][1][m][0]) + ssq4(acc[ai][1][m][1]));
                s += __shfl_xor(s, 16); s += __shfl_xor(s, 32);
                if (fq == 0) ssq[(size_t)row * 32 + u.pn * 4 + wc] = s;
#pragma unroll
                for (int bj = 0; bj < 2; ++bj) *(u32x4*)(Y + (size_t)row * DM + col0 + bj * HALF) = pack8(acc[ai][bj][m][0], acc[ai][bj][m][1]); }
    }
};

struct EpiFfn {
    static constexpr bool PERM = true, AFTER_DRAIN = false;
    bf16_t* G; float* AH; float* BH; const float* cw; const float* cb;
    __device__ __forceinline__ void operator()(const f32x4 (&acc)[2][2][4][2], const Unit& u, int wr, int wc, int fr, int fq) const {
        const int lane = threadIdx.x & 63;
        const int f0 = u.pn * 128 + wc * 32 + 8 * fq;
        f32x4 w0[2], w1[2], w2[2], bb[2];
#pragma unroll
        for (int n = 0; n < 2; ++n) { w0[n] = *(const f32x4*)(cw + f0 + 4 * n); w1[n] = *(const f32x4*)(cw + DFF + f0 + 4 * n); w2[n] = *(const f32x4*)(cw + 2 * DFF + f0 + 4 * n); bb[n] = *(const f32x4*)(cb + f0 + 4 * n); }
        const int src1 = (lane & 48) | ((fr - 1) & 15), src2 = (lane & 48) | ((fr - 2) & 15);
#pragma unroll
        for (int ai = 0; ai < 2; ++ai) {
            const int jb = u.pm * 4 + ai * 2 + wr;
            f32x4 p1[2], p2[2];
#pragma unroll
            for (int n = 0; n < 2; ++n) { p1[n] = (f32x4){0.f, 0.f, 0.f, 0.f}; p2[n] = p1[n]; }
#pragma unroll
            for (int m = 0; m < 4; ++m) {
                f32x4 o[2];
#pragma unroll
                for (int n = 0; n < 2; ++n) { f32x4 r1, r2;
#pragma unroll
                    for (int e = 0; e < 4; ++e) { const float a0 = acc[ai][0][m][n][e]; r1[e] = __shfl(a0, src1); r2[e] = __shfl(a0, src2); }
                    f32x4 a1, a2;
#pragma unroll
                    for (int e = 0; e < 4; ++e) { a1[e] = fr >= 1 ? r1[e] : p1[n][e]; a2[e] = fr >= 2 ? r2[e] : p2[n][e]; }
                    p1[n] = r1; p2[n] = r2;
                    const f32x4 c = bb[n] + w0[n] * a2 + w1[n] * a1 + w2[n] * acc[ai][0][m][n];
#pragma unroll
                    for (int e = 0; e < 4; ++e) { const float x = c[e]; const float uu = 0.7978845608028654f * (x + 0.044715f * x * x * x);
                        const float gl = x * __builtin_amdgcn_rcpf(1.f + __builtin_amdgcn_exp2f(-2.885390081777927f * uu)); o[n][e] = gl * acc[ai][1][m][n][e]; } }
                const int row = u.pm * BM + ai * HALF + wr * 64 + m * 16 + fr;
                if (!(m == 0 && fr < 2)) *(u32x4*)(G + (size_t)row * DFF + f0) = pack8(o[0], o[1]);
                if (m == 0 && fr < 2) { float* ah = AH + ((size_t)jb * 4 + 2 + fr) * DFF + f0; *(f32x4*)ah = acc[ai][0][0][0]; *(f32x4*)(ah + 4) = acc[ai][0][0][1];
                    float* bh = BH + ((size_t)jb * 2 + fr) * DFF + f0; *(f32x4*)bh = acc[ai][1][0][0]; *(f32x4*)(bh + 4) = acc[ai][1][0][1]; }
                if (m == 3 && fr >= 14) { float* ah = AH + ((size_t)jb * 4 + (fr - 14)) * DFF + f0; *(f32x4*)ah = acc[ai][0][3][0]; *(f32x4*)(ah + 4) = acc[ai][0][3][1]; }
            }
        }
    }
};
}
namespace att {
typedef short bf16x8 __attribute__((ext_vector_type(8)));
typedef short s16x4 __attribute__((ext_vector_type(4)));
typedef float f32x16 __attribute__((ext_vector_type(16)));
typedef float f32x4 __attribute__((ext_vector_type(4)));
typedef unsigned u32x4 __attribute__((ext_vector_type(4)));
typedef unsigned short bf16_t;
#define SBAR() __builtin_amdgcn_sched_barrier(0)
#define KSWZ(row, colB) ((row) * 256 + ((colB) ^ (((row) & 7) << 4)))
#define KSWZ64(row, chunk) ((row) * 128 + ((((chunk) ^ ((row) & 7))) << 4))
template <int NCB> __device__ __forceinline__ int v_st(int k, int c) { const int kk = (k & ~0xC) | ((k & 4) << 1) | ((k & 8) >> 1); return ((kk >> 3) * NCB + (c >> 5)) * 512 + ((kk & 7) * 32 + (c & 31)) * 2; }
__device__ __forceinline__ int v_rd_base(int lane) { return ((lane & 3) << 3) | (((lane >> 2) & 3) << 6) | (((lane >> 4) & 1) << 5) | (((lane >> 5) & 1) << 8); }
__device__ __forceinline__ int crow(int r, int hi) { return (r & 3) + 8 * (r >> 2) + 4 * hi; }
typedef float f32x2_cv __attribute__((ext_vector_type(2))); typedef __bf16 bf16x2_cv __attribute__((ext_vector_type(2)));
__device__ __forceinline__ unsigned cvtpk(float lo, float hi) { f32x2_cv v = {lo, hi}; bf16x2_cv b = __builtin_convertvector(v, bf16x2_cv); return __builtin_bit_cast(unsigned, b); }
__device__ __forceinline__ void mask_tile(f32x16& p0, f32x16& p1, int dq, unsigned W) {
    const float NEG = -__builtin_inff();
#pragma unroll
    for (int r = 0; r < 16; ++r) { const int c = (r & 3) + 8 * (r >> 2);
        if ((unsigned)(dq - c) >= W) p0[r] = NEG;
        if ((unsigned)(dq - c - 32) >= W) p1[r] = NEG; }
}
constexpr float THR = 8.f;
template <int SCALE_E6> __device__ __forceinline__ void partialSM(f32x16& p0, f32x16& p1, float& m_reg, float& mn, float& alpha) {
    constexpr float SCALE = SCALE_E6 * 1e-9f; constexpr float C2 = 1.4426950408889634f * SCALE;
    float pmax = p0[0];
#pragma unroll
    for (int r = 1; r < 16; ++r) pmax = fmaxf(pmax, p0[r]);
#pragma unroll
    for (int r = 0; r < 16; ++r) pmax = fmaxf(pmax, p1[r]);
    { auto rr = __builtin_amdgcn_permlane32_swap(__float_as_uint(pmax), __float_as_uint(pmax), false, false);
      pmax = fmaxf(__uint_as_float(rr[0]), __uint_as_float(rr[1])); }
    if (__builtin_expect(__all((pmax - m_reg) * SCALE <= THR), 1)) { mn = m_reg; alpha = 1.f; }
    else { mn = fmaxf(m_reg, pmax); alpha = __builtin_amdgcn_exp2f((m_reg - mn) * C2); m_reg = mn; }
    const float mnL = -mn * C2;
#pragma unroll
    for (int r = 0; r < 16; ++r) p0[r] = fmaf(p0[r], C2, mnL);
#pragma unroll
    for (int r = 0; r < 16; ++r) p1[r] = fmaf(p1[r], C2, mnL);
#pragma unroll
    for (int r = 0; r < 16; ++r) p0[r] = __builtin_amdgcn_exp2f(p0[r]);
}
__device__ __forceinline__ void finishSM(f32x16& p0, f32x16& p1, float alpha, float& l_reg, bf16x8& pa0, bf16x8& pa1, bf16x8& pa2, bf16x8& pa3) {
#pragma unroll
    for (int r = 0; r < 16; ++r) p1[r] = __builtin_amdgcn_exp2f(p1[r]);
    float ps = 0;
#pragma unroll
    for (int r = 0; r < 16; ++r) ps += p0[r];
#pragma unroll
    for (int r = 0; r < 16; ++r) ps += p1[r];
    { auto rr = __builtin_amdgcn_permlane32_swap(__float_as_uint(ps), __float_as_uint(ps), false, false);
      ps = __uint_as_float(rr[0]) + __uint_as_float(rr[1]); }
    l_reg = l_reg * alpha + ps;
#define PK4(P, B_, OUT) do { unsigned a0 = cvtpk(P[B_+0], P[B_+1]), a1 = cvtpk(P[B_+2], P[B_+3]);                          \
        unsigned b0 = cvtpk(P[B_+4], P[B_+5]), b1 = cvtpk(P[B_+6], P[B_+7]);                                             \
        auto r0 = __builtin_amdgcn_permlane32_swap(a0, b0, false, false); auto r1 = __builtin_amdgcn_permlane32_swap(a1, b1, false, false); \
        u32x4 w = {r0[0], r1[0], r0[1], r1[1]}; OUT = *reinterpret_cast<bf16x8*>(&w); } while (0)
    PK4(p0, 0, pa0); PK4(p0, 8, pa1); PK4(p1, 0, pa2); PK4(p1, 8, pa3);
#undef PK4
}
__device__ __forceinline__ void qk128(f32x16& p0, f32x16& p1, const LAS char* kl, int r32, int hi, const bf16x8* qr) {
    const LAS char* kb[4];
#pragma unroll
    for (int dd = 0; dd < 4; ++dd) kb[dd] = kl + KSWZ(r32, (dd * 16 + hi * 8) * 2);
#pragma unroll
    for (int d0 = 0; d0 < 8; ++d0) { const LAS char* a = kb[d0 & 3] + (d0 >> 2) * 128;
        const bf16x8 b0 = *reinterpret_cast<const LAS bf16x8*>(a);
        const bf16x8 b1 = *reinterpret_cast<const LAS bf16x8*>(a + 32 * 256);
        p0 = __builtin_amdgcn_mfma_f32_32x32x16_bf16(b0, qr[d0], p0, 0, 0, 0);
        p1 = __builtin_amdgcn_mfma_f32_32x32x16_bf16(b1, qr[d0], p1, 0, 0, 0); }
}
__device__ __forceinline__ void qk64(f32x16& p0, f32x16& p1, const LAS char* kl, int r32, int hi, const bf16x8* qr) {
#pragma unroll
    for (int ks = 0; ks < 4; ++ks) { const LAS char* a = kl + KSWZ64(r32, 2 * ks + hi);
        const bf16x8 b0 = *reinterpret_cast<const LAS bf16x8*>(a);
        const bf16x8 b1 = *reinterpret_cast<const LAS bf16x8*>(a + 32 * 128);
        p0 = __builtin_amdgcn_mfma_f32_32x32x16_bf16(b0, qr[ks], p0, 0, 0, 0);
        p1 = __builtin_amdgcn_mfma_f32_32x32x16_bf16(b1, qr[ks], p1, 0, 0, 0); }
}
__device__ __forceinline__ void qk_mla(f32x16& p0, f32x16& p1, int kaddr, int r32, int hi, const bf16x8* qr) {
    const int rb = kaddr + r32 * 256, sw = (r32 & 7) << 4, h16 = hi * 16;
    const int rr = kaddr + 16384 + r32 * 128;
#define KRD(dst, base, off) asm volatile("ds_read_b128 %0, %1 offset:%2" : "=&v"(dst) : "v"(base), "i"(off) : "memory")
#define WLK(n) do { asm volatile("s_waitcnt lgkmcnt(" #n ")" ::: "memory"); SBAR(); } while (0)
#define RDN(S, dd, off) do { const int a_ = rb + (((dd) * 32 + h16) ^ sw); KRD(S##0, a_, off); KRD(S##1, a_, 8192 + (off)); } while (0)
#define RDR(S, ks) do { const int a_ = rr + (((((ks) * 2 + hi)) ^ (r32 & 7)) << 4); KRD(S##0, a_, 0); KRD(S##1, a_, 4096); } while (0)
#define MM1(S, d) do { p0 = __builtin_amdgcn_mfma_f32_32x32x16_bf16(S##0, qr[d], p0, 0, 0, 0); p1 = __builtin_amdgcn_mfma_f32_32x32x16_bf16(S##1, qr[d], p1, 0, 0, 0); } while (0)
    bf16x8 A0, A1, B0, B1;
    RDN(A, 0, 0); RDN(B, 1, 0);
    WLK(2); MM1(A, 0); RDN(A, 2, 0);
    WLK(2); MM1(B, 1); RDN(B, 3, 0);
    WLK(2); MM1(A, 2); RDN(A, 0, 128);
    WLK(2); MM1(B, 3); RDN(B, 1, 128);
    WLK(2); MM1(A, 4); RDN(A, 2, 128);
    WLK(2); MM1(B, 5); RDN(B, 3, 128);
    WLK(2); MM1(A, 6); RDR(A, 0);
    WLK(2); MM1(B, 7); RDR(B, 1);
    WLK(2); MM1(A, 8); RDR(A, 2);
    WLK(2); MM1(B, 9); RDR(B, 3);
    WLK(2); MM1(A, 10);
    WLK(0); MM1(B, 11);
#undef MM1
#undef RDR
#undef RDN
#undef WLK
#undef KRD
}
template <int NCB> __device__ __forceinline__ void pv_tile(f32x16* o, int vb, bf16x8 pa0, bf16x8 pa1, bf16x8 pa2, bf16x8 pa3) {
#define TRRD(dst, off) asm volatile("ds_read_b64_tr_b16 %0, %1 offset:%2" : "=&v"(dst) : "v"(vb), "i"(off) : "memory")
    constexpr int KS_ = NCB * 1024;
#define PV_RD(S, d0) do { constexpr int b_ = (d0) * 512; TRRD(S##l0, b_); TRRD(S##h0, b_ + KS_ / 2); TRRD(S##l1, b_ + KS_); TRRD(S##h1, b_ + KS_ + KS_ / 2); TRRD(S##l2, b_ + 2 * KS_); TRRD(S##h2, b_ + 2 * KS_ + KS_ / 2); TRRD(S##l3, b_ + 3 * KS_); TRRD(S##h3, b_ + 3 * KS_ + KS_ / 2); } while (0)
#define PV_MM(S, d0) do { \
        o[d0] = __builtin_amdgcn_mfma_f32_32x32x16_bf16(pa0, (bf16x8){S##l0[0], S##l0[1], S##l0[2], S##l0[3], S##h0[0], S##h0[1], S##h0[2], S##h0[3]}, o[d0], 0, 0, 0);   \
        o[d0] = __builtin_amdgcn_mfma_f32_32x32x16_bf16(pa1, (bf16x8){S##l1[0], S##l1[1], S##l1[2], S##l1[3], S##h1[0], S##h1[1], S##h1[2], S##h1[3]}, o[d0], 0, 0, 0);   \
        o[d0] = __builtin_amdgcn_mfma_f32_32x32x16_bf16(pa2, (bf16x8){S##l2[0], S##l2[1], S##l2[2], S##l2[3], S##h2[0], S##h2[1], S##h2[2], S##h2[3]}, o[d0], 0, 0, 0);   \
        o[d0] = __builtin_amdgcn_mfma_f32_32x32x16_bf16(pa3, (bf16x8){S##l3[0], S##l3[1], S##l3[2], S##l3[3], S##h3[0], S##h3[1], S##h3[2], S##h3[3]}, o[d0], 0, 0, 0); } while (0)
#define WL(n) do { asm volatile("s_waitcnt lgkmcnt(" #n ")" ::: "memory"); SBAR(); } while (0)
    s16x4 Al0, Al1, Al2, Al3, Ah0, Ah1, Ah2, Ah3, Bl0, Bl1, Bl2, Bl3, Bh0, Bh1, Bh2, Bh3;
    PV_RD(A, 0); PV_RD(B, 1); WL(8); PV_MM(A, 0);
    if constexpr (NCB == 4) { PV_RD(A, 2); WL(8); PV_MM(B, 1); PV_RD(B, 3); WL(8); PV_MM(A, 2); WL(0); PV_MM(B, 3); }
    else { WL(0); PV_MM(B, 1); }
#undef WL
#undef PV_MM
#undef PV_RD
#undef TRRD
}

struct AttnP {
    bf16_t* QN; const bf16_t* QR; const bf16_t* KN; const bf16_t* KR; const bf16_t* V;
    bf16_t* QS; const bf16_t* KS; const bf16_t* VS;
    const float* sinks; const float* rel;
};
__device__ const unsigned char T5B[128] = {0, 1, 2, 3, 4, 5, 6, 7, 8, 9, 10, 11, 12, 13, 14, 15, 16, 16, 16, 17, 17, 18, 18, 18, 19, 19, 19, 20, 20, 20, 20, 21, 21, 21, 21, 22, 22, 22, 22, 22, 23, 23, 23, 23, 23, 23, 24, 24, 24, 24, 24, 24, 25, 25, 25, 25, 25, 25, 25, 26, 26, 26, 26, 26, 26, 26, 26, 27, 27, 27, 27, 27, 27, 27, 27, 27, 27, 28, 28, 28, 28, 28, 28, 28, 28, 28, 28, 29, 29, 29, 29, 29, 29, 29, 29, 29, 29, 29, 29, 30, 30, 30, 30, 30, 30, 30, 30, 30, 30, 30, 30, 30, 30, 31, 31, 31, 31, 31, 31, 31, 31, 31, 31, 31, 31, 31, 31, 31};

template <bool MLA> __device__ __forceinline__ void attn_unit(const AttnP& P, int b, int hh, int qb, LAS char* lds) {
    constexpr int DV = MLA ? 128 : 64, NCB = DV / 32, NQF = MLA ? 12 : 4;
    constexpr int KBYTES = MLA ? 24576 : 8192, VBYTES = 64 * DV * 2;
    constexpr int SC9 = MLA ? 72168784 : 125000000;
    constexpr float SCALE = SC9 * 1e-9f;
    constexpr int W = MLA ? (1 << 30) : 128;
    const int tid = threadIdx.x, wid = __builtin_amdgcn_readfirstlane(tid >> 6), lane = tid & 63, r32 = lane & 31, hi = lane >> 5;
    LAS char* V_lds = lds; LAS char* K_lds = lds + 2 * VBYTES;
    LAS float* ws = (LAS float*)(lds + 2 * VBYTES + 2 * KBYTES) + wid * 64; LAS float* li_l = ws; LAS float* al_l = ws + 32;
    LAS float* bias_l = (LAS float*)(lds + 2 * VBYTES + 2 * KBYTES + 2048);
    const int q0 = qb * 256; const size_t rowbase = (size_t)b * SEQ;
    const int jt0 = MLA ? 0 : (q0 == 0 ? 0 : -2);
    const int NT = MLA ? 4 * qb + 4 : 4 - jt0;
    const int kbase0 = MLA ? 0 : q0 + 64 * jt0;
    const int qlo = q0 + wid * 32, qm = qlo + r32 - 4 * hi;
    bf16x8 qr[NQF];
    const size_t qrow = rowbase + qlo + r32;
    if constexpr (MLA) {
#pragma unroll
        for (int d0 = 0; d0 < 8; ++d0) qr[d0] = *(const bf16x8*)(P.QN + qrow * 2048 + hh * 128 + d0 * 16 + hi * 8);
#pragma unroll
        for (int d0 = 0; d0 < 4; ++d0) qr[8 + d0] = *(const bf16x8*)(P.QR + qrow * 1024 + hh * 64 + d0 * 16 + hi * 8);
    } else {
#pragma unroll
        for (int d0 = 0; d0 < 4; ++d0) qr[d0] = *(const bf16x8*)(P.QS + qrow * 2048 + hh * 64 + d0 * 16 + hi * 8);
        if (tid < 128) bias_l[tid] = P.rel[(int)T5B[tid] * 32 + hh] * (1.0f / SCALE);
    }
    bf16x8 sk0, sv0;
    const int sr8 = tid >> 3, ch8 = tid & 7;
    const bf16_t* Kg; const bf16_t* Vg; const bf16_t* Rg = nullptr;
    unsigned okA = 0, okB = 0, orp = 0, ovA = 0, ovB = 0;
    if constexpr (MLA) {
        Kg = P.KN + rowbase * 2048 + hh * 128; Vg = P.V + rowbase * 2048 + hh * 128; Rg = P.KR + rowbase * 64;
        { const int rA = 4 * wid + (lane >> 4), rB = rA + 32, cp = lane & 15; okA = (unsigned)(rA * 2048 + ((cp ^ (rA & 7)) << 3)); okB = (unsigned)(rB * 2048 + ((cp ^ (rB & 7)) << 3)); }
        { const int rr = 8 * wid + (lane >> 3), cp = lane & 7; orp = (unsigned)(rr * 64 + ((cp ^ (rr & 7)) << 3)); }
        { const int stA = 2 * wid + (lane >> 5), stB = stA + 16; const int kl = (lane & 31) >> 2, c8 = 8 * (lane & 3);
          const int kkA = (stA >> 2) * 8 + kl, kkB = (stB >> 2) * 8 + kl;
          const int kA = (kkA & ~0xC) | ((kkA & 4) << 1) | ((kkA & 8) >> 1), kB = (kkB & ~0xC) | ((kkB & 4) << 1) | ((kkB & 8) >> 1);
          ovA = (unsigned)(kA * 2048 + 32 * (stA & 3) + c8); ovB = (unsigned)(kB * 2048 + 32 * (stB & 3) + c8); }
    } else { Kg = P.KS + (rowbase + sr8) * 256 + (hh >> 3) * 64 + ch8 * 8; Vg = P.VS + (rowbase + sr8) * 256 + (hh >> 3) * 64 + ch8 * 8; }
    const int kws = KSWZ64(sr8, ch8), vst0 = v_st<NCB>(sr8, ch8 * 8);
#define GLDS(gp, lp) __builtin_amdgcn_global_load_lds((const unsigned*)(gp), (LAS unsigned*)(lp), 16, 0, 0)
#define LOADT(t, bf) do { const size_t k0_ = (size_t)(kbase0 + 64 * (t)); \
        if constexpr (MLA) { LAS char* kd_ = K_lds + (bf) * KBYTES + wid * 1024; LAS char* vd_ = V_lds + (bf) * VBYTES + wid * 1024; \
            const bf16_t* kp_ = Kg + k0_ * 2048; const bf16_t* vp_ = Vg + k0_ * 2048; const bf16_t* rp_ = Rg + k0_ * 64; \
            GLDS(kp_ + okA, kd_); GLDS(kp_ + okB, kd_ + 8192); GLDS(rp_ + orp, kd_ + 16384); GLDS(vp_ + ovA, vd_); GLDS(vp_ + ovB, vd_ + 8192); } \
        else { sk0 = *(const bf16x8*)(Kg + k0_ * 256); sv0 = *(const bf16x8*)(Vg + k0_ * 256); } } while (0)
#define WRITET(bf) do { if constexpr (!MLA) { *(LAS bf16x8*)(K_lds + (bf) * KBYTES + kws) = sk0; *(LAS bf16x8*)(V_lds + (bf) * VBYTES + vst0) = sv0; } } while (0)
    float m_reg = MLA ? -1e30f : P.sinks[hh] * (1.0f / SCALE), l_reg = MLA ? 0.f : 1.f;
    f32x16 o[NCB];
#pragma unroll
    for (int d = 0; d < NCB; ++d) o[d] = f32x16{};
    const int vb0 = (int)(uintptr_t)V_lds + v_rd_base(lane);
    LOADT(0, 0); asm volatile("s_waitcnt vmcnt(0)" ::: "memory"); WRITET(0); __syncthreads();
    for (int t = 0; t < NT; ++t) {
        const int buf = t & 1;
        if (t + 1 < NT) LOADT(t + 1, buf ^ 1);
        const int kb = kbase0 + 64 * t;
        const bool act = (kb <= qlo + 31) && (MLA || kb + 63 >= qlo - (W - 1));
        if (act) {
            f32x16 p0 = f32x16{}, p1 = f32x16{};
            if constexpr (MLA) { qk_mla(p0, p1, (int)(uintptr_t)K_lds + buf * KBYTES, r32, hi, qr); }
            else { qk64(p0, p1, K_lds + buf * KBYTES, r32, hi, qr); }
            const int dq = qm - kb;
            if constexpr (!MLA) {
#pragma unroll
                for (int r = 0; r < 16; ++r) { const int c = (r & 3) + 8 * (r >> 2); p0[r] += bias_l[(dq - c) & 127]; p1[r] += bias_l[(dq - c - 32) & 127]; }
            }
            if (kb + 63 > qlo || (!MLA && kb <= qlo + 31 - W)) mask_tile(p0, p1, dq, (unsigned)W);
            float mn, alpha; bf16x8 pa0, pa1, pa2, pa3;
            partialSM<SC9>(p0, p1, m_reg, mn, alpha);
            finishSM(p0, p1, alpha, l_reg, pa0, pa1, pa2, pa3);
            if (__any(alpha < 1.f)) { if (hi == 0) al_l[r32] = alpha; asm volatile("s_waitcnt lgkmcnt(0)" ::: "memory");
#pragma unroll
                for (int d_ = 0; d_ < NCB; ++d_)
#pragma unroll
                    for (int r = 0; r < 16; ++r) o[d_][r] *= al_l[crow(r, hi)]; }
            SBAR();
            pv_tile<NCB>(o, vb0 + buf * VBYTES, pa0, pa1, pa2, pa3);
        }
        if (t + 1 < NT) { asm volatile("s_waitcnt vmcnt(0)" ::: "memory"); WRITET(buf ^ 1); }
        __syncthreads();
    }
    if (hi == 0) li_l[r32] = l_reg; asm volatile("s_waitcnt lgkmcnt(0)" ::: "memory");
    bf16_t* Ow = (MLA ? P.QN + (rowbase + qlo) * 2048 + hh * 128 : P.QS + (rowbase + qlo) * 2048 + hh * 64);
#pragma unroll
    for (int r = 0; r < 16; ++r) { const int orow = crow(r, hi); const float rl = __builtin_amdgcn_rcpf(li_l[orow]);
#pragma unroll
        for (int d0 = 0; d0 < NCB; ++d0) { const float v = o[d0][r] * rl; const float vn = __shfl_xor(v, 1);
            if ((r32 & 1) == 0) *(unsigned*)(Ow + (size_t)orow * 2048 + d0 * 32 + r32) = cvtpk(v, vn); } }
    __syncthreads();
#undef LOADT
#undef WRITET
#undef GLDS
}
#undef SBAR
}
typedef unsigned short bf16;
typedef unsigned v4u __attribute__((ext_vector_type(4)));
typedef float f32x4 __attribute__((ext_vector_type(4)));
constexpr size_t MiB = 1u << 20;
constexpr size_t WS_WIN = 1 * MiB, WS_WQ = 31 * MiB, WS_WKV = 34 * MiB, WS_WOA = 36 * MiB, WS_WOB = 44 * MiB, WS_WOUT = 52 * MiB, WS_WUP = 60 * MiB, WS_WDN = 104 * MiB;
constexpr size_t WS_ROPE = 126 * MiB;
constexpr size_t WS_SSQQ = 130 * MiB, WS_SSQKV = 131 * MiB, WS_SSQY = 132 * MiB, WS_SSQY2 = 136 * MiB;
constexpr size_t WS_XN = 140 * MiB;
constexpr size_t WS_CQ = 268 * MiB, WS_CKV = 300 * MiB, WS_KR = 316 * MiB, WS_KS = 320 * MiB, WS_VS = 336 * MiB, WS_QS = 352 * MiB;
constexpr size_t WS_QN = 480 * MiB, WS_QR = 608 * MiB, WS_KN = 672 * MiB, WS_V = 800 * MiB;
constexpr size_t WS_GT = 608 * MiB, WS_MG = 864 * MiB;
constexpr size_t WS_Y = 140 * MiB, WS_X1 = 768 * MiB, WS_H2 = 640 * MiB;
constexpr size_t WS_G = 140 * MiB, WS_AH = 492 * MiB, WS_BH = 536 * MiB;
constexpr size_t WS_Y2 = 640 * MiB, WS_END = 1024 * MiB;

struct Args {
    const float *x, *g_mix_pre, *g_mix_post, *g_ffn_pre, *g_ffn_post, *w_in, *q_norm, *w_q_up, *kv_norm, *w_kv_up, *sinks, *rel, *w_o_mla, *w_o_swa, *w_out, *w_up, *conv_w, *conv_b, *w_down;
    float* out; unsigned char* ws; int ph_lo, ph_hi;
};

__device__ __forceinline__ unsigned f2bf(float f) { unsigned u = __builtin_bit_cast(unsigned, f); return (u + 0x7fffu + ((u >> 16) & 1u)) >> 16; }
__device__ __forceinline__ unsigned pk2(float lo, float hi) { return f2bf(lo) | (f2bf(hi) << 16); }
__device__ __forceinline__ float wave_sum(float v) {
#pragma unroll
    for (int o = 1; o < 64; o <<= 1) v += __shfl_xor(v, o);
    return v;
}
__device__ __forceinline__ void tr_item(const float* W, int K, int Nsrc, int k0, int nsrc0, bf16* WT, int drow0, int dstride, const float* gain, LAS float* scr, int lane) {
#pragma unroll 8
    for (int i = 0; i < 32; ++i) { const int kk = 2 * i + (lane >> 5); float v = W[(size_t)(k0 + kk) * Nsrc + nsrc0 + (lane & 31)]; if (gain) v *= gain[k0 + kk]; scr[kk * 33 + (lane & 31)] = v; }
    asm volatile("s_waitcnt lgkmcnt(0)" ::: "memory");
    const int c = lane & 7;
#pragma unroll
    for (int j = 0; j < 4; ++j) { const int n = (lane >> 3) + 8 * j; const LAS float* s = scr + (8 * c) * 33 + n;
        v4u o; o.x = pk2(s[0 * 33], s[1 * 33]); o.y = pk2(s[2 * 33], s[3 * 33]); o.z = pk2(s[4 * 33], s[5 * 33]); o.w = pk2(s[6 * 33], s[7 * 33]);
        *(v4u*)(WT + (size_t)(drow0 + n * dstride) * K + k0 + 8 * c) = o; }
    asm volatile("s_waitcnt lgkmcnt(0)" ::: "memory");
}

__global__ void __launch_bounds__(512) fwd_mega(Args a) {
    extern __shared__ __attribute__((aligned(16))) unsigned char lds_raw[];
    LAS unsigned char* lds = (LAS unsigned char*)lds_raw;
    cg::grid_group grid = cg::this_grid();
    const int tid = threadIdx.x, lane = tid & 63, wave = __builtin_amdgcn_readfirstlane(tid >> 6);
    const int G = gridDim.x, bx = blockIdx.x;
    const int vcu = (G % 8 == 0) ? (bx % 8) * (G / 8) + bx / 8 : bx;
    unsigned char* ws = a.ws;
    bf16 *Win_t = (bf16*)(ws + WS_WIN), *Wq_t = (bf16*)(ws + WS_WQ), *Wkv_t = (bf16*)(ws + WS_WKV), *WoA_t = (bf16*)(ws + WS_WOA), *WoB_t = (bf16*)(ws + WS_WOB),
         *Wout_t = (bf16*)(ws + WS_WOUT), *Wup_t = (bf16*)(ws + WS_WUP), *Wdn_t = (bf16*)(ws + WS_WDN);
    float* rope = (float*)(ws + WS_ROPE);
    float *ssqQ = (float*)(ws + WS_SSQQ), *ssqKV = (float*)(ws + WS_SSQKV), *ssqY = (float*)(ws + WS_SSQY), *ssqY2 = (float*)(ws + WS_SSQY2);
    bf16 *XN = (bf16*)(ws + WS_XN), *CQ = (bf16*)(ws + WS_CQ), *CKV = (bf16*)(ws + WS_CKV), *KR = (bf16*)(ws + WS_KR), *KS = (bf16*)(ws + WS_KS), *VS = (bf16*)(ws + WS_VS), *QS = (bf16*)(ws + WS_QS);
    bf16 *QN = (bf16*)(ws + WS_QN), *QR = (bf16*)(ws + WS_QR), *KN = (bf16*)(ws + WS_KN), *VV = (bf16*)(ws + WS_V), *MG = (bf16*)(ws + WS_MG), *GG = (bf16*)(ws + WS_G);
    bf16 *GT = (bf16*)(ws + WS_GT), *Y = (bf16*)(ws + WS_Y), *Y2 = (bf16*)(ws + WS_Y2), *H2 = (bf16*)(ws + WS_H2);
    float *X1 = (float*)(ws + WS_X1), *AH = (float*)(ws + WS_AH), *BH = (float*)(ws + WS_BH);
    const int gw = vcu * 8 + wave, NGW = G * 8;
    const int lo = a.ph_lo, hi = a.ph_hi;
#ifndef PHMASK
#define PHMASK 0xFFFF
#endif
#define IN(k) (((PHMASK >> (k)) & 1) && lo <= (k) && (k) < hi)
#define SEAM(k) do { if (IN(k) && IN((k) + 1)) { __threadfence(); grid.sync(); __builtin_amdgcn_fence(__ATOMIC_ACQUIRE, "agent"); asm volatile("s_waitcnt vmcnt(0) lgkmcnt(0)" ::: "memory"); __syncthreads(); } } while (0)

    if (IN(0)) {
        LAS float* scr = (LAS float*)(lds + wave * 16384);
        constexpr int I_IN = 32 * 234, I_Q = 8 * 96, I_KV = 4 * 128, I_O = 32 * 64, I_UP = 32 * 352, I_DN = 88 * 64;
        constexpr int NITEMS = I_IN + I_Q + I_KV + 3 * I_O + I_UP + I_DN;
        for (int it = gw; it < NITEMS; it += NGW) {
            int r = it;
            if (r < I_IN) { const int kb = r / 234, c = (r % 234) * 32; int d0, ds = 1;
                if (c < 768) d0 = c; else if (c < 832) { d0 = 768 + (c - 768) / 32; ds = 2; } else d0 = c + 192;
                tr_item(a.w_in, 2048, 7488, kb * 64, c, Win_t, d0, ds, nullptr, scr, lane); continue; } r -= I_IN;
            if (r < I_Q) { const int kb = r / 96, c = (r % 96) * 32, h = c / 192, w = c % 192; int d0, ds = 1;
                if (w < 128) d0 = 128 * h + w; else { d0 = 2048 + 64 * h + (w - 128) / 32; ds = 2; }
                tr_item(a.w_q_up, 512, 3072, kb * 64, c, Wq_t, d0, ds, a.q_norm, scr, lane); continue; } r -= I_Q;
            if (r < I_KV) { const int kb = r / 128, c = (r % 128) * 32, h = c / 256, w = c % 256;
                const int d0 = w < 128 ? 128 * h + w : 2048 + 128 * h + (w - 128);
                tr_item(a.w_kv_up, 256, 4096, kb * 64, c, Wkv_t, d0, 1, a.kv_norm, scr, lane); continue; } r -= I_KV;
            if (r < 3 * I_O) { const int wsel = r / I_O, q = r % I_O, kb = q / 64, c = (q % 64) * 32;
                tr_item(wsel == 0 ? a.w_o_mla : wsel == 1 ? a.w_o_swa : a.w_out, 2048, 2048, kb * 64, c, wsel == 0 ? WoA_t : wsel == 1 ? WoB_t : Wout_t, c, 1, nullptr, scr, lane); continue; } r -= 3 * I_O;
            if (r < I_UP) { const int kb = r / 352, c = (r % 352) * 32; int d0;
                if (c < DFF) d0 = 256 * (c / 128) + (c % 128); else { const int c2 = c - DFF; d0 = 256 * (c2 / 128) + 128 + (c2 % 128); }
                tr_item(a.w_up, 2048, 11264, kb * 64, c, Wup_t, d0, 1, nullptr, scr, lane); continue; } r -= I_UP;
            { const int kb = r / 64, c = (r % 64) * 32; tr_item(a.w_down, DFF, 2048, kb * 64, c, Wdn_t, c, 1, nullptr, scr, lane); }
        }
        for (int i = bx * 512 + tid; i < 192 * 2048 / 8; i += G * 512) *(v4u*)(Win_t + (size_t)832 * 2048 + (size_t)i * 8) = (v4u){0u, 0u, 0u, 0u};
        for (int i = bx * 512 + tid; i < SEQ * 32; i += G * 512) { const int pos = i >> 5, k = i & 31;
            const float inv = __builtin_amdgcn_exp2f(-(float)(2 * k) * (13.287712379549449f / 64.0f)); const float ang = (float)pos * inv;
            const double rev = (double)ang * 0.15915494309189535; const float fr = (float)(rev - __builtin_rint(rev));
            rope[2 * i] = __builtin_amdgcn_cosf(fr); rope[2 * i + 1] = __builtin_amdgcn_sinf(fr); }
        for (int m = gw; m < NTOK; m += NGW) {
            const f32x4* xr = (const f32x4*)(a.x + (size_t)m * DM) + lane; f32x4 v[8]; float s = 0.f;
#pragma unroll
            for (int j = 0; j < 8; ++j) { v[j] = xr[64 * j]; s += (v[j].x * v[j].x + v[j].y * v[j].y) + (v[j].z * v[j].z + v[j].w * v[j].w); }
            const float rs = 1.0f / sqrtf(wave_sum(s) * (1.f / DM) + EPS);
            unsigned long long* o8 = (unsigned long long*)(XN + (size_t)m * DM) + lane;
#pragma unroll
            for (int j = 0; j < 8; ++j) { const f32x4 g = *((const f32x4*)a.g_mix_pre + lane + 64 * j);
                o8[64 * j] = (unsigned long long)pk2(v[j].x * rs * g.x, v[j].y * rs * g.y) | ((unsigned long long)pk2(v[j].z * rs * g.z, v[j].w * rs * g.w) << 32); }
        }
    }
    SEAM(0);
    if (IN(1)) {
        pg8::Gemm g{XN, Win_t, NTOK, 3584, 2048}; pg8::StaticOrder S; S.init(NTOK, 3584, G, bx);
        ep::EpiIn E{CQ, CKV, KR, QS, KS, VS, ssqQ, ssqKV, rope};
        pg8::gemm_phase<ep::EpiIn, pg8::StaticOrder, true, true>(lds, g, S, E);
    }
    SEAM(1);
    if (IN(2)) {
        { pg8::Gemm g{CQ, Wq_t, NTOK, 3072, 512}; pg8::StaticOrder S; S.init(NTOK, 3072, G, bx);
          ep::EpiUp E{ssqQ, 8, 1.0f / 512.0f, QN, QR, 2048, 1024, 8, 1, rope};
          pg8::gemm_phase<ep::EpiUp, pg8::StaticOrder, true, true>(lds, g, S, E); }
        { pg8::Gemm g{CKV, Wkv_t, NTOK, 4096, 256}; pg8::StaticOrder S; S.init(NTOK, 4096, G, bx);
          ep::EpiUp E{ssqKV, 4, 1.0f / 256.0f, KN, VV, 2048, 2048, 8, 0, rope};
          pg8::gemm_phase<ep::EpiUp, pg8::StaticOrder, true, true>(lds, g, S, E); }
    }
    SEAM(2);
    if (IN(3)) {
        att::AttnP P{QN, QR, KN, KR, VV, QS, KS, VS, a.sinks, a.rel};
#ifndef NO_MLA
        for (int it = vcu; it < 1024; it += G) { const int bh = it >> 5, s = it & 31;
            att::attn_unit<true>(P, bh >> 4, bh & 15, 63 - s, (LAS char*)lds);
            att::attn_unit<true>(P, bh >> 4, bh & 15, s, (LAS char*)lds); }
#endif
#ifndef NO_SWA
        for (int it = vcu; it < 4096; it += G) { const int qb = it & 63, hq = (it >> 6) & 31, b = it >> 11;
            att::attn_unit<false>(P, b, hq, qb, (LAS char*)lds); }
#endif
    }
    SEAM(3);
    if (IN(4)) {
        pg8::Gemm g{XN, Win_t + (size_t)3584 * 2048, NTOK, 4096, 2048}; pg8::StaticOrder S; S.init(NTOK, 4096, G, bx);
        ep::EpiSig E{GT}; pg8::gemm_phase<ep::EpiSig, pg8::StaticOrder, true, true>(lds, g, S, E);
    }
    SEAM(4);
    if (IN(5)) {
        { pg8::Gemm g{QN, WoA_t, NTOK, 2048, 2048}; pg8::StaticOrder S; S.init(NTOK, 2048, G, bx);
          ep::EpiGate<false> E{GT, MG}; pg8::gemm_phase<ep::EpiGate<false>, pg8::StaticOrder, true, true>(lds, g, S, E); }
        { pg8::Gemm g{QS, WoB_t, NTOK, 2048, 2048}; pg8::StaticOrder S; S.init(NTOK, 2048, G, bx);
          ep::EpiGate<true> E{GT, MG}; pg8::gemm_phase<ep::EpiGate<true>, pg8::StaticOrder, true, true>(lds, g, S, E); }
    }
    SEAM(5);
    if (IN(6)) {
        pg8::Gemm g{MG, Wout_t, NTOK, 2048, 2048}; pg8::StaticOrder S; S.init(NTOK, 2048, G, bx);
        ep::EpiBfSsq E{Y, ssqY}; pg8::gemm_phase<ep::EpiBfSsq, pg8::StaticOrder, true, true>(lds, g, S, E);
    }
    SEAM(6);
    if (IN(7)) {
        for (int m = gw; m < NTOK; m += NGW) {
            float sy = ssqY[(size_t)m * 32 + (lane & 31)];
#pragma unroll
            for (int o = 1; o < 32; o <<= 1) sy += __shfl_xor(sy, o);
            const float rsy = 1.0f / sqrtf(sy * (1.f / DM) + EPS);
            const f32x4* xr = (const f32x4*)(a.x + (size_t)m * DM) + lane; const unsigned long long* yr = (const unsigned long long*)(Y + (size_t)m * DM) + lane;
            f32x4* outr = (f32x4*)(X1 + (size_t)m * DM) + lane; f32x4 v[8]; float s = 0.f;
#pragma unroll
            for (int j = 0; j < 8; ++j) { const f32x4 g = *((const f32x4*)a.g_mix_post + lane + 64 * j); const unsigned long long yw = yr[64 * j];
                const f32x4 yv = {__uint_as_float((unsigned)yw << 16), __uint_as_float((unsigned)yw & 0xffff0000u), __uint_as_float((unsigned)(yw >> 32) << 16), __uint_as_float((unsigned)(yw >> 32) & 0xffff0000u)};
                v[j] = xr[64 * j] + yv * rsy * g; outr[64 * j] = v[j];
                s += (v[j].x * v[j].x + v[j].y * v[j].y) + (v[j].z * v[j].z + v[j].w * v[j].w); }
            const float rs = 1.0f / sqrtf(wave_sum(s) * (1.f / DM) + EPS);
            unsigned long long* o8 = (unsigned long long*)(H2 + (size_t)m * DM) + lane;
#pragma unroll
            for (int j = 0; j < 8; ++j) { const f32x4 g = *((const f32x4*)a.g_ffn_pre + lane + 64 * j);
                o8[64 * j] = (unsigned long long)pk2(v[j].x * rs * g.x, v[j].y * rs * g.y) | ((unsigned long long)pk2(v[j].z * rs * g.z, v[j].w * rs * g.w) << 32); }
        }
    }
    SEAM(7);
    if (IN(8)) {
        pg8::Gemm g{H2, Wup_t, NTOK, 11264, 2048}; pg8::StaticOrder S; S.init(NTOK, 11264, G, bx);
        ep::EpiFfn E{GG, AH, BH, a.conv_w, a.conv_b}; pg8::gemm_phase<ep::EpiFfn, pg8::StaticOrder, true, true>(lds, g, S, E);
    }
    SEAM(8);
    if (IN(9)) {
        constexpr int NF4 = DFF / 4;
        for (int i = bx * 512 + tid; i < 1024 * NF4; i += G * 512) { const int f = (i % NF4) * 4, rj = i / NF4, jb = rj >> 1, ii = rj & 1; const bool first = (jb & 255) == 0;
            const f32x4 z = {0.f, 0.f, 0.f, 0.f};
            const f32x4 a0 = *(const f32x4*)(AH + ((size_t)jb * 4 + 2 + ii) * DFF + f);
            const f32x4 pm1 = first ? z : *(const f32x4*)(AH + ((size_t)(jb - 1) * 4 + 1) * DFF + f);
            const f32x4 pm2 = first ? z : *(const f32x4*)(AH + ((size_t)(jb - 1) * 4 + 0) * DFF + f);
            const f32x4 a1 = ii ? *(const f32x4*)(AH + ((size_t)jb * 4 + 2) * DFF + f) : pm1;
            const f32x4 a2 = ii ? pm1 : pm2;
            const f32x4 bv = *(const f32x4*)(BH + ((size_t)jb * 2 + ii) * DFF + f);
            const f32x4 c = *(const f32x4*)(a.conv_b + f) + *(const f32x4*)(a.conv_w + f) * a2 + *(const f32x4*)(a.conv_w + DFF + f) * a1 + *(const f32x4*)(a.conv_w + 2 * DFF + f) * a0;
            float o[4];
#pragma unroll
            for (int e = 0; e < 4; ++e) { const float x = c[e]; const float uu = 0.7978845608028654f * (x + 0.044715f * x * x * x);
                o[e] = x * __builtin_amdgcn_rcpf(1.f + __builtin_amdgcn_exp2f(-2.885390081777927f * uu)) * bv[e]; }
            *(unsigned long long*)(GG + ((size_t)jb * 64 + ii) * DFF + f) = (unsigned long long)pk2(o[0], o[1]) | ((unsigned long long)pk2(o[2], o[3]) << 32); }
    }
    SEAM(9);
    if (IN(10)) {
        pg8::Gemm g{GG, Wdn_t, NTOK, 2048, DFF}; pg8::StaticOrder S; S.init(NTOK, 2048, G, bx);
        ep::EpiBfSsq E{Y2, ssqY2}; pg8::gemm_phase<ep::EpiBfSsq, pg8::StaticOrder, true, true>(lds, g, S, E);
    }
    SEAM(10);
    if (IN(11)) {
        for (int m = gw; m < NTOK; m += NGW) {
            float sy = ssqY2[(size_t)m * 32 + (lane & 31)];
#pragma unroll
            for (int o = 1; o < 32; o <<= 1) sy += __shfl_xor(sy, o);
            const float rsy = 1.0f / sqrtf(sy * (1.f / DM) + EPS);
            const unsigned long long* yr = (const unsigned long long*)(Y2 + (size_t)m * DM) + lane; const f32x4* x1r = (const f32x4*)(X1 + (size_t)m * DM) + lane; f32x4* outr = (f32x4*)(a.out + (size_t)m * DM) + lane;
#pragma unroll
            for (int j = 0; j < 8; ++j) { const f32x4 g = *((const f32x4*)a.g_ffn_post + lane + 64 * j); const unsigned long long yw = yr[64 * j];
                const f32x4 yv = {__uint_as_float((unsigned)yw << 16), __uint_as_float((unsigned)yw & 0xffff0000u), __uint_as_float((unsigned)(yw >> 32) << 16), __uint_as_float((unsigned)(yw >> 32) & 0xffff0000u)};
                outr[64 * j] = x1r[64 * j] + yv * rsy * g; }
        }
    }
#undef IN
#undef SEAM
}

constexpr int LDS_BYTES = 147456;
extern "C" void kernel_launch(void* const* d_in, const int* in_sizes, int n_in, void* d_out, int out_size, void* d_ws, size_t ws_size, hipStream_t stream) {
    static int grid = 0;
    if (grid == 0) {
        if (n_in != 19 || in_sizes[0] != NTOK * DM || out_size != NTOK * DM || ws_size < WS_END) { fprintf(stderr, "kernel_launch: unexpected shapes (n_in %d, in0 %d, out %d, ws %zu)\n", n_in, n_in > 0 ? in_sizes[0] : -1, out_size, ws_size); grid = -1; return; }
        int dev = 0, cus = 0, per_cu = 0;
        hipGetDevice(&dev); hipDeviceGetAttribute(&cus, hipDeviceAttributeMultiprocessorCount, dev);
        if (hipFuncSetAttribute((const void*)fwd_mega, hipFuncAttributeMaxDynamicSharedMemorySize, LDS_BYTES) != hipSuccess) { fprintf(stderr, "kernel_launch: hipFuncSetAttribute failed\n"); grid = -1; return; }
        if (hipOccupancyMaxActiveBlocksPerMultiprocessor(&per_cu, (const void*)fwd_mega, 512, LDS_BYTES) != hipSuccess || per_cu < 1) { fprintf(stderr, "kernel_launch: occupancy query says %d\n", per_cu); per_cu = 1; }
        (void)hipGetLastError();
        grid = cus * 1;
        if (grid % 8 != 0 || grid <= 0) { fprintf(stderr, "kernel_launch: odd CU count %d\n", cus); }
    }
    if (grid < 0) return;
    Args a{};
    a.x = (const float*)d_in[0]; a.g_mix_pre = (const float*)d_in[1]; a.g_mix_post = (const float*)d_in[2]; a.g_ffn_pre = (const float*)d_in[3]; a.g_ffn_post = (const float*)d_in[4];
    a.w_in = (const float*)d_in[5]; a.q_norm = (const float*)d_in[6]; a.w_q_up = (const float*)d_in[7]; a.kv_norm = (const float*)d_in[8]; a.w_kv_up = (const float*)d_in[9];
    a.sinks = (const float*)d_in[10]; a.rel = (const float*)d_in[11]; a.w_o_mla = (const float*)d_in[12]; a.w_o_swa = (const float*)d_in[13]; a.w_out = (const float*)d_in[14];
    a.w_up = (const float*)d_in[15]; a.conv_w = (const float*)d_in[16]; a.conv_b = (const float*)d_in[17]; a.w_down = (const float*)d_in[18];
    a.out = (float*)d_out; a.ws = (unsigned char*)d_ws;
#ifndef NLAUNCH_SPLIT
#define NLAUNCH_SPLIT 0
#endif
    for (int ph = 0; ph < 12; ph += (NLAUNCH_SPLIT ? 1 : 12)) {
        a.ph_lo = ph; a.ph_hi = NLAUNCH_SPLIT ? ph + 1 : 12;
        void* args[] = {&a};
        hipError_t e = hipLaunchCooperativeKernel((const void*)fwd_mega, dim3(grid), dim3(512), args, LDS_BYTES, stream);
        if (e != hipSuccess) fprintf(stderr, "kernel_launch: cooperative launch failed: %s (grid %d)\n", hipGetErrorString(e), grid);
    }
}
```

```cpp
#include <hip/hip_runtime.h>
#include <hip/hip_cooperative_groups.h>
#include <cstdio>
#include <cstdint>
namespace cg = cooperative_groups;
namespace pg8 {
#define PG8_LAS __attribute__((address_space(3)))
typedef unsigned short bf16_t;
typedef short bf16x8 __attribute__((ext_vector_type(8)));
typedef float f32x4 __attribute__((ext_vector_type(4)));
typedef unsigned u32x4 __attribute__((ext_vector_type(4)));
constexpr int BM = 256, BK = 64, HALF = 128, HTB = HALF * BK * 2  , STAGE_BYTES = 8 * HTB, NXCD = 8, WGM = 8;

__host__ __device__ __forceinline__ int lds_byte(int r, int c) { const int st = (r >> 4) * 2 + (c >> 5), rr = r & 15, cc = c & 31, ob = rr * 64 + cc * 2; return st * 1024 + (ob ^ (((ob >> 9) & 1) << 5)); }
__host__ __device__ __forceinline__ void stage_rc(int b, int& R, int& C) { const int st = b / 1024, sb = b % 1024, swz = sb ^ (((sb >> 9) & 1) << 5); R = (st >> 1) * 16 + swz / 64; C = (st & 1) * 32 + (swz % 64) / 2; }
__host__ __device__ __forceinline__ int perm32(int rho) { const int n = rho >> 4, i = rho & 15; return 8 * (i >> 2) + 4 * n + (i & 3); }

struct Unit { int pm, pn; };
struct Gemm { const bf16_t* A; const bf16_t* Bt; int M, N, K; };

struct StaticOrder {
    int nM, nN, nwg, G, c;
    __host__ __device__ void init(int M, int N, int G_, int c_) { nM = M / BM; nN = N / BM; nwg = nM * nN; G = G_; c = c_; }
    __host__ __device__ bool next(int i, Unit& u) const {
        const long L = (long)i * G + c; if (L >= nwg) return false;
        int wgid = (int)L; { const int q = nwg / NXCD, r = nwg % NXCD, xcd = wgid % NXCD, off = wgid / NXCD; wgid = (xcd < r ? xcd * (q + 1) : r * (q + 1) + (xcd - r) * q) + off; }
        const int nig = WGM * nN, gid = wgid / nig, fm = gid * WGM, gsz = (nM - fm) < WGM ? (nM - fm) : WGM;
        u.pm = fm + ((wgid % nig) % gsz); u.pn = (wgid % nig) / gsz; return true;
    }
    __device__ __forceinline__ void a_ready(const Unit&) const {}
    __device__ __forceinline__ void done(const Unit&) const {}
};

typedef float f32x2_cv __attribute__((ext_vector_type(2))); typedef __bf16 bf16x2_cv __attribute__((ext_vector_type(2)));
__device__ __forceinline__ unsigned cvt_pk_bf16(float lo, float hi) { f32x2_cv v = {lo, hi}; bf16x2_cv b = __builtin_convertvector(v, bf16x2_cv); return __builtin_bit_cast(unsigned, b); }
template <class Epi, class Sched, bool ALIGN_EPI = false, bool SP2 = false>
__device__ __forceinline__ void gemm_phase(PG8_LAS unsigned char* lds, const Gemm g, const Sched& S, const Epi& E) {
    const int tid = threadIdx.x, wid = __builtin_amdgcn_readfirstlane(tid >> 6), lane = tid & 63, wr = wid >> 2, wc = wid & 3, fr = lane & 15, fq = lane >> 4;
    const int K = g.K, nt = K / BK;
    unsigned voffA[2], voffB[2];
#pragma unroll
    for (int i = 0; i < 2; ++i) { int R, C; stage_rc(tid * 16 + i * 8192, R, C); const int Rb = Epi::PERM ? ((R & ~31) + perm32(R & 31)) : R;
        voffA[i] = (unsigned)(R * K + C) * 2u; voffB[i] = (unsigned)(Rb * K + C) * 2u; }
    const size_t kstep = (size_t)(BK * 2);
    const size_t hstep = (size_t)HALF * K * 2;
    const size_t tstep = 2 * hstep;
    const unsigned ldsw = (unsigned)wid * 1024u;
    const int aoff = lds_byte(wr * 64 + fr, fq * 8), boff = lds_byte(wc * 32 + fr, fq * 8);
#define PG8_SA(b, h) (((b) * 2 + (h)) * HTB)
#define PG8_SB(b, h) ((4 + (b) * 2 + (h)) * HTB)
#define PG8_STAGE(bufoff, gbase, voff) do { _Pragma("unroll") for (int _i = 0; _i < 2; ++_i) \
        __builtin_amdgcn_global_load_lds((const unsigned*)((const char*)(gbase) + (voff)[_i]), (PG8_LAS unsigned*)(lds + (bufoff) + ldsw + _i * 8192), 16, 0, 0); } while (0)
#define PG8_LDA(dst, b, h) do { _Pragma("unroll") for (int m = 0; m < 4; ++m) _Pragma("unroll") for (int k = 0; k < 2; ++k) dst[m][k] = *(const PG8_LAS bf16x8*)(lds + PG8_SA(b, h) + aoff + m * 2048 + k * 1024); } while (0)
#define PG8_LDB(dst, b, h) do { _Pragma("unroll") for (int n = 0; n < 2; ++n) _Pragma("unroll") for (int k = 0; k < 2; ++k) dst[n][k] = *(const PG8_LAS bf16x8*)(lds + PG8_SB(b, h) + boff + n * 2048 + k * 1024); } while (0)
#define PG8_MMA(ai, bj, At, Bt) do { __builtin_amdgcn_s_setprio(1); _Pragma("unroll") for (int m = 0; m < 4; ++m) _Pragma("unroll") for (int n = 0; n < 2; ++n) _Pragma("unroll") for (int k = 0; k < 2; ++k) \
        acc[ai][bj][m][n] = __builtin_amdgcn_mfma_f32_16x16x32_bf16(Bt[n][k], At[m][k], acc[ai][bj][m][n], 0, 0, 0); __builtin_amdgcn_s_setprio(0); } while (0)
#define PG8_WAIT_V(n) asm volatile("s_waitcnt vmcnt(" #n ")" ::: "memory")
#define PG8_WAIT_L(n) asm volatile("s_waitcnt lgkmcnt(" #n ")" ::: "memory")
#define PG8_BAR __builtin_amdgcn_s_barrier()
#define PG8_SCHED __builtin_amdgcn_sched_barrier(0)
    Unit cur, nxt; int ui = 0;
    if (!S.next(0, cur)) return;
    f32x4 acc[2][2][4][2];
#pragma unroll
    for (int a = 0; a < 2; ++a)
#pragma unroll
        for (int b = 0; b < 2; ++b)
#pragma unroll
            for (int m = 0; m < 4; ++m)
#pragma unroll
                for (int n = 0; n < 2; ++n) acc[a][b][m][n] = (f32x4){0.f, 0.f, 0.f, 0.f};
    bf16x8 At[4][2], B0[2][2], B1[2][2];
    const char* cA = (const char*)g.A + (size_t)cur.pm * tstep; const char* cB = (const char*)g.Bt + (size_t)cur.pn * tstep;
    S.a_ready(cur);
    if constexpr (SP2) {
        PG8_STAGE(PG8_SB(0, 0), cB, voffB); PG8_STAGE(PG8_SB(0, 1), cB + hstep, voffB); PG8_STAGE(PG8_SA(0, 0), cA, voffA); PG8_STAGE(PG8_SA(0, 1), cA + hstep, voffA);
        PG8_STAGE(PG8_SB(1, 0), cB + kstep, voffB); PG8_STAGE(PG8_SA(1, 0), cA + kstep, voffA); PG8_STAGE(PG8_SB(1, 1), cB + hstep + kstep, voffB);
        PG8_WAIT_V(0); PG8_WAIT_L(0); PG8_BAR;
        if (wr == 1) PG8_BAR;
    } else {
        PG8_STAGE(PG8_SB(0, 0), cB, voffB); PG8_STAGE(PG8_SA(0, 0), cA, voffA); PG8_STAGE(PG8_SB(0, 1), cB + hstep, voffB); PG8_STAGE(PG8_SA(0, 1), cA + hstep, voffA);
        if (wr == 1) PG8_BAR;
        PG8_WAIT_V(4); PG8_BAR;
        PG8_STAGE(PG8_SB(1, 0), cB + kstep, voffB); PG8_STAGE(PG8_SA(1, 0), cA + kstep, voffA); PG8_STAGE(PG8_SB(1, 1), cB + hstep + kstep, voffB);
        PG8_WAIT_V(6); PG8_BAR;
    }
    for (;;) {
        const bool has_next = S.next(ui + 1, nxt);
        const char* nA = has_next ? (const char*)g.A + (size_t)nxt.pm * tstep : cA; const char* nB = has_next ? (const char*)g.Bt + (size_t)nxt.pn * tstep : cB;
        for (int t = 0; t < nt; t += 2) {
            const bool last = (t == nt - 2);
            const char* a1 = cA + (size_t)(t + 1) * kstep;
            const char* a2 = last ? nA : cA + (size_t)(t + 2) * kstep; const char* b2 = last ? nB : cB + (size_t)(t + 2) * kstep;
            const char* a3 = a2 + kstep; const char* b3 = b2 + kstep;
            if (last && has_next) S.a_ready(nxt);
            if constexpr (SP2) {
            PG8_LDB(B0, 0, 0); PG8_LDB(B1, 0, 1); PG8_SCHED; PG8_LDA(At, 0, 0); PG8_STAGE(PG8_SA(1, 1), a1 + hstep, voffA);
            PG8_WAIT_V(8); PG8_WAIT_L(0); PG8_BAR; PG8_MMA(0, 0, At, B0); PG8_MMA(0, 1, At, B1); PG8_BAR; PG8_SCHED;
            PG8_LDA(At, 0, 1); PG8_STAGE(PG8_SB(0, 0), b2, voffB); PG8_STAGE(PG8_SB(0, 1), b2 + hstep, voffB); PG8_STAGE(PG8_SA(0, 0), a2, voffA);
            PG8_WAIT_V(8); PG8_WAIT_L(0); PG8_BAR; PG8_MMA(1, 0, At, B0); PG8_MMA(1, 1, At, B1); PG8_BAR; PG8_SCHED;
            PG8_LDB(B0, 1, 0); PG8_LDB(B1, 1, 1); PG8_SCHED; PG8_LDA(At, 1, 0); PG8_STAGE(PG8_SA(0, 1), a2 + hstep, voffA);
            PG8_WAIT_V(8); PG8_WAIT_L(0); PG8_BAR; PG8_MMA(0, 0, At, B0); PG8_MMA(0, 1, At, B1); PG8_BAR; PG8_SCHED;
            PG8_LDA(At, 1, 1); PG8_STAGE(PG8_SB(1, 0), b3, voffB); PG8_STAGE(PG8_SB(1, 1), b3 + hstep, voffB); PG8_STAGE(PG8_SA(1, 0), a3, voffA);
            PG8_WAIT_V(8); PG8_WAIT_L(0); PG8_BAR; PG8_MMA(1, 0, At, B0); PG8_MMA(1, 1, At, B1); PG8_BAR; PG8_SCHED;
            } else {
            PG8_LDB(B0, 0, 0); PG8_SCHED; PG8_LDA(At, 0, 0); PG8_STAGE(PG8_SA(1, 1), a1 + hstep, voffA);
            PG8_WAIT_L(8); PG8_BAR; PG8_WAIT_L(0); PG8_MMA(0, 0, At, B0); PG8_BAR; PG8_SCHED;
            PG8_LDB(B1, 0, 1); PG8_STAGE(PG8_SB(0, 0), b2, voffB);
            PG8_BAR; PG8_WAIT_L(0); PG8_MMA(0, 1, At, B1); PG8_BAR;
            PG8_LDA(At, 0, 1); PG8_STAGE(PG8_SA(0, 0), a2, voffA);
            PG8_BAR; PG8_WAIT_L(0); PG8_MMA(1, 0, At, B0); PG8_BAR; PG8_SCHED;
            PG8_STAGE(PG8_SB(0, 1), b2 + hstep, voffB);
            PG8_WAIT_V(6); PG8_BAR; PG8_MMA(1, 1, At, B1); PG8_BAR;
            PG8_LDB(B0, 1, 0); PG8_SCHED; PG8_LDA(At, 1, 0); PG8_STAGE(PG8_SA(0, 1), a2 + hstep, voffA);
            PG8_WAIT_L(8); PG8_BAR; PG8_WAIT_L(0); PG8_MMA(0, 0, At, B0); PG8_BAR; PG8_SCHED;
            PG8_LDB(B1, 1, 1); PG8_STAGE(PG8_SB(1, 0), b3, voffB);
            PG8_BAR; PG8_WAIT_L(0); PG8_MMA(0, 1, At, B1); PG8_BAR;
            PG8_LDA(At, 1, 1); PG8_STAGE(PG8_SA(1, 0), a3, voffA);
            PG8_BAR; PG8_WAIT_L(0); PG8_MMA(1, 0, At, B0); PG8_BAR; PG8_SCHED;
            PG8_STAGE(PG8_SB(1, 1), b3 + hstep, voffB);
            PG8_WAIT_V(6); PG8_BAR; PG8_MMA(1, 1, At, B1); PG8_BAR;
            }
        }
        if constexpr (ALIGN_EPI) { if (wr == 0) PG8_BAR; }
        if constexpr (!Epi::AFTER_DRAIN) { E(acc, cur, wr, wc, fr, fq); S.done(cur); }
        if (!has_next) break;
#pragma unroll
        for (int a = 0; a < 2; ++a)
#pragma unroll
            for (int b = 0; b < 2; ++b)
#pragma unroll
                for (int m = 0; m < 4; ++m)
#pragma unroll
                    for (int n = 0; n < 2; ++n) acc[a][b][m][n] = (f32x4){0.f, 0.f, 0.f, 0.f};
        cur = nxt; cA = nA; cB = nB; ++ui;
        if constexpr (ALIGN_EPI) { if (wr == 1) PG8_BAR; }
    }
    PG8_WAIT_V(0);
    if constexpr (!ALIGN_EPI) { if (wr == 0) PG8_BAR; }
    PG8_BAR;
    if constexpr (Epi::AFTER_DRAIN) { E.fused(acc, cur, wr, wc, fr, fq, lds, wid, lane); S.done(cur); }
#undef PG8_SA
#undef PG8_SB
#undef PG8_STAGE
#undef PG8_LDA
#undef PG8_LDB
#undef PG8_MMA
#undef PG8_WAIT_V
#undef PG8_WAIT_L
#undef PG8_BAR
#undef PG8_SCHED
}
}
constexpr int SEQ = 16384, NTOK = 32768, DM = 2048, DFF = 5632;
constexpr float EPS = 1e-6f;
#define GAS __attribute__((address_space(1)))
#define LAS __attribute__((address_space(3)))

namespace ep {
using namespace pg8;
typedef float f32x2 __attribute__((ext_vector_type(2)));
__device__ __forceinline__ u32x4 pack8(const f32x4 a, const f32x4 b) { u32x4 w; w.x = cvt_pk_bf16(a[0], a[1]); w.y = cvt_pk_bf16(a[2], a[3]); w.z = cvt_pk_bf16(b[0], b[1]); w.w = cvt_pk_bf16(b[2], b[3]); return w; }
__device__ __forceinline__ float bflo(unsigned u) { return __uint_as_float(u << 16); }
__device__ __forceinline__ float bfhi(unsigned u) { return __uint_as_float(u & 0xffff0000u); }
__device__ __forceinline__ void unpack8(const u32x4 w, f32x4& a, f32x4& b) { a = (f32x4){bflo(w.x), bfhi(w.x), bflo(w.y), bfhi(w.y)}; b = (f32x4){bflo(w.z), bfhi(w.z), bflo(w.w), bfhi(w.w)}; }
__device__ __forceinline__ float sigmoidf_(float x) { return __builtin_amdgcn_rcpf(1.f + __builtin_amdgcn_exp2f(-1.4426950408889634f * x)); }
__device__ __forceinline__ float ssq4(const f32x4 x) { return (x[0] * x[0] + x[1] * x[1]) + (x[2] * x[2] + x[3] * x[3]); }
__device__ __forceinline__ void rope8(f32x4& v0, f32x4& v1, const f32x4 csA, const f32x4 csB) {
    const float a0 = v0[0] * csA[0] - v0[1] * csA[1], b0 = v0[1] * csA[0] + v0[0] * csA[1];
    const float a1 = v0[2] * csA[2] - v0[3] * csA[3], b1 = v0[3] * csA[2] + v0[2] * csA[3];
    const float a2 = v1[0] * csB[0] - v1[1] * csB[1], b2 = v1[1] * csB[0] + v1[0] * csB[1];
    const float a3 = v1[2] * csB[2] - v1[3] * csB[3], b3 = v1[3] * csB[2] + v1[2] * csB[3];
    v0 = (f32x4){a0, b0, a1, b1}; v1 = (f32x4){a2, b2, a3, b3};
}

struct EpiIn {
    static constexpr bool PERM = true, AFTER_DRAIN = false;
    bf16_t *CQ, *CKV, *KR, *QS, *KS, *VS; float *ssqQ, *ssqKV; const float* rope;
    __device__ __forceinline__ void operator()(const f32x4 (&acc)[2][2][4][2], const Unit& u, int wr, int wc, int fr, int fq) const {
        const int pn = u.pn, row0 = u.pm * BM + wr * 64 + fr, cw = wc * 32 + 8 * fq;
        if (pn < 3) {
            float* sq = pn < 2 ? ssqQ : ssqKV; const int nslot = pn < 2 ? 8 : 4, slot = (pn < 2 ? pn * 4 : 0) + wc, ldc = pn < 2 ? 512 : 256;
            bf16_t* base = pn < 2 ? CQ + pn * 256 : CKV;
#pragma unroll
            for (int ai = 0; ai < 2; ++ai)
#pragma unroll
                for (int m = 0; m < 4; ++m) { const int row = row0 + ai * HALF + m * 16;
                    float s = (ssq4(acc[ai][0][m][0]) + ssq4(acc[ai][0][m][1])) + (ssq4(acc[ai][1][m][0]) + ssq4(acc[ai][1][m][1]));
                    s += __shfl_xor(s, 16); s += __shfl_xor(s, 32);
                    if (fq == 0) sq[(size_t)row * nslot + slot] = s;
#pragma unroll
                    for (int bj = 0; bj < 2; ++bj) *(u32x4*)(base + (size_t)row * ldc + bj * HALF + cw) = pack8(acc[ai][bj][m][0], acc[ai][bj][m][1]); }
        } else if (pn == 3) {
            if (wc < 2) {
#pragma unroll
                for (int ai = 0; ai < 2; ++ai)
#pragma unroll
                    for (int m = 0; m < 4; ++m) { const int row = row0 + ai * HALF + m * 16; const int pos = row & (SEQ - 1);
                        const float* cs = rope + ((size_t)pos * 32 + 16 * wc + 4 * fq) * 2;
                        const f32x4 csA = *(const f32x4*)cs, csB = *(const f32x4*)(cs + 4);
                        f32x4 v0 = acc[ai][0][m][0], v1 = acc[ai][0][m][1]; rope8(v0, v1, csA, csB);
                        *(u32x4*)(KR + (size_t)row * 64 + cw) = pack8(v0, v1); }
            }
        } else if (pn < 14) {
            bf16_t* base; int ldc;
            if (pn < 12) { base = QS + (pn - 4) * 256; ldc = 2048; } else if (pn == 12) { base = KS; ldc = 256; } else { base = VS; ldc = 256; }
#pragma unroll
            for (int ai = 0; ai < 2; ++ai)
#pragma unroll
                for (int m = 0; m < 4; ++m) { const int row = row0 + ai * HALF + m * 16;
#pragma unroll
                    for (int bj = 0; bj < 2; ++bj) *(u32x4*)(base + (size_t)row * ldc + bj * HALF + cw) = pack8(acc[ai][bj][m][0], acc[ai][bj][m][1]); }
        }
    }
};

struct EpiSig {
    static constexpr bool PERM = true, AFTER_DRAIN = false;
    bf16_t* GT;
    __device__ __forceinline__ void operator()(const f32x4 (&acc)[2][2][4][2], const Unit& u, int wr, int wc, int fr, int fq) const {
        const int row0 = u.pm * BM + wr * 64 + fr, cw = wc * 32 + 8 * fq; bf16_t* base = GT + u.pn * 256;
#pragma unroll
        for (int ai = 0; ai < 2; ++ai)
#pragma unroll
            for (int m = 0; m < 4; ++m) { const int row = row0 + ai * HALF + m * 16;
#pragma unroll
                for (int bj = 0; bj < 2; ++bj) { f32x4 v0 = acc[ai][bj][m][0], v1 = acc[ai][bj][m][1];
#pragma unroll
                    for (int e = 0; e < 4; ++e) { v0[e] = sigmoidf_(v0[e]); v1[e] = sigmoidf_(v1[e]); }
                    *(u32x4*)(base + (size_t)row * 4096 + bj * HALF + cw) = pack8(v0, v1); } }
    }
};

struct EpiUp {
    static constexpr bool PERM = true, AFTER_DRAIN = false;
    const float* ssq; int nslot; float invK; bf16_t* O0; bf16_t* O1; int ld0, ld1, split; int rope1; const float* rope; float oscale;
    __device__ __forceinline__ void operator()(const f32x4 (&acc)[2][2][4][2], const Unit& u, int wr, int wc, int fr, int fq) const {
        const int pn = u.pn, row0 = u.pm * BM + wr * 64 + fr, cw = wc * 32 + 8 * fq;
        const int t = pn < split ? 0 : 1; bf16_t* base = t ? O1 + (pn - split) * 256 : O0 + pn * 256; const int ld = t ? ld1 : ld0;
        const bool dorope = (t == 1) && rope1;
#pragma unroll
        for (int ai = 0; ai < 2; ++ai)
#pragma unroll
            for (int m = 0; m < 4; ++m) { const int row = row0 + ai * HALF + m * 16;
                float s;
                if (nslot == 8) { const f32x4 a = *(const f32x4*)(ssq + (size_t)row * 8), b = *(const f32x4*)(ssq + (size_t)row * 8 + 4); s = ((a[0] + a[1]) + (a[2] + a[3])) + ((b[0] + b[1]) + (b[2] + b[3])); }
                else { const f32x4 a = *(const f32x4*)(ssq + (size_t)row * 4); s = (a[0] + a[1]) + (a[2] + a[3]); }
                const float rs = oscale / sqrtf(s * invK + EPS);
                f32x4 csA = {1.f, 0.f, 1.f, 0.f}, csB = {1.f, 0.f, 1.f, 0.f};
                if (dorope) { const int pos = row & (SEQ - 1); const float* cs = rope + ((size_t)pos * 32 + 16 * (wc & 1) + 4 * fq) * 2; csA = *(const f32x4*)cs; csB = *(const f32x4*)(cs + 4); }
#pragma unroll
                for (int bj = 0; bj < 2; ++bj) { f32x4 v0 = acc[ai][bj][m][0] * rs, v1 = acc[ai][bj][m][1] * rs;
                    if (dorope) rope8(v0, v1, csA, csB);
                    *(u32x4*)(base + (size_t)row * ld + bj * HALF + cw) = pack8(v0, v1); } }
    }
};

template <bool SECOND> struct EpiGate {
    static constexpr bool PERM = true, AFTER_DRAIN = false;
    const bf16_t* GT; bf16_t* MG;
    __device__ __forceinline__ void operator()(const f32x4 (&acc)[2][2][4][2], const Unit& u, int wr, int wc, int fr, int fq) const {
        const int row0 = u.pm * BM + wr * 64 + fr, col0 = u.pn * BM + wc * 32 + 8 * fq;
#pragma unroll
        for (int ai = 0; ai < 2; ++ai)
#pragma unroll
            for (int m = 0; m < 4; ++m) { const int row = row0 + ai * HALF + m * 16;
#pragma unroll
                for (int bj = 0; bj < 2; ++bj) { const int col = col0 + bj * HALF;
                    const u32x4 gw = *(const u32x4*)(GT + (size_t)row * 4096 + (SECOND ? 2048 : 0) + col); f32x4 g0, g1; unpack8(gw, g0, g1);
                    f32x4 v0 = acc[ai][bj][m][0] * g0, v1 = acc[ai][bj][m][1] * g1;
                    bf16_t* p = MG + (size_t)row * DM + col;
                    if (SECOND) { const u32x4 pw = *(const u32x4*)p; f32x4 p0, p1; unpack8(pw, p0, p1); v0 += p0; v1 += p1; }
                    *(u32x4*)p = pack8(v0, v1); } }
    }
};

struct EpiBfSsq {
    static constexpr bool PERM = true, AFTER_DRAIN = false;
    bf16_t* Y; float* ssq;
    __device__ __forceinline__ void operator()(const f32x4 (&acc)[2][2][4][2], const Unit& u, int wr, int wc, int fr, int fq) const {
        const int row0 = u.pm * BM + wr * 64 + fr, col0 = u.pn * BM + wc * 32 + 8 * fq;
#pragma unroll
        for (int ai = 0; ai < 2; ++ai)
#pragma unroll
            for (int m = 0; m < 4; ++m) { const int row = row0 + ai * HALF + m * 16;
                float s = (ssq4(acc[ai][0][m][0]) + ssq4(acc[ai][0][m][1])) + (ssq4(acc[ai][1][m][0]) + ssq4(acc[ai][1][m][1]));
                s += __shfl_xor(s, 16); s += __shfl_xor(s, 32);
                if (fq == 0) ssq[(size_t)row * 32 + u.pn * 4 + wc] = s;
#pragma unroll
                for (int bj = 0; bj < 2; ++bj) *(u32x4*)(Y + (size_t)row * DM + col0 + bj * HALF) = pack8(acc[ai][bj][m][0], acc[ai][bj][m][1]); }
    }
};

struct EpiFfn {
    static constexpr bool PERM = true, AFTER_DRAIN = false;
    bf16_t* G; float* AH; float* BH; const float* cw; const float* cb;
    __device__ __forceinline__ void operator()(const f32x4 (&acc)[2][2][4][2], const Unit& u, int wr, int wc, int fr, int fq) const {
        const int lane = threadIdx.x & 63;
        const int f0 = u.pn * 128 + wc * 32 + 8 * fq;
        f32x4 w0[2], w1[2], w2[2], bb[2];
#pragma unroll
        for (int n = 0; n < 2; ++n) { w0[n] = *(const f32x4*)(cw + f0 + 4 * n); w1[n] = *(const f32x4*)(cw + DFF + f0 + 4 * n); w2[n] = *(const f32x4*)(cw + 2 * DFF + f0 + 4 * n); bb[n] = *(const f32x4*)(cb + f0 + 4 * n); }
        const int src1 = (lane & 48) | ((fr - 1) & 15), src2 = (lane & 48) | ((fr - 2) & 15);
#pragma unroll
        for (int ai = 0; ai < 2; ++ai) {
            const int jb = u.pm * 4 + ai * 2 + wr;
            f32x4 p1[2], p2[2];
#pragma unroll
            for (int n = 0; n < 2; ++n) { p1[n] = (f32x4){0.f, 0.f, 0.f, 0.f}; p2[n] = p1[n]; }
#pragma unroll
            for (int m = 0; m < 4; ++m) {
                f32x4 o[2];
#pragma unroll
                for (int n = 0; n < 2; ++n) { f32x4 r1, r2;
#pragma unroll
                    for (int e = 0; e < 4; ++e) { const float a0 = acc[ai][0][m][n][e]; r1[e] = __shfl(a0, src1); r2[e] = __shfl(a0, src2); }
                    f32x4 a1, a2;
#pragma unroll
                    for (int e = 0; e < 4; ++e) { a1[e] = fr >= 1 ? r1[e] : p1[n][e]; a2[e] = fr >= 2 ? r2[e] : p2[n][e]; }
                    p1[n] = r1; p2[n] = r2;
                    const f32x4 c = bb[n] + w0[n] * a2 + w1[n] * a1 + w2[n] * acc[ai][0][m][n];
#pragma unroll
                    for (int e = 0; e < 4; ++e) { const float x = c[e]; const float uu = 0.7978845608028654f * (x + 0.044715f * x * x * x);
                        const float gl = x * __builtin_amdgcn_rcpf(1.f + __builtin_amdgcn_exp2f(-2.885390081777927f * uu)); o[n][e] = gl * acc[ai][1][m][n][e]; } }
                const int row = u.pm * BM + ai * HALF + wr * 64 + m * 16 + fr;
                if (!(m == 0 && fr < 2)) *(u32x4*)(G + (size_t)row * DFF + f0) = pack8(o[0], o[1]);
                if (m == 0 && fr < 2) { float* ah = AH + ((size_t)jb * 4 + 2 + fr) * DFF + f0; *(f32x4*)ah = acc[ai][0][0][0]; *(f32x4*)(ah + 4) = acc[ai][0][0][1];
                    float* bh = BH + ((size_t)jb * 2 + fr) * DFF + f0; *(f32x4*)bh = acc[ai][1][0][0]; *(f32x4*)(bh + 4) = acc[ai][1][0][1]; }
                if (m == 3 && fr >= 14) { float* ah = AH + ((size_t)jb * 4 + (fr - 14)) * DFF + f0; *(f32x4*)ah = acc[ai][0][3][0]; *(f32x4*)(ah + 4) = acc[ai][0][3][1]; }
            }
        }
    }
};
}
namespace att {
typedef short bf16x8 __attribute__((ext_vector_type(8)));
typedef short s16x4 __attribute__((ext_vector_type(4)));
typedef float f32x16 __attribute__((ext_vector_type(16)));
typedef float f32x4 __attribute__((ext_vector_type(4)));
typedef unsigned u32x4 __attribute__((ext_vector_type(4)));
typedef unsigned short bf16_t;
#define SBAR() __builtin_amdgcn_sched_barrier(0)
#define KSWZ(row, colB) ((row) * 256 + ((colB) ^ (((row) & 7) << 4)))
#define KSWZ64(row, chunk) ((row) * 128 + ((((chunk) ^ ((row) & 7))) << 4))
template <int NCB> __device__ __forceinline__ int v_st(int k, int c) { const int kk = (k & ~0xC) | ((k & 4) << 1) | ((k & 8) >> 1); return ((kk >> 3) * NCB + (c >> 5)) * 512 + ((kk & 7) * 32 + (c & 31)) * 2; }
__device__ __forceinline__ int v_rd_base(int lane) { return ((lane & 3) << 3) | (((lane >> 2) & 3) << 6) | (((lane >> 4) & 1) << 5) | (((lane >> 5) & 1) << 8); }
__device__ __forceinline__ int crow(int r, int hi) { return (r & 3) + 8 * (r >> 2) + 4 * hi; }
typedef float f32x2_cv __attribute__((ext_vector_type(2))); typedef __bf16 bf16x2_cv __attribute__((ext_vector_type(2)));
__device__ __forceinline__ unsigned cvtpk(float lo, float hi) { f32x2_cv v = {lo, hi}; bf16x2_cv b = __builtin_convertvector(v, bf16x2_cv); return __builtin_bit_cast(unsigned, b); }
__device__ __forceinline__ void mask_tile(f32x16& p0, f32x16& p1, int dq, unsigned W) {
    const float NEG = -__builtin_inff();
#pragma unroll
    for (int r = 0; r < 16; ++r) { const int c = (r & 3) + 8 * (r >> 2);
        if ((unsigned)(dq - c) >= W) p0[r] = NEG;
        if ((unsigned)(dq - c - 32) >= W) p1[r] = NEG; }
}
constexpr float THR = 8.f;
template <int SCALE_E6> __device__ __forceinline__ void partialSM(f32x16& p0, f32x16& p1, float& m_reg, float& mn, float& alpha) {
    constexpr float SCALE = SCALE_E6 * 1e-9f; constexpr float C2 = 1.4426950408889634f * SCALE;
    float pmax = p0[0];
#pragma unroll
    for (int r = 1; r < 16; ++r) pmax = fmaxf(pmax, p0[r]);
#pragma unroll
    for (int r = 0; r < 16; ++r) pmax = fmaxf(pmax, p1[r]);
    { auto rr = __builtin_amdgcn_permlane32_swap(__float_as_uint(pmax), __float_as_uint(pmax), false, false);
      pmax = fmaxf(__uint_as_float(rr[0]), __uint_as_float(rr[1])); }
    if (__builtin_expect(__all((pmax - m_reg) * SCALE <= THR), 1)) { mn = m_reg; alpha = 1.f; }
    else { mn = fmaxf(m_reg, pmax); alpha = __builtin_amdgcn_exp2f((m_reg - mn) * C2); m_reg = mn; }
    const float mnL = -mn * C2;
#pragma unroll
    for (int r = 0; r < 16; ++r) p0[r] = fmaf(p0[r], C2, mnL);
#pragma unroll
    for (int r = 0; r < 16; ++r) p1[r] = fmaf(p1[r], C2, mnL);
#pragma unroll
    for (int r = 0; r < 16; ++r) p0[r] = __builtin_amdgcn_exp2f(p0[r]);
}
__device__ __forceinline__ void partialSM_pre(f32x16& p0, f32x16& p1, float& m_reg, float& alpha) {
    constexpr float THR2 = THR * 1.4426950408889634f;
    float pmax = p0[0];
#pragma unroll
    for (int r = 1; r < 16; ++r) pmax = fmaxf(pmax, p0[r]);
#pragma unroll
    for (int r = 0; r < 16; ++r) pmax = fmaxf(pmax, p1[r]);
    { auto rr = __builtin_amdgcn_permlane32_swap(__float_as_uint(pmax), __float_as_uint(pmax), false, false);
      pmax = fmaxf(__uint_as_float(rr[0]), __uint_as_float(rr[1])); }
    if (__builtin_expect(__all(pmax <= THR2), 1)) { alpha = 1.f; }
    else { const float d = fmaxf(pmax, 0.f); m_reg += d; alpha = __builtin_amdgcn_exp2f(-d);
#pragma unroll
        for (int r = 0; r < 16; ++r) { p0[r] -= d; p1[r] -= d; } }
#pragma unroll
    for (int r = 0; r < 16; ++r) p0[r] = __builtin_amdgcn_exp2f(p0[r]);
}
__device__ __forceinline__ void finishSM(f32x16& p0, f32x16& p1, float alpha, float& l_reg, bf16x8& pa0, bf16x8& pa1, bf16x8& pa2, bf16x8& pa3) {
#pragma unroll
    for (int r = 0; r < 16; ++r) p1[r] = __builtin_amdgcn_exp2f(p1[r]);
    float ps = 0;
#pragma unroll
    for (int r = 0; r < 16; ++r) ps += p0[r];
#pragma unroll
    for (int r = 0; r < 16; ++r) ps += p1[r];
    { auto rr = __builtin_amdgcn_permlane32_swap(__float_as_uint(ps), __float_as_uint(ps), false, false);
      ps = __uint_as_float(rr[0]) + __uint_as_float(rr[1]); }
    l_reg = l_reg * alpha + ps;
#define PK4(P, B_, OUT) do { unsigned a0 = cvtpk(P[B_+0], P[B_+1]), a1 = cvtpk(P[B_+2], P[B_+3]);                          \
        unsigned b0 = cvtpk(P[B_+4], P[B_+5]), b1 = cvtpk(P[B_+6], P[B_+7]);                                             \
        auto r0 = __builtin_amdgcn_permlane32_swap(a0, b0, false, false); auto r1 = __builtin_amdgcn_permlane32_swap(a1, b1, false, false); \
        u32x4 w = {r0[0], r1[0], r0[1], r1[1]}; OUT = *reinterpret_cast<bf16x8*>(&w); } while (0)
    PK4(p0, 0, pa0); PK4(p0, 8, pa1); PK4(p1, 0, pa2); PK4(p1, 8, pa3);
#undef PK4
}
__device__ __forceinline__ void qk128(f32x16& p0, f32x16& p1, const LAS char* kl, int r32, int hi, const bf16x8* qr) {
    const LAS char* kb[4];
#pragma unroll
    for (int dd = 0; dd < 4; ++dd) kb[dd] = kl + KSWZ(r32, (dd * 16 + hi * 8) * 2);
#pragma unroll
    for (int d0 = 0; d0 < 8; ++d0) { const LAS char* a = kb[d0 & 3] + (d0 >> 2) * 128;
        const bf16x8 b0 = *reinterpret_cast<const LAS bf16x8*>(a);
        const bf16x8 b1 = *reinterpret_cast<const LAS bf16x8*>(a + 32 * 256);
        p0 = __builtin_amdgcn_mfma_f32_32x32x16_bf16(b0, qr[d0], p0, 0, 0, 0);
        p1 = __builtin_amdgcn_mfma_f32_32x32x16_bf16(b1, qr[d0], p1, 0, 0, 0); }
}
__device__ __forceinline__ void qk64(f32x16& p0, f32x16& p1, const LAS char* kl, int r32, int hi, const bf16x8* qr) {
#pragma unroll
    for (int ks = 0; ks < 4; ++ks) { const LAS char* a = kl + KSWZ64(r32, 2 * ks + hi);
        const bf16x8 b0 = *reinterpret_cast<const LAS bf16x8*>(a);
        const bf16x8 b1 = *reinterpret_cast<const LAS bf16x8*>(a + 32 * 128);
        p0 = __builtin_amdgcn_mfma_f32_32x32x16_bf16(b0, qr[ks], p0, 0, 0, 0);
        p1 = __builtin_amdgcn_mfma_f32_32x32x16_bf16(b1, qr[ks], p1, 0, 0, 0); }
}
__device__ __forceinline__ void qk_mla(f32x16& p0, f32x16& p1, int kaddr, int r32, int hi, const bf16x8* qr) {
    const int rb = kaddr + r32 * 256, sw = (r32 & 7) << 4, h16 = hi * 16;
    const int rr = kaddr + 16384 + r32 * 128;
#define KRD(dst, base, off) asm volatile("ds_read_b128 %0, %1 offset:%2" : "=&v"(dst) : "v"(base), "i"(off) : "memory")
#define WLK(n) do { asm volatile("s_waitcnt lgkmcnt(" #n ")" ::: "memory"); SBAR(); } while (0)
#define RDN(S, dd, off) do { const int a_ = rb + (((dd) * 32 + h16) ^ sw); KRD(S##0, a_, off); KRD(S##1, a_, 8192 + (off)); } while (0)
#define RDR(S, ks) do { const int a_ = rr + (((((ks) * 2 + hi)) ^ (r32 & 7)) << 4); KRD(S##0, a_, 0); KRD(S##1, a_, 4096); } while (0)
#define MM1(S, d) do { p0 = __builtin_amdgcn_mfma_f32_32x32x16_bf16(S##0, qr[d], p0, 0, 0, 0); p1 = __builtin_amdgcn_mfma_f32_32x32x16_bf16(S##1, qr[d], p1, 0, 0, 0); } while (0)
    bf16x8 A0, A1, B0, B1;
    RDN(A, 0, 0); RDN(B, 1, 0);
    WLK(2); MM1(A, 0); RDN(A, 2, 0);
    WLK(2); MM1(B, 1); RDN(B, 3, 0);
    WLK(2); MM1(A, 2); RDN(A, 0, 128);
    WLK(2); MM1(B, 3); RDN(B, 1, 128);
    WLK(2); MM1(A, 4); RDN(A, 2, 128);
    WLK(2); MM1(B, 5); RDN(B, 3, 128);
    WLK(2); MM1(A, 6); RDR(A, 0);
    WLK(2); MM1(B, 7); RDR(B, 1);
    WLK(2); MM1(A, 8); RDR(A, 2);
    WLK(2); MM1(B, 9); RDR(B, 3);
    WLK(2); MM1(A, 10);
    WLK(0); MM1(B, 11);
#undef MM1
#undef RDR
#undef RDN
#undef WLK
#undef KRD
}
template <int NCB> __device__ __forceinline__ void pv_tile(f32x16* o, int vb, bf16x8 pa0, bf16x8 pa1, bf16x8 pa2, bf16x8 pa3) {
#define TRRD(dst, off) asm volatile("ds_read_b64_tr_b16 %0, %1 offset:%2" : "=&v"(dst) : "v"(vb), "i"(off) : "memory")
    constexpr int KS_ = NCB * 1024;
#define PV_RD(S, d0) do { constexpr int b_ = (d0) * 512; TRRD(S##l0, b_); TRRD(S##h0, b_ + KS_ / 2); TRRD(S##l1, b_ + KS_); TRRD(S##h1, b_ + KS_ + KS_ / 2); TRRD(S##l2, b_ + 2 * KS_); TRRD(S##h2, b_ + 2 * KS_ + KS_ / 2); TRRD(S##l3, b_ + 3 * KS_); TRRD(S##h3, b_ + 3 * KS_ + KS_ / 2); } while (0)
#define PV_MM(S, d0) do { \
        o[d0] = __builtin_amdgcn_mfma_f32_32x32x16_bf16(pa0, (bf16x8){S##l0[0], S##l0[1], S##l0[2], S##l0[3], S##h0[0], S##h0[1], S##h0[2], S##h0[3]}, o[d0], 0, 0, 0);   \
        o[d0] = __builtin_amdgcn_mfma_f32_32x32x16_bf16(pa1, (bf16x8){S##l1[0], S##l1[1], S##l1[2], S##l1[3], S##h1[0], S##h1[1], S##h1[2], S##h1[3]}, o[d0], 0, 0, 0);   \
        o[d0] = __builtin_amdgcn_mfma_f32_32x32x16_bf16(pa2, (bf16x8){S##l2[0], S##l2[1], S##l2[2], S##l2[3], S##h2[0], S##h2[1], S##h2[2], S##h2[3]}, o[d0], 0, 0, 0);   \
        o[d0] = __builtin_amdgcn_mfma_f32_32x32x16_bf16(pa3, (bf16x8){S##l3[0], S##l3[1], S##l3[2], S##l3[3], S##h3[0], S##h3[1], S##h3[2], S##h3[3]}, o[d0], 0, 0, 0); } while (0)
#define WL(n) do { asm volatile("s_waitcnt lgkmcnt(" #n ")" ::: "memory"); SBAR(); } while (0)
    s16x4 Al0, Al1, Al2, Al3, Ah0, Ah1, Ah2, Ah3, Bl0, Bl1, Bl2, Bl3, Bh0, Bh1, Bh2, Bh3;
    PV_RD(A, 0); PV_RD(B, 1); WL(8); PV_MM(A, 0);
    if constexpr (NCB == 4) { PV_RD(A, 2); WL(8); PV_MM(B, 1); PV_RD(B, 3); WL(8); PV_MM(A, 2); WL(0); PV_MM(B, 3); }
    else { WL(0); PV_MM(B, 1); }
#undef WL
#undef PV_MM
#undef PV_RD
#undef TRRD
}

struct AttnP {
    bf16_t* QN; const bf16_t* QR; const bf16_t* KN; const bf16_t* KR; const bf16_t* V;
    bf16_t* QS; const bf16_t* KS; const bf16_t* VS;
    const float* sinks; const float* rel;
};
__device__ const unsigned char T5B[128] = {0, 1, 2, 3, 4, 5, 6, 7, 8, 9, 10, 11, 12, 13, 14, 15, 16, 16, 16, 17, 17, 18, 18, 18, 19, 19, 19, 20, 20, 20, 20, 21, 21, 21, 21, 22, 22, 22, 22, 22, 23, 23, 23, 23, 23, 23, 24, 24, 24, 24, 24, 24, 25, 25, 25, 25, 25, 25, 25, 26, 26, 26, 26, 26, 26, 26, 26, 27, 27, 27, 27, 27, 27, 27, 27, 27, 27, 28, 28, 28, 28, 28, 28, 28, 28, 28, 28, 29, 29, 29, 29, 29, 29, 29, 29, 29, 29, 29, 29, 30, 30, 30, 30, 30, 30, 30, 30, 30, 30, 30, 30, 30, 30, 31, 31, 31, 31, 31, 31, 31, 31, 31, 31, 31, 31, 31, 31, 31};

template <bool MLA> __device__ __forceinline__ void attn_unit(const AttnP& P, int b, int hh, int qb, LAS char* lds) {
    constexpr int DV = MLA ? 128 : 64, NCB = DV / 32, NQF = MLA ? 12 : 4;
    constexpr int KBYTES = MLA ? 24576 : 8192, VBYTES = 64 * DV * 2;
    constexpr int SC9 = MLA ? 72168784 : 125000000;
    constexpr float SCALE = SC9 * 1e-9f;
    constexpr int W = MLA ? (1 << 30) : 128;
    const int tid = threadIdx.x, wid = __builtin_amdgcn_readfirstlane(tid >> 6), lane = tid & 63, r32 = lane & 31, hi = lane >> 5;
    LAS char* V_lds = lds; LAS char* K_lds = lds + 2 * VBYTES;
    LAS float* ws = (LAS float*)(lds + 2 * VBYTES + 2 * KBYTES) + wid * 64; LAS float* li_l = ws; LAS float* al_l = ws + 32;
    LAS float* bias_l = (LAS float*)(lds + 2 * VBYTES + 2 * KBYTES + 2048);
    const int q0 = qb * 256; const size_t rowbase = (size_t)b * SEQ;
    const int jt0 = MLA ? 0 : (q0 == 0 ? 0 : -2);
    const int NT = MLA ? 4 * qb + 4 : 4 - jt0;
    const int kbase0 = MLA ? 0 : q0 + 64 * jt0;
    const int qlo = q0 + wid * 32, qm = qlo + r32 - 4 * hi;
    bf16x8 qr[NQF];
    const size_t qrow = rowbase + qlo + r32;
    if constexpr (MLA) {
#pragma unroll
        for (int d0 = 0; d0 < 8; ++d0) qr[d0] = *(const bf16x8*)(P.QN + qrow * 2048 + hh * 128 + d0 * 16 + hi * 8);
#pragma unroll
        for (int d0 = 0; d0 < 4; ++d0) qr[8 + d0] = *(const bf16x8*)(P.QR + qrow * 1024 + hh * 64 + d0 * 16 + hi * 8);
    } else {
#pragma unroll
        for (int d0 = 0; d0 < 4; ++d0) qr[d0] = *(const bf16x8*)(P.QS + qrow * 2048 + hh * 64 + d0 * 16 + hi * 8);
        if (tid < 128) bias_l[tid] = P.rel[(int)T5B[tid] * 32 + hh] * (1.0f / SCALE);
    }
    bf16x8 sk0, sv0;
    const int sr8 = tid >> 3, ch8 = tid & 7;
    const bf16_t* Kg; const bf16_t* Vg; const bf16_t* Rg = nullptr;
    unsigned okA = 0, okB = 0, orp = 0, ovA = 0, ovB = 0;
    if constexpr (MLA) {
        Kg = P.KN + rowbase * 2048 + hh * 128; Vg = P.V + rowbase * 2048 + hh * 128; Rg = P.KR + rowbase * 64;
        { const int rA = 4 * wid + (lane >> 4), rB = rA + 32, cp = lane & 15; okA = (unsigned)(rA * 2048 + ((cp ^ (rA & 7)) << 3)); okB = (unsigned)(rB * 2048 + ((cp ^ (rB & 7)) << 3)); }
        { const int rr = 8 * wid + (lane >> 3), cp = lane & 7; orp = (unsigned)(rr * 64 + ((cp ^ (rr & 7)) << 3)); }
        { const int stA = 2 * wid + (lane >> 5), stB = stA + 16; const int kl = (lane & 31) >> 2, c8 = 8 * (lane & 3);
          const int kkA = (stA >> 2) * 8 + kl, kkB = (stB >> 2) * 8 + kl;
          const int kA = (kkA & ~0xC) | ((kkA & 4) << 1) | ((kkA & 8) >> 1), kB = (kkB & ~0xC) | ((kkB & 4) << 1) | ((kkB & 8) >> 1);
          ovA = (unsigned)(kA * 2048 + 32 * (stA & 3) + c8); ovB = (unsigned)(kB * 2048 + 32 * (stB & 3) + c8); }
    } else { Kg = P.KS + (rowbase + sr8) * 256 + (hh >> 3) * 64 + ch8 * 8; Vg = P.VS + (rowbase + sr8) * 256 + (hh >> 3) * 64 + ch8 * 8; }
    const int kws = KSWZ64(sr8, ch8), vst0 = v_st<NCB>(sr8, ch8 * 8);
#define GLDS(gp, lp) __builtin_amdgcn_global_load_lds((const unsigned*)(gp), (LAS unsigned*)(lp), 16, 0, 0)
#define LOADT(t, bf) do { const size_t k0_ = (size_t)(kbase0 + 64 * (t)); \
        if constexpr (MLA) { LAS char* kd_ = K_lds + (bf) * KBYTES + wid * 1024; LAS char* vd_ = V_lds + (bf) * VBYTES + wid * 1024; \
            const bf16_t* kp_ = Kg + k0_ * 2048; const bf16_t* vp_ = Vg + k0_ * 2048; const bf16_t* rp_ = Rg + k0_ * 64; \
            GLDS(kp_ + okA, kd_); GLDS(kp_ + okB, kd_ + 8192); GLDS(rp_ + orp, kd_ + 16384); GLDS(vp_ + ovA, vd_); GLDS(vp_ + ovB, vd_ + 8192); } \
        else { sk0 = *(const bf16x8*)(Kg + k0_ * 256); sv0 = *(const bf16x8*)(Vg + k0_ * 256); } } while (0)
#define WRITET(bf) do { if constexpr (!MLA) { *(LAS bf16x8*)(K_lds + (bf) * KBYTES + kws) = sk0; *(LAS bf16x8*)(V_lds + (bf) * VBYTES + vst0) = sv0; } } while (0)
    float m_reg = MLA ? 0.f : P.sinks[hh] * (1.0f / SCALE), l_reg = MLA ? 0.f : 1.f;
    f32x16 o[NCB];
#pragma unroll
    for (int d = 0; d < NCB; ++d) o[d] = f32x16{};
    const int vb0 = (int)(uintptr_t)V_lds + v_rd_base(lane);
    LOADT(0, 0); asm volatile("s_waitcnt vmcnt(0)" ::: "memory"); WRITET(0); __syncthreads();
    for (int t = 0; t < NT; ++t) {
        const int buf = t & 1;
        if (t + 1 < NT) LOADT(t + 1, buf ^ 1);
        const int kb = kbase0 + 64 * t;
        const bool act = (kb <= qlo + 31) && (MLA || kb + 63 >= qlo - (W - 1));
        if (act) {
            f32x16 p0 = f32x16{}, p1 = f32x16{};
            if constexpr (MLA) {
#pragma unroll
                for (int r = 0; r < 16; ++r) { p0[r] = -m_reg; p1[r] = -m_reg; } }
            if constexpr (MLA) { qk_mla(p0, p1, (int)(uintptr_t)K_lds + buf * KBYTES, r32, hi, qr); }
            else { qk64(p0, p1, K_lds + buf * KBYTES, r32, hi, qr); }
            const int dq = qm - kb;
            if constexpr (!MLA) {
#pragma unroll
                for (int r = 0; r < 16; ++r) { const int c = (r & 3) + 8 * (r >> 2); p0[r] += bias_l[(dq - c) & 127]; p1[r] += bias_l[(dq - c - 32) & 127]; }
            }
            if (kb + 63 > qlo || (!MLA && kb <= qlo + 31 - W)) mask_tile(p0, p1, dq, (unsigned)W);
            float mn, alpha; bf16x8 pa0, pa1, pa2, pa3;
            if constexpr (MLA) { partialSM_pre(p0, p1, m_reg, alpha); (void)mn; } else { partialSM<SC9>(p0, p1, m_reg, mn, alpha); }
            finishSM(p0, p1, alpha, l_reg, pa0, pa1, pa2, pa3);
            if (__any(alpha < 1.f)) { if (hi == 0) al_l[r32] = alpha; asm volatile("s_waitcnt lgkmcnt(0)" ::: "memory");
#pragma unroll
                for (int d_ = 0; d_ < NCB; ++d_)
#pragma unroll
                    for (int r = 0; r < 16; ++r) o[d_][r] *= al_l[crow(r, hi)]; }
            SBAR();
            pv_tile<NCB>(o, vb0 + buf * VBYTES, pa0, pa1, pa2, pa3);
        }
        if (t + 1 < NT) { asm volatile("s_waitcnt vmcnt(0)" ::: "memory"); WRITET(buf ^ 1); }
        __syncthreads();
    }
    if (hi == 0) li_l[r32] = l_reg; asm volatile("s_waitcnt lgkmcnt(0)" ::: "memory");
    bf16_t* Ow = (MLA ? P.QN + (rowbase + qlo) * 2048 + hh * 128 : P.QS + (rowbase + qlo) * 2048 + hh * 64);
#pragma unroll
    for (int r = 0; r < 16; ++r) { const int orow = crow(r, hi); const float rl = __builtin_amdgcn_rcpf(li_l[orow]);
#pragma unroll
        for (int d0 = 0; d0 < NCB; ++d0) { const float v = o[d0][r] * rl; const float vn = __shfl_xor(v, 1);
            if ((r32 & 1) == 0) *(unsigned*)(Ow + (size_t)orow * 2048 + d0 * 32 + r32) = cvtpk(v, vn); } }
    __syncthreads();
#undef LOADT
#undef WRITET
#undef GLDS
}
#undef SBAR
}
typedef unsigned short bf16;
typedef unsigned v4u __attribute__((ext_vector_type(4)));
typedef float f32x4 __attribute__((ext_vector_type(4)));
constexpr size_t MiB = 1u << 20;
constexpr size_t WS_WIN = 1 * MiB, WS_WQ = 31 * MiB, WS_WKV = 34 * MiB, WS_WOA = 36 * MiB, WS_WOB = 44 * MiB, WS_WOUT = 52 * MiB, WS_WUP = 60 * MiB, WS_WDN = 104 * MiB;
constexpr size_t WS_ROPE = 126 * MiB;
constexpr size_t WS_SSQQ = 130 * MiB, WS_SSQKV = 131 * MiB, WS_SSQY = 132 * MiB, WS_SSQY2 = 136 * MiB;
constexpr size_t WS_XN = 140 * MiB;
constexpr size_t WS_CQ = 268 * MiB, WS_CKV = 300 * MiB, WS_KR = 316 * MiB, WS_KS = 320 * MiB, WS_VS = 336 * MiB, WS_QS = 352 * MiB;
constexpr size_t WS_QN = 480 * MiB, WS_QR = 608 * MiB, WS_KN = 672 * MiB, WS_V = 800 * MiB;
constexpr size_t WS_GT = 608 * MiB, WS_MG = 864 * MiB;
constexpr size_t WS_Y = 140 * MiB, WS_X1 = 768 * MiB, WS_H2 = 640 * MiB;
constexpr size_t WS_G = 140 * MiB, WS_AH = 492 * MiB, WS_BH = 536 * MiB;
constexpr size_t WS_Y2 = 640 * MiB, WS_END = 1024 * MiB;

struct Args {
    const float *x, *g_mix_pre, *g_mix_post, *g_ffn_pre, *g_ffn_post, *w_in, *q_norm, *w_q_up, *kv_norm, *w_kv_up, *sinks, *rel, *w_o_mla, *w_o_swa, *w_out, *w_up, *conv_w, *conv_b, *w_down;
    float* out; unsigned char* ws; int ph_lo, ph_hi;
};

__device__ __forceinline__ unsigned f2bf(float f) { unsigned u = __builtin_bit_cast(unsigned, f); return (u + 0x7fffu + ((u >> 16) & 1u)) >> 16; }
__device__ __forceinline__ unsigned pk2(float lo, float hi) { return f2bf(lo) | (f2bf(hi) << 16); }
__device__ __forceinline__ float wave_sum(float v) {
#pragma unroll
    for (int o = 1; o < 64; o <<= 1) v += __shfl_xor(v, o);
    return v;
}
__device__ __forceinline__ void tr_item(const float* W, int K, int Nsrc, int k0, int nsrc0, bf16* WT, int drow0, int dstride, const float* gain, LAS float* scr, int lane) {
#pragma unroll 8
    for (int i = 0; i < 32; ++i) { const int kk = 2 * i + (lane >> 5); float v = W[(size_t)(k0 + kk) * Nsrc + nsrc0 + (lane & 31)]; if (gain) v *= gain[k0 + kk]; scr[kk * 33 + (lane & 31)] = v; }
    asm volatile("s_waitcnt lgkmcnt(0)" ::: "memory");
    const int c = lane & 7;
#pragma unroll
    for (int j = 0; j < 4; ++j) { const int n = (lane >> 3) + 8 * j; const LAS float* s = scr + (8 * c) * 33 + n;
        v4u o; o.x = pk2(s[0 * 33], s[1 * 33]); o.y = pk2(s[2 * 33], s[3 * 33]); o.z = pk2(s[4 * 33], s[5 * 33]); o.w = pk2(s[6 * 33], s[7 * 33]);
        *(v4u*)(WT + (size_t)(drow0 + n * dstride) * K + k0 + 8 * c) = o; }
    asm volatile("s_waitcnt lgkmcnt(0)" ::: "memory");
}

__global__ void __launch_bounds__(512) fwd_mega(Args a) {
    extern __shared__ __attribute__((aligned(16))) unsigned char lds_raw[];
    LAS unsigned char* lds = (LAS unsigned char*)lds_raw;
    cg::grid_group grid = cg::this_grid();
    const int tid = threadIdx.x, lane = tid & 63, wave = __builtin_amdgcn_readfirstlane(tid >> 6);
    const int G = gridDim.x, bx = blockIdx.x;
    const int vcu = (G % 8 == 0) ? (bx % 8) * (G / 8) + bx / 8 : bx;
    unsigned char* ws = a.ws;
    bf16 *Win_t = (bf16*)(ws + WS_WIN), *Wq_t = (bf16*)(ws + WS_WQ), *Wkv_t = (bf16*)(ws + WS_WKV), *WoA_t = (bf16*)(ws + WS_WOA), *WoB_t = (bf16*)(ws + WS_WOB),
         *Wout_t = (bf16*)(ws + WS_WOUT), *Wup_t = (bf16*)(ws + WS_WUP), *Wdn_t = (bf16*)(ws + WS_WDN);
    float* rope = (float*)(ws + WS_ROPE);
    float *ssqQ = (float*)(ws + WS_SSQQ), *ssqKV = (float*)(ws + WS_SSQKV), *ssqY = (float*)(ws + WS_SSQY), *ssqY2 = (float*)(ws + WS_SSQY2);
    bf16 *XN = (bf16*)(ws + WS_XN), *CQ = (bf16*)(ws + WS_CQ), *CKV = (bf16*)(ws + WS_CKV), *KR = (bf16*)(ws + WS_KR), *KS = (bf16*)(ws + WS_KS), *VS = (bf16*)(ws + WS_VS), *QS = (bf16*)(ws + WS_QS);
    bf16 *QN = (bf16*)(ws + WS_QN), *QR = (bf16*)(ws + WS_QR), *KN = (bf16*)(ws + WS_KN), *VV = (bf16*)(ws + WS_V), *MG = (bf16*)(ws + WS_MG), *GG = (bf16*)(ws + WS_G);
    bf16 *GT = (bf16*)(ws + WS_GT), *Y = (bf16*)(ws + WS_Y), *Y2 = (bf16*)(ws + WS_Y2), *H2 = (bf16*)(ws + WS_H2);
    float *X1 = (float*)(ws + WS_X1), *AH = (float*)(ws + WS_AH), *BH = (float*)(ws + WS_BH);
    const int gw = vcu * 8 + wave, NGW = G * 8;
    const int lo = a.ph_lo, hi = a.ph_hi;
#ifndef PHMASK
#define PHMASK 0xFFFF
#endif
#define IN(k) (((PHMASK >> (k)) & 1) && lo <= (k) && (k) < hi)
#define SEAM(k) do { if (IN(k) && IN((k) + 1)) { __threadfence(); grid.sync(); __builtin_amdgcn_fence(__ATOMIC_ACQUIRE, "agent"); asm volatile("s_waitcnt vmcnt(0) lgkmcnt(0)" ::: "memory"); __syncthreads(); } } while (0)

    if (IN(0)) {
        LAS float* scr = (LAS float*)(lds + wave * 16384);
        constexpr int I_IN = 32 * 234, I_Q = 8 * 96, I_KV = 4 * 128, I_O = 32 * 64, I_UP = 32 * 352, I_DN = 88 * 64;
        constexpr int NITEMS = I_IN + I_Q + I_KV + 3 * I_O + I_UP + I_DN;
        for (int it = gw; it < NITEMS; it += NGW) {
            int r = it;
            if (r < I_IN) { const int kb = r / 234, c = (r % 234) * 32; int d0, ds = 1;
                if (c < 768) d0 = c; else if (c < 832) { d0 = 768 + (c - 768) / 32; ds = 2; } else d0 = c + 192;
                tr_item(a.w_in, 2048, 7488, kb * 64, c, Win_t, d0, ds, nullptr, scr, lane); continue; } r -= I_IN;
            if (r < I_Q) { const int kb = r / 96, c = (r % 96) * 32, h = c / 192, w = c % 192; int d0, ds = 1;
                if (w < 128) d0 = 128 * h + w; else { d0 = 2048 + 64 * h + (w - 128) / 32; ds = 2; }
                tr_item(a.w_q_up, 512, 3072, kb * 64, c, Wq_t, d0, ds, a.q_norm, scr, lane); continue; } r -= I_Q;
            if (r < I_KV) { const int kb = r / 128, c = (r % 128) * 32, h = c / 256, w = c % 256;
                const int d0 = w < 128 ? 128 * h + w : 2048 + 128 * h + (w - 128);
                tr_item(a.w_kv_up, 256, 4096, kb * 64, c, Wkv_t, d0, 1, a.kv_norm, scr, lane); continue; } r -= I_KV;
            if (r < 3 * I_O) { const int wsel = r / I_O, q = r % I_O, kb = q / 64, c = (q % 64) * 32;
                tr_item(wsel == 0 ? a.w_o_mla : wsel == 1 ? a.w_o_swa : a.w_out, 2048, 2048, kb * 64, c, wsel == 0 ? WoA_t : wsel == 1 ? WoB_t : Wout_t, c, 1, nullptr, scr, lane); continue; } r -= 3 * I_O;
            if (r < I_UP) { const int kb = r / 352, c = (r % 352) * 32; int d0;
                if (c < DFF) d0 = 256 * (c / 128) + (c % 128); else { const int c2 = c - DFF; d0 = 256 * (c2 / 128) + 128 + (c2 % 128); }
                tr_item(a.w_up, 2048, 11264, kb * 64, c, Wup_t, d0, 1, nullptr, scr, lane); continue; } r -= I_UP;
            { const int kb = r / 64, c = (r % 64) * 32; tr_item(a.w_down, DFF, 2048, kb * 64, c, Wdn_t, c, 1, nullptr, scr, lane); }
        }
        for (int i = bx * 512 + tid; i < 192 * 2048 / 8; i += G * 512) *(v4u*)(Win_t + (size_t)832 * 2048 + (size_t)i * 8) = (v4u){0u, 0u, 0u, 0u};
        for (int i = bx * 512 + tid; i < SEQ * 32; i += G * 512) { const int pos = i >> 5, k = i & 31;
            const float inv = __builtin_amdgcn_exp2f(-(float)(2 * k) * (13.287712379549449f / 64.0f)); const float ang = (float)pos * inv;
            const double rev = (double)ang * 0.15915494309189535; const float fr = (float)(rev - __builtin_rint(rev));
            rope[2 * i] = __builtin_amdgcn_cosf(fr); rope[2 * i + 1] = __builtin_amdgcn_sinf(fr); }
        for (int m = gw; m < NTOK; m += NGW) {
            const f32x4* xr = (const f32x4*)(a.x + (size_t)m * DM) + lane; f32x4 v[8]; float s = 0.f;
#pragma unroll
            for (int j = 0; j < 8; ++j) { v[j] = xr[64 * j]; s += (v[j].x * v[j].x + v[j].y * v[j].y) + (v[j].z * v[j].z + v[j].w * v[j].w); }
            const float rs = 1.0f / sqrtf(wave_sum(s) * (1.f / DM) + EPS);
            unsigned long long* o8 = (unsigned long long*)(XN + (size_t)m * DM) + lane;
#pragma unroll
            for (int j = 0; j < 8; ++j) { const f32x4 g = *((const f32x4*)a.g_mix_pre + lane + 64 * j);
                o8[64 * j] = (unsigned long long)pk2(v[j].x * rs * g.x, v[j].y * rs * g.y) | ((unsigned long long)pk2(v[j].z * rs * g.z, v[j].w * rs * g.w) << 32); }
        }
    }
    SEAM(0);
    if (IN(1)) {
        pg8::Gemm g{XN, Win_t, NTOK, 3584, 2048}; pg8::StaticOrder S; S.init(NTOK, 3584, G, bx);
        ep::EpiIn E{CQ, CKV, KR, QS, KS, VS, ssqQ, ssqKV, rope};
        pg8::gemm_phase<ep::EpiIn, pg8::StaticOrder, true, true>(lds, g, S, E);
    }
    SEAM(1);
    if (IN(2)) {
        { pg8::Gemm g{CQ, Wq_t, NTOK, 3072, 512}; pg8::StaticOrder S; S.init(NTOK, 3072, G, bx);
          ep::EpiUp E{ssqQ, 8, 1.0f / 512.0f, QN, QR, 2048, 1024, 8, 1, rope, 0.07216878364870322f * 1.4426950408889634f};
          pg8::gemm_phase<ep::EpiUp, pg8::StaticOrder, true, true>(lds, g, S, E); }
        { pg8::Gemm g{CKV, Wkv_t, NTOK, 4096, 256}; pg8::StaticOrder S; S.init(NTOK, 4096, G, bx);
          ep::EpiUp E{ssqKV, 4, 1.0f / 256.0f, KN, VV, 2048, 2048, 8, 0, rope, 1.0f};
          pg8::gemm_phase<ep::EpiUp, pg8::StaticOrder, true, true>(lds, g, S, E); }
    }
    SEAM(2);
    if (IN(3)) {
        att::AttnP P{QN, QR, KN, KR, VV, QS, KS, VS, a.sinks, a.rel};
#ifndef NO_MLA
        for (int it = vcu; it < 1024; it += G) { const int bh = it >> 5, s = it & 31;
            att::attn_unit<true>(P, bh >> 4, bh & 15, 63 - s, (LAS char*)lds);
            att::attn_unit<true>(P, bh >> 4, bh & 15, s, (LAS char*)lds); }
#endif
#ifndef NO_SWA
        for (int it = vcu; it < 4096; it += G) { const int qb = it & 63, hq = (it >> 6) & 31, b = it >> 11;
            att::attn_unit<false>(P, b, hq, qb, (LAS char*)lds); }
#endif
    }
    SEAM(3);
    if (IN(4)) {
        pg8::Gemm g{XN, Win_t + (size_t)3584 * 2048, NTOK, 4096, 2048}; pg8::StaticOrder S; S.init(NTOK, 4096, G, bx);
        ep::EpiSig E{GT}; pg8::gemm_phase<ep::EpiSig, pg8::StaticOrder, true, true>(lds, g, S, E);
    }
    SEAM(4);
    if (IN(5)) {
        { pg8::Gemm g{QN, WoA_t, NTOK, 2048, 2048}; pg8::StaticOrder S; S.init(NTOK, 2048, G, bx);
          ep::EpiGate<false> E{GT, MG}; pg8::gemm_phase<ep::EpiGate<false>, pg8::StaticOrder, true, true>(lds, g, S, E); }
        { pg8::Gemm g{QS, WoB_t, NTOK, 2048, 2048}; pg8::StaticOrder S; S.init(NTOK, 2048, G, bx);
          ep::EpiGate<true> E{GT, MG}; pg8::gemm_phase<ep::EpiGate<true>, pg8::StaticOrder, true, true>(lds, g, S, E); }
    }
    SEAM(5);
    if (IN(6)) {
        pg8::Gemm g{MG, Wout_t, NTOK, 2048, 2048}; pg8::StaticOrder S; S.init(NTOK, 2048, G, bx);
        ep::EpiBfSsq E{Y, ssqY}; pg8::gemm_phase<ep::EpiBfSsq, pg8::StaticOrder, true, true>(lds, g, S, E);
    }
    SEAM(6);
    if (IN(7)) {
        for (int m = gw; m < NTOK; m += NGW) {
            float sy = ssqY[(size_t)m * 32 + (lane & 31)];
#pragma unroll
            for (int o = 1; o < 32; o <<= 1) sy += __shfl_xor(sy, o);
            const float rsy = 1.0f / sqrtf(sy * (1.f / DM) + EPS);
            const f32x4* xr = (const f32x4*)(a.x + (size_t)m * DM) + lane; const unsigned long long* yr = (const unsigned long long*)(Y + (size_t)m * DM) + lane;
            f32x4* outr = (f32x4*)(X1 + (size_t)m * DM) + lane; f32x4 v[8]; float s = 0.f;
#pragma unroll
            for (int j = 0; j < 8; ++j) { const f32x4 g = *((const f32x4*)a.g_mix_post + lane + 64 * j); const unsigned long long yw = yr[64 * j];
                const f32x4 yv = {__uint_as_float((unsigned)yw << 16), __uint_as_float((unsigned)yw & 0xffff0000u), __uint_as_float((unsigned)(yw >> 32) << 16), __uint_as_float((unsigned)(yw >> 32) & 0xffff0000u)};
                v[j] = xr[64 * j] + yv * rsy * g; outr[64 * j] = v[j];
                s += (v[j].x * v[j].x + v[j].y * v[j].y) + (v[j].z * v[j].z + v[j].w * v[j].w); }
            const float rs = 1.0f / sqrtf(wave_sum(s) * (1.f / DM) + EPS);
            unsigned long long* o8 = (unsigned long long*)(H2 + (size_t)m * DM) + lane;
#pragma unroll
            for (int j = 0; j < 8; ++j) { const f32x4 g = *((const f32x4*)a.g_ffn_pre + lane + 64 * j);
                o8[64 * j] = (unsigned long long)pk2(v[j].x * rs * g.x, v[j].y * rs * g.y) | ((unsigned long long)pk2(v[j].z * rs * g.z, v[j].w * rs * g.w) << 32); }
        }
    }
    SEAM(7);
    if (IN(8)) {
        pg8::Gemm g{H2, Wup_t, NTOK, 11264, 2048}; pg8::StaticOrder S; S.init(NTOK, 11264, G, bx);
        ep::EpiFfn E{GG, AH, BH, a.conv_w, a.conv_b}; pg8::gemm_phase<ep::EpiFfn, pg8::StaticOrder, true, true>(lds, g, S, E);
    }
    SEAM(8);
    if (IN(9)) {
        constexpr int NF4 = DFF / 4;
        for (int i = bx * 512 + tid; i < 1024 * NF4; i += G * 512) { const int f = (i % NF4) * 4, rj = i / NF4, jb = rj >> 1, ii = rj & 1; const bool first = (jb & 255) == 0;
            const f32x4 z = {0.f, 0.f, 0.f, 0.f};
            const f32x4 a0 = *(const f32x4*)(AH + ((size_t)jb * 4 + 2 + ii) * DFF + f);
            const f32x4 pm1 = first ? z : *(const f32x4*)(AH + ((size_t)(jb - 1) * 4 + 1) * DFF + f);
            const f32x4 pm2 = first ? z : *(const f32x4*)(AH + ((size_t)(jb - 1) * 4 + 0) * DFF + f);
            const f32x4 a1 = ii ? *(const f32x4*)(AH + ((size_t)jb * 4 + 2) * DFF + f) : pm1;
            const f32x4 a2 = ii ? pm1 : pm2;
            const f32x4 bv = *(const f32x4*)(BH + ((size_t)jb * 2 + ii) * DFF + f);
            const f32x4 c = *(const f32x4*)(a.conv_b + f) + *(const f32x4*)(a.conv_w + f) * a2 + *(const f32x4*)(a.conv_w + DFF + f) * a1 + *(const f32x4*)(a.conv_w + 2 * DFF + f) * a0;
            float o[4];
#pragma unroll
            for (int e = 0; e < 4; ++e) { const float x = c[e]; const float uu = 0.7978845608028654f * (x + 0.044715f * x * x * x);
                o[e] = x * __builtin_amdgcn_rcpf(1.f + __builtin_amdgcn_exp2f(-2.885390081777927f * uu)) * bv[e]; }
            *(unsigned long long*)(GG + ((size_t)jb * 64 + ii) * DFF + f) = (unsigned long long)pk2(o[0], o[1]) | ((unsigned long long)pk2(o[2], o[3]) << 32); }
    }
    SEAM(9);
    if (IN(10)) {
        pg8::Gemm g{GG, Wdn_t, NTOK, 2048, DFF}; pg8::StaticOrder S; S.init(NTOK, 2048, G, bx);
        ep::EpiBfSsq E{Y2, ssqY2}; pg8::gemm_phase<ep::EpiBfSsq, pg8::StaticOrder, true, true>(lds, g, S, E);
    }
    SEAM(10);
    if (IN(11)) {
        for (int m = gw; m < NTOK; m += NGW) {
            float sy = ssqY2[(size_t)m * 32 + (lane & 31)];
#pragma unroll
            for (int o = 1; o < 32; o <<= 1) sy += __shfl_xor(sy, o);
            const float rsy = 1.0f / sqrtf(sy * (1.f / DM) + EPS);
            const unsigned long long* yr = (const unsigned long long*)(Y2 + (size_t)m * DM) + lane; const f32x4* x1r = (const f32x4*)(X1 + (size_t)m * DM) + lane; f32x4* outr = (f32x4*)(a.out + (size_t)m * DM) + lane;
#pragma unroll
            for (int j = 0; j < 8; ++j) { const f32x4 g = *((const f32x4*)a.g_ffn_post + lane + 64 * j); const unsigned long long yw = yr[64 * j];
                const f32x4 yv = {__uint_as_float((unsigned)yw << 16), __uint_as_float((unsigned)yw & 0xffff0000u), __uint_as_float((unsigned)(yw >> 32) << 16), __uint_as_float((unsigned)(yw >> 32) & 0xffff0000u)};
                outr[64 * j] = x1r[64 * j] + yv * rsy * g; }
        }
    }
#undef IN
#undef SEAM
}

constexpr int LDS_BYTES = 147456;
extern "C" void kernel_launch(void* const* d_in, const int* in_sizes, int n_in, void* d_out, int out_size, void* d_ws, size_t ws_size, hipStream_t stream) {
    static int grid = 0;
    if (grid == 0) {
        if (n_in != 19 || in_sizes[0] != NTOK * DM || out_size != NTOK * DM || ws_size < WS_END) { fprintf(stderr, "kernel_launch: unexpected shapes (n_in %d, in0 %d, out %d, ws %zu)\n", n_in, n_in > 0 ? in_sizes[0] : -1, out_size, ws_size); grid = -1; return; }
        int dev = 0, cus = 0, per_cu = 0;
        hipGetDevice(&dev); hipDeviceGetAttribute(&cus, hipDeviceAttributeMultiprocessorCount, dev);
        if (hipFuncSetAttribute((const void*)fwd_mega, hipFuncAttributeMaxDynamicSharedMemorySize, LDS_BYTES) != hipSuccess) { fprintf(stderr, "kernel_launch: hipFuncSetAttribute failed\n"); grid = -1; return; }
        if (hipOccupancyMaxActiveBlocksPerMultiprocessor(&per_cu, (const void*)fwd_mega, 512, LDS_BYTES) != hipSuccess || per_cu < 1) { fprintf(stderr, "kernel_launch: occupancy query says %d\n", per_cu); per_cu = 1; }
        (void)hipGetLastError();
        grid = cus * 1;
        if (grid % 8 != 0 || grid <= 0) { fprintf(stderr, "kernel_launch: odd CU count %d\n", cus); }
    }
    if (grid < 0) return;
    Args a{};
    a.x = (const float*)d_in[0]; a.g_mix_pre = (const float*)d_in[1]; a.g_mix_post = (const float*)d_in[2]; a.g_ffn_pre = (const float*)d_in[3]; a.g_ffn_post = (const float*)d_in[4];
    a.w_in = (const float*)d_in[5]; a.q_norm = (const float*)d_in[6]; a.w_q_up = (const float*)d_in[7]; a.kv_norm = (const float*)d_in[8]; a.w_kv_up = (const float*)d_in[9];
    a.sinks = (const float*)d_in[10]; a.rel = (const float*)d_in[11]; a.w_o_mla = (const float*)d_in[12]; a.w_o_swa = (const float*)d_in[13]; a.w_out = (const float*)d_in[14];
    a.w_up = (const float*)d_in[15]; a.conv_w = (const float*)d_in[16]; a.conv_b = (const float*)d_in[17]; a.w_down = (const float*)d_in[18];
    a.out = (float*)d_out; a.ws = (unsigned char*)d_ws;
#ifndef NLAUNCH_SPLIT
#define NLAUNCH_SPLIT 0
#endif
    for (int ph = 0; ph < 12; ph += (NLAUNCH_SPLIT ? 1 : 12)) {
        a.ph_lo = ph; a.ph_hi = NLAUNCH_SPLIT ? ph + 1 : 12;
        void* args[] = {&a};
        hipError_t e = hipLaunchCooperativeKernel((const void*)fwd_mega, dim3(grid), dim3(512), args, LDS_BYTES, stream);
        if (e != hipSuccess) fprintf(stderr, "kernel_launch: cooperative launch failed: %s (grid %d)\n", hipGetErrorString(e), grid);
    }
}
```

```cpp
#include <hip/hip_runtime.h>
#include <hip/hip_cooperative_groups.h>
#include <cstdio>
#include <cstdint>
namespace cg = cooperative_groups;
namespace pg8 {
#define PG8_LAS __attribute__((address_space(3)))
typedef unsigned short bf16_t;
typedef short bf16x8 __attribute__((ext_vector_type(8)));
typedef float f32x4 __attribute__((ext_vector_type(4)));
typedef unsigned u32x4 __attribute__((ext_vector_type(4)));
constexpr int BM = 256, BK = 64, HALF = 128, HTB = HALF * BK * 2  , STAGE_BYTES = 8 * HTB, NXCD = 8, WGM = 8;

__host__ __device__ __forceinline__ int lds_byte(int r, int c) { const int st = (r >> 4) * 2 + (c >> 5), rr = r & 15, cc = c & 31, ob = rr * 64 + cc * 2; return st * 1024 + (ob ^ (((ob >> 9) & 1) << 5)); }
__host__ __device__ __forceinline__ void stage_rc(int b, int& R, int& C) { const int st = b / 1024, sb = b % 1024, swz = sb ^ (((sb >> 9) & 1) << 5); R = (st >> 1) * 16 + swz / 64; C = (st & 1) * 32 + (swz % 64) / 2; }
__host__ __device__ __forceinline__ int perm32(int rho) { const int n = rho >> 4, i = rho & 15; return 8 * (i >> 2) + 4 * n + (i & 3); }

struct Unit { int pm, pn; };
struct Gemm { const bf16_t* A; const bf16_t* Bt; int M, N, K; };

struct StaticOrder {
    int nM, nN, nwg, G, c;
    __host__ __device__ void init(int M, int N, int G_, int c_) { nM = M / BM; nN = N / BM; nwg = nM * nN; G = G_; c = c_; }
    __host__ __device__ bool next(int i, Unit& u) const {
        const long L = (long)i * G + c; if (L >= nwg) return false;
        int wgid = (int)L; { const int q = nwg / NXCD, r = nwg % NXCD, xcd = wgid % NXCD, off = wgid / NXCD; wgid = (xcd < r ? xcd * (q + 1) : r * (q + 1) + (xcd - r) * q) + off; }
        const int nig = WGM * nN, gid = wgid / nig, fm = gid * WGM, gsz = (nM - fm) < WGM ? (nM - fm) : WGM;
        u.pm = fm + ((wgid % nig) % gsz); u.pn = (wgid % nig) / gsz; return true;
    }
    __device__ __forceinline__ void a_ready(const Unit&) const {}
    __device__ __forceinline__ void done(const Unit&) const {}
};

typedef float f32x2_cv __attribute__((ext_vector_type(2))); typedef __bf16 bf16x2_cv __attribute__((ext_vector_type(2)));
__device__ __forceinline__ unsigned cvt_pk_bf16(float lo, float hi) { f32x2_cv v = {lo, hi}; bf16x2_cv b = __builtin_convertvector(v, bf16x2_cv); return __builtin_bit_cast(unsigned, b); }
template <class Epi, class Sched, bool ALIGN_EPI = false, bool SP2 = false>
__device__ __forceinline__ void gemm_phase(PG8_LAS unsigned char* lds, const Gemm g, const Sched& S, const Epi& E) {
    const int tid = threadIdx.x, wid = __builtin_amdgcn_readfirstlane(tid >> 6), lane = tid & 63, wr = wid >> 2, wc = wid & 3, fr = lane & 15, fq = lane >> 4;
    const int K = g.K, nt = K / BK;
    unsigned voffA[2], voffB[2];
#pragma unroll
    for (int i = 0; i < 2; ++i) { int R, C; stage_rc(tid * 16 + i * 8192, R, C); const int Rb = Epi::PERM ? ((R & ~31) + perm32(R & 31)) : R;
        voffA[i] = (unsigned)(R * K + C) * 2u; voffB[i] = (unsigned)(Rb * K + C) * 2u; }
    const size_t kstep = (size_t)(BK * 2);
    const size_t hstep = (size_t)HALF * K * 2;
    const size_t tstep = 2 * hstep;
    const unsigned ldsw = (unsigned)wid * 1024u;
    const int aoff = lds_byte(wr * 64 + fr, fq * 8), boff = lds_byte(wc * 32 + fr, fq * 8);
#define PG8_SA(b, h) (((b) * 2 + (h)) * HTB)
#define PG8_SB(b, h) ((4 + (b) * 2 + (h)) * HTB)
#define PG8_STAGE(bufoff, gbase, voff) do { _Pragma("unroll") for (int _i = 0; _i < 2; ++_i) \
        __builtin_amdgcn_global_load_lds((const unsigned*)((const char*)(gbase) + (voff)[_i]), (PG8_LAS unsigned*)(lds + (bufoff) + ldsw + _i * 8192), 16, 0, 0); } while (0)
#define PG8_LDA(dst, b, h) do { _Pragma("unroll") for (int m = 0; m < 4; ++m) _Pragma("unroll") for (int k = 0; k < 2; ++k) dst[m][k] = *(const PG8_LAS bf16x8*)(lds + PG8_SA(b, h) + aoff + m * 2048 + k * 1024); } while (0)
#define PG8_LDB(dst, b, h) do { _Pragma("unroll") for (int n = 0; n < 2; ++n) _Pragma("unroll") for (int k = 0; k < 2; ++k) dst[n][k] = *(const PG8_LAS bf16x8*)(lds + PG8_SB(b, h) + boff + n * 2048 + k * 1024); } while (0)
#define PG8_MMA(ai, bj, At, Bt) do { __builtin_amdgcn_s_setprio(1); _Pragma("unroll") for (int m = 0; m < 4; ++m) _Pragma("unroll") for (int n = 0; n < 2; ++n) _Pragma("unroll") for (int k = 0; k < 2; ++k) \
        acc[ai][bj][m][n] = __builtin_amdgcn_mfma_f32_16x16x32_bf16(Bt[n][k], At[m][k], acc[ai][bj][m][n], 0, 0, 0); __builtin_amdgcn_s_setprio(0); } while (0)
#define PG8_WAIT_V(n) asm volatile("s_waitcnt vmcnt(" #n ")" ::: "memory")
#define PG8_WAIT_L(n) asm volatile("s_waitcnt lgkmcnt(" #n ")" ::: "memory")
#define PG8_BAR __builtin_amdgcn_s_barrier()
#define PG8_SCHED __builtin_amdgcn_sched_barrier(0)
    Unit cur, nxt; int ui = 0;
    if (!S.next(0, cur)) return;
    f32x4 acc[2][2][4][2];
#pragma unroll
    for (int a = 0; a < 2; ++a)
#pragma unroll
        for (int b = 0; b < 2; ++b)
#pragma unroll
            for (int m = 0; m < 4; ++m)
#pragma unroll
                for (int n = 0; n < 2; ++n) acc[a][b][m][n] = (f32x4){0.f, 0.f, 0.f, 0.f};
    bf16x8 At[4][2], B0[2][2], B1[2][2];
    const char* cA = (const char*)g.A + (size_t)cur.pm * tstep; const char* cB = (const char*)g.Bt + (size_t)cur.pn * tstep;
    S.a_ready(cur);
    if constexpr (SP2) {
        PG8_STAGE(PG8_SB(0, 0), cB, voffB); PG8_STAGE(PG8_SB(0, 1), cB + hstep, voffB); PG8_STAGE(PG8_SA(0, 0), cA, voffA); PG8_STAGE(PG8_SA(0, 1), cA + hstep, voffA);
        PG8_STAGE(PG8_SB(1, 0), cB + kstep, voffB); PG8_STAGE(PG8_SA(1, 0), cA + kstep, voffA); PG8_STAGE(PG8_SB(1, 1), cB + hstep + kstep, voffB);
        PG8_WAIT_V(0); PG8_WAIT_L(0); PG8_BAR;
        if (wr == 1) PG8_BAR;
    } else {
        PG8_STAGE(PG8_SB(0, 0), cB, voffB); PG8_STAGE(PG8_SA(0, 0), cA, voffA); PG8_STAGE(PG8_SB(0, 1), cB + hstep, voffB); PG8_STAGE(PG8_SA(0, 1), cA + hstep, voffA);
        if (wr == 1) PG8_BAR;
        PG8_WAIT_V(4); PG8_BAR;
        PG8_STAGE(PG8_SB(1, 0), cB + kstep, voffB); PG8_STAGE(PG8_SA(1, 0), cA + kstep, voffA); PG8_STAGE(PG8_SB(1, 1), cB + hstep + kstep, voffB);
        PG8_WAIT_V(6); PG8_BAR;
    }
    for (;;) {
        const bool has_next = S.next(ui + 1, nxt);
        const char* nA = has_next ? (const char*)g.A + (size_t)nxt.pm * tstep : cA; const char* nB = has_next ? (const char*)g.Bt + (size_t)nxt.pn * tstep : cB;
        for (int t = 0; t < nt; t += 2) {
            const bool last = (t == nt - 2);
            const char* a1 = cA + (size_t)(t + 1) * kstep;
            const char* a2 = last ? nA : cA + (size_t)(t + 2) * kstep; const char* b2 = last ? nB : cB + (size_t)(t + 2) * kstep;
            const char* a3 = a2 + kstep; const char* b3 = b2 + kstep;
            if (last && has_next) S.a_ready(nxt);
            if constexpr (SP2) {
            PG8_LDB(B0, 0, 0); PG8_LDB(B1, 0, 1); PG8_SCHED; PG8_LDA(At, 0, 0); PG8_STAGE(PG8_SA(1, 1), a1 + hstep, voffA);
            PG8_WAIT_V(8); PG8_WAIT_L(0); PG8_BAR; PG8_MMA(0, 0, At, B0); PG8_MMA(0, 1, At, B1); PG8_BAR; PG8_SCHED;
            PG8_LDA(At, 0, 1); PG8_STAGE(PG8_SB(0, 0), b2, voffB); PG8_STAGE(PG8_SB(0, 1), b2 + hstep, voffB); PG8_STAGE(PG8_SA(0, 0), a2, voffA);
            PG8_WAIT_V(8); PG8_WAIT_L(0); PG8_BAR; PG8_MMA(1, 0, At, B0); PG8_MMA(1, 1, At, B1); PG8_BAR; PG8_SCHED;
            PG8_LDB(B0, 1, 0); PG8_LDB(B1, 1, 1); PG8_SCHED; PG8_LDA(At, 1, 0); PG8_STAGE(PG8_SA(0, 1), a2 + hstep, voffA);
            PG8_WAIT_V(8); PG8_WAIT_L(0); PG8_BAR; PG8_MMA(0, 0, At, B0); PG8_MMA(0, 1, At, B1); PG8_BAR; PG8_SCHED;
            PG8_LDA(At, 1, 1); PG8_STAGE(PG8_SB(1, 0), b3, voffB); PG8_STAGE(PG8_SB(1, 1), b3 + hstep, voffB); PG8_STAGE(PG8_SA(1, 0), a3, voffA);
            PG8_WAIT_V(8); PG8_WAIT_L(0); PG8_BAR; PG8_MMA(1, 0, At, B0); PG8_MMA(1, 1, At, B1); PG8_BAR; PG8_SCHED;
            } else {
            PG8_LDB(B0, 0, 0); PG8_SCHED; PG8_LDA(At, 0, 0); PG8_STAGE(PG8_SA(1, 1), a1 + hstep, voffA);
            PG8_WAIT_L(8); PG8_BAR; PG8_WAIT_L(0); PG8_MMA(0, 0, At, B0); PG8_BAR; PG8_SCHED;
            PG8_LDB(B1, 0, 1); PG8_STAGE(PG8_SB(0, 0), b2, voffB);
            PG8_BAR; PG8_WAIT_L(0); PG8_MMA(0, 1, At, B1); PG8_BAR;
            PG8_LDA(At, 0, 1); PG8_STAGE(PG8_SA(0, 0), a2, voffA);
            PG8_BAR; PG8_WAIT_L(0); PG8_MMA(1, 0, At, B0); PG8_BAR; PG8_SCHED;
            PG8_STAGE(PG8_SB(0, 1), b2 + hstep, voffB);
            PG8_WAIT_V(6); PG8_BAR; PG8_MMA(1, 1, At, B1); PG8_BAR;
            PG8_LDB(B0, 1, 0); PG8_SCHED; PG8_LDA(At, 1, 0); PG8_STAGE(PG8_SA(0, 1), a2 + hstep, voffA);
            PG8_WAIT_L(8); PG8_BAR; PG8_WAIT_L(0); PG8_MMA(0, 0, At, B0); PG8_BAR; PG8_SCHED;
            PG8_LDB(B1, 1, 1); PG8_STAGE(PG8_SB(1, 0), b3, voffB);
            PG8_BAR; PG8_WAIT_L(0); PG8_MMA(0, 1, At, B1); PG8_BAR;
            PG8_LDA(At, 1, 1); PG8_STAGE(PG8_SA(1, 0), a3, voffA);
            PG8_BAR; PG8_WAIT_L(0); PG8_MMA(1, 0, At, B0); PG8_BAR; PG8_SCHED;
            PG8_STAGE(PG8_SB(1, 1), b3 + hstep, voffB);
            PG8_WAIT_V(6); PG8_BAR; PG8_MMA(1, 1, At, B1); PG8_BAR;
            }
        }
        if constexpr (ALIGN_EPI) { if (wr == 0) PG8_BAR; }
        if constexpr (!Epi::AFTER_DRAIN) { E(acc, cur, wr, wc, fr, fq); S.done(cur); }
        if (!has_next) break;
#pragma unroll
        for (int a = 0; a < 2; ++a)
#pragma unroll
            for (int b = 0; b < 2; ++b)
#pragma unroll
                for (int m = 0; m < 4; ++m)
#pragma unroll
                    for (int n = 0; n < 2; ++n) acc[a][b][m][n] = (f32x4){0.f, 0.f, 0.f, 0.f};
        cur = nxt; cA = nA; cB = nB; ++ui;
        if constexpr (ALIGN_EPI) { if (wr == 1) PG8_BAR; }
    }
    PG8_WAIT_V(0);
    if constexpr (!ALIGN_EPI) { if (wr == 0) PG8_BAR; }
    PG8_BAR;
    if constexpr (Epi::AFTER_DRAIN) { E.fused(acc, cur, wr, wc, fr, fq, lds, wid, lane); S.done(cur); }
#undef PG8_SA
#undef PG8_SB
#undef PG8_STAGE
#undef PG8_LDA
#undef PG8_LDB
#undef PG8_MMA
#undef PG8_WAIT_V
#undef PG8_WAIT_L
#undef PG8_BAR
#undef PG8_SCHED
}
}
constexpr int SEQ = 16384, NTOK = 32768, DM = 2048, DFF = 5632;
constexpr float EPS = 1e-6f;
#define GAS __attribute__((address_space(1)))
#define LAS __attribute__((address_space(3)))

namespace ep {
using namespace pg8;
typedef float f32x2 __attribute__((ext_vector_type(2)));
__device__ __forceinline__ u32x4 pack8(const f32x4 a, const f32x4 b) { u32x4 w; w.x = cvt_pk_bf16(a[0], a[1]); w.y = cvt_pk_bf16(a[2], a[3]); w.z = cvt_pk_bf16(b[0], b[1]); w.w = cvt_pk_bf16(b[2], b[3]); return w; }
__device__ __forceinline__ float bflo(unsigned u) { return __uint_as_float(u << 16); }
__device__ __forceinline__ float bfhi(unsigned u) { return __uint_as_float(u & 0xffff0000u); }
__device__ __forceinline__ void unpack8(const u32x4 w, f32x4& a, f32x4& b) { a = (f32x4){bflo(w.x), bfhi(w.x), bflo(w.y), bfhi(w.y)}; b = (f32x4){bflo(w.z), bfhi(w.z), bflo(w.w), bfhi(w.w)}; }
__device__ __forceinline__ float sigmoidf_(float x) { return __builtin_amdgcn_rcpf(1.f + __builtin_amdgcn_exp2f(-1.4426950408889634f * x)); }
__device__ __forceinline__ float ssq4(const f32x4 x) { return (x[0] * x[0] + x[1] * x[1]) + (x[2] * x[2] + x[3] * x[3]); }
__device__ __forceinline__ void rope8(f32x4& v0, f32x4& v1, const f32x4 csA, const f32x4 csB) {
    const float a0 = v0[0] * csA[0] - v0[1] * csA[1], b0 = v0[1] * csA[0] + v0[0] * csA[1];
    const float a1 = v0[2] * csA[2] - v0[3] * csA[3], b1 = v0[3] * csA[2] + v0[2] * csA[3];
    const float a2 = v1[0] * csB[0] - v1[1] * csB[1], b2 = v1[1] * csB[0] + v1[0] * csB[1];
    const float a3 = v1[2] * csB[2] - v1[3] * csB[3], b3 = v1[3] * csB[2] + v1[2] * csB[3];
    v0 = (f32x4){a0, b0, a1, b1}; v1 = (f32x4){a2, b2, a3, b3};
}

struct EpiIn {
    static constexpr bool PERM = true, AFTER_DRAIN = false;
    bf16_t *CQ, *CKV, *KR, *QS, *KS, *VS; float *ssqQ, *ssqKV; const float* rope;
    __device__ __forceinline__ void operator()(const f32x4 (&acc)[2][2][4][2], const Unit& u, int wr, int wc, int fr, int fq) const {
        const int pn = u.pn, row0 = u.pm * BM + wr * 64 + fr, cw = wc * 32 + 8 * fq;
        if (pn < 3) {
            float* sq = pn < 2 ? ssqQ : ssqKV; const int nslot = pn < 2 ? 8 : 4, slot = (pn < 2 ? pn * 4 : 0) + wc, ldc = pn < 2 ? 512 : 256;
            bf16_t* base = pn < 2 ? CQ + pn * 256 : CKV;
#pragma unroll
            for (int ai = 0; ai < 2; ++ai)
#pragma unroll
                for (int m = 0; m < 4; ++m) { const int row = row0 + ai * HALF + m * 16;
                    float s = (ssq4(acc[ai][0][m][0]) + ssq4(acc[ai][0][m][1])) + (ssq4(acc[ai][1][m][0]) + ssq4(acc[ai][1][m][1]));
                    s += __shfl_xor(s, 16); s += __shfl_xor(s, 32);
                    if (fq == 0) sq[(size_t)row * nslot + slot] = s;
#pragma unroll
                    for (int bj = 0; bj < 2; ++bj) *(u32x4*)(base + (size_t)row * ldc + bj * HALF + cw) = pack8(acc[ai][bj][m][0], acc[ai][bj][m][1]); }
        } else if (pn == 3) {
            if (wc < 2) {
#pragma unroll
                for (int ai = 0; ai < 2; ++ai)
#pragma unroll
                    for (int m = 0; m < 4; ++m) { const int row = row0 + ai * HALF + m * 16; const int pos = row & (SEQ - 1);
                        const float* cs = rope + ((size_t)pos * 32 + 16 * wc + 4 * fq) * 2;
                        const f32x4 csA = *(const f32x4*)cs, csB = *(const f32x4*)(cs + 4);
                        f32x4 v0 = acc[ai][0][m][0], v1 = acc[ai][0][m][1]; rope8(v0, v1, csA, csB);
                        *(u32x4*)(KR + (size_t)row * 64 + cw) = pack8(v0, v1); }
            }
        } else if (pn < 14) {
            bf16_t* base; int ldc;
            if (pn < 12) { base = QS + (pn - 4) * 256; ldc = 2048; } else if (pn == 12) { base = KS; ldc = 256; } else { base = VS; ldc = 256; }
#pragma unroll
            for (int ai = 0; ai < 2; ++ai)
#pragma unroll
                for (int m = 0; m < 4; ++m) { const int row = row0 + ai * HALF + m * 16;
#pragma unroll
                    for (int bj = 0; bj < 2; ++bj) *(u32x4*)(base + (size_t)row * ldc + bj * HALF + cw) = pack8(acc[ai][bj][m][0], acc[ai][bj][m][1]); }
        }
    }
};

struct EpiSig {
    static constexpr bool PERM = true, AFTER_DRAIN = false;
    bf16_t* GT;
    __device__ __forceinline__ void operator()(const f32x4 (&acc)[2][2][4][2], const Unit& u, int wr, int wc, int fr, int fq) const {
        const int row0 = u.pm * BM + wr * 64 + fr, cw = wc * 32 + 8 * fq; bf16_t* base = GT + u.pn * 256;
#pragma unroll
        for (int ai = 0; ai < 2; ++ai)
#pragma unroll
            for (int m = 0; m < 4; ++m) { const int row = row0 + ai * HALF + m * 16;
#pragma unroll
                for (int bj = 0; bj < 2; ++bj) { f32x4 v0 = acc[ai][bj][m][0], v1 = acc[ai][bj][m][1];
#pragma unroll
                    for (int e = 0; e < 4; ++e) { v0[e] = sigmoidf_(v0[e]); v1[e] = sigmoidf_(v1[e]); }
                    *(u32x4*)(base + (size_t)row * 4096 + bj * HALF + cw) = pack8(v0, v1); } }
    }
};

struct EpiUp {
    static constexpr bool PERM = true, AFTER_DRAIN = false;
    const float* ssq; int nslot; float invK; bf16_t* O0; bf16_t* O1; int ld0, ld1, split; int rope1; const float* rope; float oscale;
    __device__ __forceinline__ void operator()(const f32x4 (&acc)[2][2][4][2], const Unit& u, int wr, int wc, int fr, int fq) const {
        const int pn = u.pn, row0 = u.pm * BM + wr * 64 + fr, cw = wc * 32 + 8 * fq;
        const int t = pn < split ? 0 : 1; bf16_t* base = t ? O1 + (pn - split) * 256 : O0 + pn * 256; const int ld = t ? ld1 : ld0;
        const bool dorope = (t == 1) && rope1;
#pragma unroll
        for (int ai = 0; ai < 2; ++ai)
#pragma unroll
            for (int m = 0; m < 4; ++m) { const int row = row0 + ai * HALF + m * 16;
                float s;
                if (nslot == 8) { const f32x4 a = *(const f32x4*)(ssq + (size_t)row * 8), b = *(const f32x4*)(ssq + (size_t)row * 8 + 4); s = ((a[0] + a[1]) + (a[2] + a[3])) + ((b[0] + b[1]) + (b[2] + b[3])); }
                else { const f32x4 a = *(const f32x4*)(ssq + (size_t)row * 4); s = (a[0] + a[1]) + (a[2] + a[3]); }
                const float rs = oscale / sqrtf(s * invK + EPS);
                f32x4 csA = {1.f, 0.f, 1.f, 0.f}, csB = {1.f, 0.f, 1.f, 0.f};
                if (dorope) { const int pos = row & (SEQ - 1); const float* cs = rope + ((size_t)pos * 32 + 16 * (wc & 1) + 4 * fq) * 2; csA = *(const f32x4*)cs; csB = *(const f32x4*)(cs + 4); }
#pragma unroll
                for (int bj = 0; bj < 2; ++bj) { f32x4 v0 = acc[ai][bj][m][0] * rs, v1 = acc[ai][bj][m][1] * rs;
                    if (dorope) rope8(v0, v1, csA, csB);
                    *(u32x4*)(base + (size_t)row * ld + bj * HALF + cw) = pack8(v0, v1); } }
    }
};

template <bool SECOND> struct EpiGate {
    static constexpr bool PERM = true, AFTER_DRAIN = false;
    const bf16_t* GT; bf16_t* MG;
    __device__ __forceinline__ void operator()(const f32x4 (&acc)[2][2][4][2], const Unit& u, int wr, int wc, int fr, int fq) const {
        const int row0 = u.pm * BM + wr * 64 + fr, col0 = u.pn * BM + wc * 32 + 8 * fq;
#pragma unroll
        for (int ai = 0; ai < 2; ++ai)
#pragma unroll
            for (int m = 0; m < 4; ++m) { const int row = row0 + ai * HALF + m * 16;
#pragma unroll
                for (int bj = 0; bj < 2; ++bj) { const int col = col0 + bj * HALF;
                    const u32x4 gw = *(const u32x4*)(GT + (size_t)row * 4096 + (SECOND ? 2048 : 0) + col); f32x4 g0, g1; unpack8(gw, g0, g1);
                    f32x4 v0 = acc[ai][bj][m][0] * g0, v1 = acc[ai][bj][m][1] * g1;
                    bf16_t* p = MG + (size_t)row * DM + col;
                    if (SECOND) { const u32x4 pw = *(const u32x4*)p; f32x4 p0, p1; unpack8(pw, p0, p1); v0 += p0; v1 += p1; }
                    *(u32x4*)p = pack8(v0, v1); } }
    }
};

struct EpiBfSsq {
    static constexpr bool PERM = true, AFTER_DRAIN = false;
    bf16_t* Y; float* ssq;
    __device__ __forceinline__ void operator()(const f32x4 (&acc)[2][2][4][2], const Unit& u, int wr, int wc, int fr, int fq) const {
        const int row0 = u.pm * BM + wr * 64 + fr, col0 = u.pn * BM + wc * 32 + 8 * fq;
#pragma unroll
        for (int ai = 0; ai < 2; ++ai)
#pragma unroll
            for (int m = 0; m < 4; ++m) { const int row = row0 + ai * HALF + m * 16;
                float s = (ssq4(acc[ai][0][m][0]) + ssq4(acc[ai][0][m][1])) + (ssq4(acc[ai][1][m][0]) + ssq4(acc[ai][1][m][1]));
                s += __shfl_xor(s, 16); s += __shfl_xor(s, 32);
                if (fq == 0) ssq[(size_t)row * 32 + u.pn * 4 + wc] = s;
#pragma unroll
                for (int bj = 0; bj < 2; ++bj) *(u32x4*)(Y + (size_t)row * DM + col0 + bj * HALF) = pack8(acc[ai][bj][m][0], acc[ai][bj][m][1]); }
    }
};

struct EpiFfn {
    static constexpr bool PERM = true, AFTER_DRAIN = false;
    bf16_t* G; float* AH; float* BH; const float* cw; const float* cb;
    __device__ __forceinline__ void operator()(const f32x4 (&acc)[2][2][4][2], const Unit& u, int wr, int wc, int fr, int fq) const {
        const int lane = threadIdx.x & 63;
        const int f0 = u.pn * 128 + wc * 32 + 8 * fq;
        f32x4 w0[2], w1[2], w2[2], bb[2];
#pragma unroll
        for (int n = 0; n < 2; ++n) { w0[n] = *(const f32x4*)(cw + f0 + 4 * n); w1[n] = *(const f32x4*)(cw + DFF + f0 + 4 * n); w2[n] = *(const f32x4*)(cw + 2 * DFF + f0 + 4 * n); bb[n] = *(const f32x4*)(cb + f0 + 4 * n); }
        const int src1 = (lane & 48) | ((fr - 1) & 15), src2 = (lane & 48) | ((fr - 2) & 15);
#pragma unroll
        for (int ai = 0; ai < 2; ++ai) {
            const int jb = u.pm * 4 + ai * 2 + wr;
            f32x4 p1[2], p2[2];
#pragma unroll
            for (int n = 0; n < 2; ++n) { p1[n] = (f32x4){0.f, 0.f, 0.f, 0.f}; p2[n] = p1[n]; }
#pragma unroll
            for (int m = 0; m < 4; ++m) {
                f32x4 o[2];
#pragma unroll
                for (int n = 0; n < 2; ++n) { f32x4 r1, r2;
#pragma unroll
                    for (int e = 0; e < 4; ++e) { const float a0 = acc[ai][0][m][n][e]; r1[e] = __shfl(a0, src1); r2[e] = __shfl(a0, src2); }
                    f32x4 a1, a2;
#pragma unroll
                    for (int e = 0; e < 4; ++e) { a1[e] = fr >= 1 ? r1[e] : p1[n][e]; a2[e] = fr >= 2 ? r2[e] : p2[n][e]; }
                    p1[n] = r1; p2[n] = r2;
                    const f32x4 c = bb[n] + w0[n] * a2 + w1[n] * a1 + w2[n] * acc[ai][0][m][n];
#pragma unroll
                    for (int e = 0; e < 4; ++e) { const float x = c[e]; const float uu = 0.7978845608028654f * (x + 0.044715f * x * x * x);
                        const float gl = x * __builtin_amdgcn_rcpf(1.f + __builtin_amdgcn_exp2f(-2.885390081777927f * uu)); o[n][e] = gl * acc[ai][1][m][n][e]; } }
                const int row = u.pm * BM + ai * HALF + wr * 64 + m * 16 + fr;
                if (!(m == 0 && fr < 2)) *(u32x4*)(G + (size_t)row * DFF + f0) = pack8(o[0], o[1]);
                if (m == 0 && fr < 2) { float* ah = AH + ((size_t)jb * 4 + 2 + fr) * DFF + f0; *(f32x4*)ah = acc[ai][0][0][0]; *(f32x4*)(ah + 4) = acc[ai][0][0][1];
                    float* bh = BH + ((size_t)jb * 2 + fr) * DFF + f0; *(f32x4*)bh = acc[ai][1][0][0]; *(f32x4*)(bh + 4) = acc[ai][1][0][1]; }
                if (m == 3 && fr >= 14) { float* ah = AH + ((size_t)jb * 4 + (fr - 14)) * DFF + f0; *(f32x4*)ah = acc[ai][0][3][0]; *(f32x4*)(ah + 4) = acc[ai][0][3][1]; }
            }
        }
    }
};
}
namespace att {
typedef short bf16x8 __attribute__((ext_vector_type(8)));
typedef short s16x4 __attribute__((ext_vector_type(4)));
typedef float f32x16 __attribute__((ext_vector_type(16)));
typedef float f32x4 __attribute__((ext_vector_type(4)));
typedef unsigned u32x4 __attribute__((ext_vector_type(4)));
typedef unsigned short bf16_t;
#define SBAR() __builtin_amdgcn_sched_barrier(0)
#define KSWZ(row, colB) ((row) * 256 + ((colB) ^ (((row) & 7) << 4)))
#define KSWZ64(row, chunk) ((row) * 128 + ((((chunk) ^ ((row) & 7))) << 4))
template <int NCB> __device__ __forceinline__ int v_st(int k, int c) { const int kk = (k & ~0xC) | ((k & 4) << 1) | ((k & 8) >> 1); return ((kk >> 3) * NCB + (c >> 5)) * 512 + ((kk & 7) * 32 + (c & 31)) * 2; }
__device__ __forceinline__ int v_rd_base(int lane) { return ((lane & 3) << 3) | (((lane >> 2) & 3) << 6) | (((lane >> 4) & 1) << 5) | (((lane >> 5) & 1) << 8); }
__device__ __forceinline__ int crow(int r, int hi) { return (r & 3) + 8 * (r >> 2) + 4 * hi; }
typedef float f32x2_cv __attribute__((ext_vector_type(2))); typedef __bf16 bf16x2_cv __attribute__((ext_vector_type(2)));
__device__ __forceinline__ unsigned cvtpk(float lo, float hi) { f32x2_cv v = {lo, hi}; bf16x2_cv b = __builtin_convertvector(v, bf16x2_cv); return __builtin_bit_cast(unsigned, b); }
__device__ __forceinline__ void mask_tile(f32x16& p0, f32x16& p1, int dq, unsigned W) {
    const float NEG = -__builtin_inff();
#pragma unroll
    for (int r = 0; r < 16; ++r) { const int c = (r & 3) + 8 * (r >> 2);
        if ((unsigned)(dq - c) >= W) p0[r] = NEG;
        if ((unsigned)(dq - c - 32) >= W) p1[r] = NEG; }
}
constexpr float THR = 8.f;
template <int SCALE_E6> __device__ __forceinline__ void partialSM(f32x16& p0, f32x16& p1, float& m_reg, float& mn, float& alpha) {
    constexpr float SCALE = SCALE_E6 * 1e-9f; constexpr float C2 = 1.4426950408889634f * SCALE;
    float pmax = p0[0];
#pragma unroll
    for (int r = 1; r < 16; ++r) pmax = fmaxf(pmax, p0[r]);
#pragma unroll
    for (int r = 0; r < 16; ++r) pmax = fmaxf(pmax, p1[r]);
    { auto rr = __builtin_amdgcn_permlane32_swap(__float_as_uint(pmax), __float_as_uint(pmax), false, false);
      pmax = fmaxf(__uint_as_float(rr[0]), __uint_as_float(rr[1])); }
    if (__builtin_expect(__all((pmax - m_reg) * SCALE <= THR), 1)) { mn = m_reg; alpha = 1.f; }
    else { mn = fmaxf(m_reg, pmax); alpha = __builtin_amdgcn_exp2f((m_reg - mn) * C2); m_reg = mn; }
    const float mnL = -mn * C2;
#pragma unroll
    for (int r = 0; r < 16; ++r) p0[r] = fmaf(p0[r], C2, mnL);
#pragma unroll
    for (int r = 0; r < 16; ++r) p1[r] = fmaf(p1[r], C2, mnL);
#pragma unroll
    for (int r = 0; r < 16; ++r) p0[r] = __builtin_amdgcn_exp2f(p0[r]);
}
__device__ __forceinline__ void partialSM_pre(f32x16& p0, f32x16& p1, float& m_reg, float& alpha) {
    constexpr float THR2 = THR * 1.4426950408889634f;
    float pmax = p0[0];
#pragma unroll
    for (int r = 1; r < 16; ++r) pmax = fmaxf(pmax, p0[r]);
#pragma unroll
    for (int r = 0; r < 16; ++r) pmax = fmaxf(pmax, p1[r]);
    { auto rr = __builtin_amdgcn_permlane32_swap(__float_as_uint(pmax), __float_as_uint(pmax), false, false);
      pmax = fmaxf(__uint_as_float(rr[0]), __uint_as_float(rr[1])); }
    if (__builtin_expect(__all(pmax <= THR2), 1)) { alpha = 1.f; }
    else { const float d = fmaxf(pmax, 0.f); m_reg += d; alpha = __builtin_amdgcn_exp2f(-d);
#pragma unroll
        for (int r = 0; r < 16; ++r) { p0[r] -= d; p1[r] -= d; } }
#pragma unroll
    for (int r = 0; r < 16; ++r) p0[r] = __builtin_amdgcn_exp2f(p0[r]);
}
__device__ __forceinline__ void finishSM(f32x16& p0, f32x16& p1, float alpha, float& l_reg, bf16x8& pa0, bf16x8& pa1, bf16x8& pa2, bf16x8& pa3) {
#pragma unroll
    for (int r = 0; r < 16; ++r) p1[r] = __builtin_amdgcn_exp2f(p1[r]);
    float ps = 0;
#pragma unroll
    for (int r = 0; r < 16; ++r) ps += p0[r];
#pragma unroll
    for (int r = 0; r < 16; ++r) ps += p1[r];
    { auto rr = __builtin_amdgcn_permlane32_swap(__float_as_uint(ps), __float_as_uint(ps), false, false);
      ps = __uint_as_float(rr[0]) + __uint_as_float(rr[1]); }
    l_reg = l_reg * alpha + ps;
#define PK4(P, B_, OUT) do { unsigned a0 = cvtpk(P[B_+0], P[B_+1]), a1 = cvtpk(P[B_+2], P[B_+3]);                          \
        unsigned b0 = cvtpk(P[B_+4], P[B_+5]), b1 = cvtpk(P[B_+6], P[B_+7]);                                             \
        auto r0 = __builtin_amdgcn_permlane32_swap(a0, b0, false, false); auto r1 = __builtin_amdgcn_permlane32_swap(a1, b1, false, false); \
        u32x4 w = {r0[0], r1[0], r0[1], r1[1]}; OUT = *reinterpret_cast<bf16x8*>(&w); } while (0)
    PK4(p0, 0, pa0); PK4(p0, 8, pa1); PK4(p1, 0, pa2); PK4(p1, 8, pa3);
#undef PK4
}
__device__ __forceinline__ void qk128(f32x16& p0, f32x16& p1, const LAS char* kl, int r32, int hi, const bf16x8* qr) {
    const LAS char* kb[4];
#pragma unroll
    for (int dd = 0; dd < 4; ++dd) kb[dd] = kl + KSWZ(r32, (dd * 16 + hi * 8) * 2);
#pragma unroll
    for (int d0 = 0; d0 < 8; ++d0) { const LAS char* a = kb[d0 & 3] + (d0 >> 2) * 128;
        const bf16x8 b0 = *reinterpret_cast<const LAS bf16x8*>(a);
        const bf16x8 b1 = *reinterpret_cast<const LAS bf16x8*>(a + 32 * 256);
        p0 = __builtin_amdgcn_mfma_f32_32x32x16_bf16(b0, qr[d0], p0, 0, 0, 0);
        p1 = __builtin_amdgcn_mfma_f32_32x32x16_bf16(b1, qr[d0], p1, 0, 0, 0); }
}
__device__ __forceinline__ void qk64(f32x16& p0, f32x16& p1, const LAS char* kl, int r32, int hi, const bf16x8* qr) {
#pragma unroll
    for (int ks = 0; ks < 4; ++ks) { const LAS char* a = kl + KSWZ64(r32, 2 * ks + hi);
        const bf16x8 b0 = *reinterpret_cast<const LAS bf16x8*>(a);
        const bf16x8 b1 = *reinterpret_cast<const LAS bf16x8*>(a + 32 * 128);
        p0 = __builtin_amdgcn_mfma_f32_32x32x16_bf16(b0, qr[ks], p0, 0, 0, 0);
        p1 = __builtin_amdgcn_mfma_f32_32x32x16_bf16(b1, qr[ks], p1, 0, 0, 0); }
}
__device__ __forceinline__ void qk_mla(f32x16& p0, f32x16& p1, int kaddr, int r32, int hi, const bf16x8* qr) {
    const int rb = kaddr + r32 * 256, sw = (r32 & 7) << 4, h16 = hi * 16;
    const int rr = kaddr + 16384 + r32 * 128;
#define KRD(dst, base, off) asm volatile("ds_read_b128 %0, %1 offset:%2" : "=&v"(dst) : "v"(base), "i"(off) : "memory")
#define WLK(n) do { asm volatile("s_waitcnt lgkmcnt(" #n ")" ::: "memory"); SBAR(); } while (0)
#define RDN(S, dd, off) do { const int a_ = rb + (((dd) * 32 + h16) ^ sw); KRD(S##0, a_, off); KRD(S##1, a_, 8192 + (off)); } while (0)
#define RDR(S, ks) do { const int a_ = rr + (((((ks) * 2 + hi)) ^ (r32 & 7)) << 4); KRD(S##0, a_, 0); KRD(S##1, a_, 4096); } while (0)
#define MM1(S, d) do { p0 = __builtin_amdgcn_mfma_f32_32x32x16_bf16(S##0, qr[d], p0, 0, 0, 0); p1 = __builtin_amdgcn_mfma_f32_32x32x16_bf16(S##1, qr[d], p1, 0, 0, 0); } while (0)
    bf16x8 A0, A1, B0, B1;
    RDN(A, 0, 0); RDN(B, 1, 0);
    WLK(2); MM1(A, 0); RDN(A, 2, 0);
    WLK(2); MM1(B, 1); RDN(B, 3, 0);
    WLK(2); MM1(A, 2); RDN(A, 0, 128);
    WLK(2); MM1(B, 3); RDN(B, 1, 128);
    WLK(2); MM1(A, 4); RDN(A, 2, 128);
    WLK(2); MM1(B, 5); RDN(B, 3, 128);
    WLK(2); MM1(A, 6); RDR(A, 0);
    WLK(2); MM1(B, 7); RDR(B, 1);
    WLK(2); MM1(A, 8); RDR(A, 2);
    WLK(2); MM1(B, 9); RDR(B, 3);
    WLK(2); MM1(A, 10);
    WLK(0); MM1(B, 11);
#undef MM1
#undef RDR
#undef RDN
#undef WLK
#undef KRD
}
template <int NCB> __device__ __forceinline__ void pv_tile(f32x16* o, int vb, bf16x8 pa0, bf16x8 pa1, bf16x8 pa2, bf16x8 pa3) {
#define TRRD(dst, off) asm volatile("ds_read_b64_tr_b16 %0, %1 offset:%2" : "=&v"(dst) : "v"(vb), "i"(off) : "memory")
    constexpr int KS_ = NCB * 1024;
#define PV_RD(S, d0) do { constexpr int b_ = (d0) * 512; TRRD(S##l0, b_); TRRD(S##h0, b_ + KS_ / 2); TRRD(S##l1, b_ + KS_); TRRD(S##h1, b_ + KS_ + KS_ / 2); TRRD(S##l2, b_ + 2 * KS_); TRRD(S##h2, b_ + 2 * KS_ + KS_ / 2); TRRD(S##l3, b_ + 3 * KS_); TRRD(S##h3, b_ + 3 * KS_ + KS_ / 2); } while (0)
#define PV_MM(S, d0) do { \
        o[d0] = __builtin_amdgcn_mfma_f32_32x32x16_bf16(pa0, (bf16x8){S##l0[0], S##l0[1], S##l0[2], S##l0[3], S##h0[0], S##h0[1], S##h0[2], S##h0[3]}, o[d0], 0, 0, 0);   \
        o[d0] = __builtin_amdgcn_mfma_f32_32x32x16_bf16(pa1, (bf16x8){S##l1[0], S##l1[1], S##l1[2], S##l1[3], S##h1[0], S##h1[1], S##h1[2], S##h1[3]}, o[d0], 0, 0, 0);   \
        o[d0] = __builtin_amdgcn_mfma_f32_32x32x16_bf16(pa2, (bf16x8){S##l2[0], S##l2[1], S##l2[2], S##l2[3], S##h2[0], S##h2[1], S##h2[2], S##h2[3]}, o[d0], 0, 0, 0);   \
        o[d0] = __builtin_amdgcn_mfma_f32_32x32x16_bf16(pa3, (bf16x8){S##l3[0], S##l3[1], S##l3[2], S##l3[3], S##h3[0], S##h3[1], S##h3[2], S##h3[3]}, o[d0], 0, 0, 0); } while (0)
#define WL(n) do { asm volatile("s_waitcnt lgkmcnt(" #n ")" ::: "memory"); SBAR(); } while (0)
    s16x4 Al0, Al1, Al2, Al3, Ah0, Ah1, Ah2, Ah3, Bl0, Bl1, Bl2, Bl3, Bh0, Bh1, Bh2, Bh3;
    PV_RD(A, 0); PV_RD(B, 1); WL(8); PV_MM(A, 0);
    if constexpr (NCB == 4) { PV_RD(A, 2); WL(8); PV_MM(B, 1); PV_RD(B, 3); WL(8); PV_MM(A, 2); WL(0); PV_MM(B, 3); }
    else { WL(0); PV_MM(B, 1); }
#undef WL
#undef PV_MM
#undef PV_RD
#undef TRRD
}

struct AttnP {
    bf16_t* QN; const bf16_t* QR; const bf16_t* KN; const bf16_t* KR; const bf16_t* V;
    bf16_t* QS; const bf16_t* KS; const bf16_t* VS;
    const float* sinks; const float* rel;
};
__device__ const unsigned char T5B[128] = {0, 1, 2, 3, 4, 5, 6, 7, 8, 9, 10, 11, 12, 13, 14, 15, 16, 16, 16, 17, 17, 18, 18, 18, 19, 19, 19, 20, 20, 20, 20, 21, 21, 21, 21, 22, 22, 22, 22, 22, 23, 23, 23, 23, 23, 23, 24, 24, 24, 24, 24, 24, 25, 25, 25, 25, 25, 25, 25, 26, 26, 26, 26, 26, 26, 26, 26, 27, 27, 27, 27, 27, 27, 27, 27, 27, 27, 28, 28, 28, 28, 28, 28, 28, 28, 28, 28, 29, 29, 29, 29, 29, 29, 29, 29, 29, 29, 29, 29, 30, 30, 30, 30, 30, 30, 30, 30, 30, 30, 30, 30, 30, 30, 31, 31, 31, 31, 31, 31, 31, 31, 31, 31, 31, 31, 31, 31, 31};

template <bool MLA> __device__ __forceinline__ void attn_unit(const AttnP& P, int b, int hh, int qb, LAS char* lds) {
    constexpr int DV = MLA ? 128 : 64, NCB = DV / 32, NQF = MLA ? 12 : 4;
    constexpr int KBYTES = MLA ? 24576 : 8192, VBYTES = 64 * DV * 2;
    constexpr int SC9 = MLA ? 72168784 : 125000000;
    constexpr float SCALE = SC9 * 1e-9f;
    constexpr int W = MLA ? (1 << 30) : 128;
    const int tid = threadIdx.x, wid = __builtin_amdgcn_readfirstlane(tid >> 6), lane = tid & 63, r32 = lane & 31, hi = lane >> 5;
    LAS char* V_lds = lds; LAS char* K_lds = lds + 2 * VBYTES;
    LAS float* ws = (LAS float*)(lds + 2 * VBYTES + 2 * KBYTES) + wid * 64; LAS float* li_l = ws; LAS float* al_l = ws + 32;
    LAS float* bias_l = (LAS float*)(lds + 2 * VBYTES + 2 * KBYTES + 2048);
    const int q0 = qb * 256; const size_t rowbase = (size_t)b * SEQ;
    const int jt0 = MLA ? 0 : (q0 == 0 ? 0 : -2);
    const int NT = MLA ? 4 * qb + 4 : 4 - jt0;
    const int kbase0 = MLA ? 0 : q0 + 64 * jt0;
    const int qlo = q0 + wid * 32, qm = qlo + r32 - 4 * hi;
    bf16x8 qr[NQF];
    const size_t qrow = rowbase + qlo + r32;
    if constexpr (MLA) {
#pragma unroll
        for (int d0 = 0; d0 < 8; ++d0) qr[d0] = *(const bf16x8*)(P.QN + qrow * 2048 + hh * 128 + d0 * 16 + hi * 8);
#pragma unroll
        for (int d0 = 0; d0 < 4; ++d0) qr[8 + d0] = *(const bf16x8*)(P.QR + qrow * 1024 + hh * 64 + d0 * 16 + hi * 8);
    } else {
#pragma unroll
        for (int d0 = 0; d0 < 4; ++d0) qr[d0] = *(const bf16x8*)(P.QS + qrow * 2048 + hh * 64 + d0 * 16 + hi * 8);
        if (tid < 128) bias_l[tid] = P.rel[(int)T5B[tid] * 32 + hh] * (1.0f / SCALE);
    }
    bf16x8 sk0, sv0;
    const int sr8 = tid >> 3, ch8 = tid & 7;
    const bf16_t* Kg; const bf16_t* Vg; const bf16_t* Rg = nullptr;
    unsigned okA = 0, okB = 0, orp = 0, ovA = 0, ovB = 0;
    if constexpr (MLA) {
        Kg = P.KN + rowbase * 2048 + hh * 128; Vg = P.V + rowbase * 2048 + hh * 128; Rg = P.KR + rowbase * 64;
        { const int rA = 4 * wid + (lane >> 4), rB = rA + 32, cp = lane & 15; okA = (unsigned)(rA * 2048 + ((cp ^ (rA & 7)) << 3)); okB = (unsigned)(rB * 2048 + ((cp ^ (rB & 7)) << 3)); }
        { const int rr = 8 * wid + (lane >> 3), cp = lane & 7; orp = (unsigned)(rr * 64 + ((cp ^ (rr & 7)) << 3)); }
        { const int stA = 2 * wid + (lane >> 5), stB = stA + 16; const int kl = (lane & 31) >> 2, c8 = 8 * (lane & 3);
          const int kkA = (stA >> 2) * 8 + kl, kkB = (stB >> 2) * 8 + kl;
          const int kA = (kkA & ~0xC) | ((kkA & 4) << 1) | ((kkA & 8) >> 1), kB = (kkB & ~0xC) | ((kkB & 4) << 1) | ((kkB & 8) >> 1);
          ovA = (unsigned)(kA * 2048 + 32 * (stA & 3) + c8); ovB = (unsigned)(kB * 2048 + 32 * (stB & 3) + c8); }
    } else { Kg = P.KS + (rowbase + sr8) * 256 + (hh >> 3) * 64 + ch8 * 8; Vg = P.VS + (rowbase + sr8) * 256 + (hh >> 3) * 64 + ch8 * 8; }
    const int kws = KSWZ64(sr8, ch8), vst0 = v_st<NCB>(sr8, ch8 * 8);
#define GLDS(gp, lp) __builtin_amdgcn_global_load_lds((const unsigned*)(gp), (LAS unsigned*)(lp), 16, 0, 0)
#define LOADT(t, bf) do { const size_t k0_ = (size_t)(kbase0 + 64 * (t)); \
        if constexpr (MLA) { LAS char* kd_ = K_lds + (bf) * KBYTES + wid * 1024; LAS char* vd_ = V_lds + (bf) * VBYTES + wid * 1024; \
            const bf16_t* kp_ = Kg + k0_ * 2048; const bf16_t* vp_ = Vg + k0_ * 2048; const bf16_t* rp_ = Rg + k0_ * 64; \
            GLDS(kp_ + okA, kd_); GLDS(kp_ + okB, kd_ + 8192); GLDS(rp_ + orp, kd_ + 16384); GLDS(vp_ + ovA, vd_); GLDS(vp_ + ovB, vd_ + 8192); } \
        else { sk0 = *(const bf16x8*)(Kg + k0_ * 256); sv0 = *(const bf16x8*)(Vg + k0_ * 256); } } while (0)
#define WRITET(bf) do { if constexpr (!MLA) { *(LAS bf16x8*)(K_lds + (bf) * KBYTES + kws) = sk0; *(LAS bf16x8*)(V_lds + (bf) * VBYTES + vst0) = sv0; } } while (0)
    float m_reg = MLA ? 0.f : P.sinks[hh] * (1.0f / SCALE), l_reg = MLA ? 0.f : 1.f;
    f32x16 o[NCB];
#pragma unroll
    for (int d = 0; d < NCB; ++d) o[d] = f32x16{};
    const int vb0 = (int)(uintptr_t)V_lds + v_rd_base(lane);
    LOADT(0, 0); asm volatile("s_waitcnt vmcnt(0)" ::: "memory"); WRITET(0); __syncthreads();
    for (int t = 0; t < NT; ++t) {
        const int buf = t & 1;
        if (t + 1 < NT) LOADT(t + 1, buf ^ 1);
        const int kb = kbase0 + 64 * t;
        const bool act = (kb <= qlo + 31) && (MLA || kb + 63 >= qlo - (W - 1));
        if (act) {
            f32x16 p0 = f32x16{}, p1 = f32x16{};
            if constexpr (MLA) {
#pragma unroll
                for (int r = 0; r < 16; ++r) { p0[r] = -m_reg; p1[r] = -m_reg; } }
            if constexpr (MLA) { qk_mla(p0, p1, (int)(uintptr_t)K_lds + buf * KBYTES, r32, hi, qr); }
            else { qk64(p0, p1, K_lds + buf * KBYTES, r32, hi, qr); }
            const int dq = qm - kb;
            if constexpr (!MLA) {
#pragma unroll
                for (int r = 0; r < 16; ++r) { const int c = (r & 3) + 8 * (r >> 2); p0[r] += bias_l[(dq - c) & 127]; p1[r] += bias_l[(dq - c - 32) & 127]; }
            }
            if (kb + 63 > qlo || (!MLA && kb <= qlo + 31 - W)) mask_tile(p0, p1, dq, (unsigned)W);
            float mn, alpha; bf16x8 pa0, pa1, pa2, pa3;
            if constexpr (MLA) { partialSM_pre(p0, p1, m_reg, alpha); (void)mn; } else { partialSM<SC9>(p0, p1, m_reg, mn, alpha); }
            finishSM(p0, p1, alpha, l_reg, pa0, pa1, pa2, pa3);
            if (__any(alpha < 1.f)) { if (hi == 0) al_l[r32] = alpha; asm volatile("s_waitcnt lgkmcnt(0)" ::: "memory");
#pragma unroll
                for (int d_ = 0; d_ < NCB; ++d_)
#pragma unroll
                    for (int r = 0; r < 16; ++r) o[d_][r] *= al_l[crow(r, hi)]; }
            SBAR();
            pv_tile<NCB>(o, vb0 + buf * VBYTES, pa0, pa1, pa2, pa3);
        }
        if (t + 1 < NT) { asm volatile("s_waitcnt vmcnt(0)" ::: "memory"); WRITET(buf ^ 1); }
        __syncthreads();
    }
    if (hi == 0) li_l[r32] = l_reg; asm volatile("s_waitcnt lgkmcnt(0)" ::: "memory");
    bf16_t* Ow = (MLA ? P.QN + (rowbase + qlo) * 2048 + hh * 128 : P.QS + (rowbase + qlo) * 2048 + hh * 64);
#pragma unroll
    for (int r = 0; r < 16; ++r) { const int orow = crow(r, hi); const float rl = __builtin_amdgcn_rcpf(li_l[orow]);
#pragma unroll
        for (int d0 = 0; d0 < NCB; ++d0) { const float v = o[d0][r] * rl; const float vn = __shfl_xor(v, 1);
            if ((r32 & 1) == 0) *(unsigned*)(Ow + (size_t)orow * 2048 + d0 * 32 + r32) = cvtpk(v, vn); } }
    __syncthreads();
#undef LOADT
#undef WRITET
#undef GLDS
}
#undef SBAR
}
typedef unsigned short bf16;
typedef unsigned v4u __attribute__((ext_vector_type(4)));
typedef float f32x4 __attribute__((ext_vector_type(4)));
constexpr size_t MiB = 1u << 20;
constexpr size_t WS_WIN = 1 * MiB, WS_WQ = 31 * MiB, WS_WKV = 34 * MiB, WS_WOA = 36 * MiB, WS_WOB = 44 * MiB, WS_WOUT = 52 * MiB, WS_WUP = 60 * MiB, WS_WDN = 104 * MiB;
constexpr size_t WS_ROPE = 126 * MiB;
constexpr size_t WS_SSQQ = 130 * MiB, WS_SSQKV = 131 * MiB, WS_SSQY = 132 * MiB, WS_SSQY2 = 136 * MiB;
constexpr size_t WS_XN = 140 * MiB;
constexpr size_t WS_CQ = 268 * MiB, WS_CKV = 300 * MiB, WS_KR = 316 * MiB, WS_KS = 320 * MiB, WS_VS = 336 * MiB, WS_QS = 352 * MiB;
constexpr size_t WS_QN = 480 * MiB, WS_QR = 608 * MiB, WS_KN = 672 * MiB, WS_V = 800 * MiB;
constexpr size_t WS_GT = 608 * MiB, WS_MG = 864 * MiB;
constexpr size_t WS_Y = 140 * MiB, WS_X1 = 768 * MiB, WS_H2 = 640 * MiB;
constexpr size_t WS_G = 140 * MiB, WS_AH = 492 * MiB, WS_BH = 536 * MiB;
constexpr size_t WS_Y2 = 640 * MiB, WS_END = 1024 * MiB;

struct Args {
    const float *x, *g_mix_pre, *g_mix_post, *g_ffn_pre, *g_ffn_post, *w_in, *q_norm, *w_q_up, *kv_norm, *w_kv_up, *sinks, *rel, *w_o_mla, *w_o_swa, *w_out, *w_up, *conv_w, *conv_b, *w_down;
    float* out; unsigned char* ws; int ph_lo, ph_hi;
};

__device__ __forceinline__ unsigned f2bf(float f) { unsigned u = __builtin_bit_cast(unsigned, f); return (u + 0x7fffu + ((u >> 16) & 1u)) >> 16; }
__device__ __forceinline__ unsigned pk2(float lo, float hi) { return f2bf(lo) | (f2bf(hi) << 16); }
__device__ __forceinline__ float wave_sum(float v) {
#pragma unroll
    for (int o = 1; o < 64; o <<= 1) v += __shfl_xor(v, o);
    return v;
}
__device__ __forceinline__ void tr_item(const float* W, int K, int Nsrc, int k0, int nsrc0, bf16* WT, int drow0, int dstride, const float* gain, LAS float* scr, int lane) {
#pragma unroll 8
    for (int i = 0; i < 32; ++i) { const int kk = 2 * i + (lane >> 5); float v = W[(size_t)(k0 + kk) * Nsrc + nsrc0 + (lane & 31)]; if (gain) v *= gain[k0 + kk]; scr[kk * 33 + (lane & 31)] = v; }
    asm volatile("s_waitcnt lgkmcnt(0)" ::: "memory");
    const int c = lane & 7;
#pragma unroll
    for (int j = 0; j < 4; ++j) { const int n = (lane >> 3) + 8 * j; const LAS float* s = scr + (8 * c) * 33 + n;
        v4u o; o.x = pk2(s[0 * 33], s[1 * 33]); o.y = pk2(s[2 * 33], s[3 * 33]); o.z = pk2(s[4 * 33], s[5 * 33]); o.w = pk2(s[6 * 33], s[7 * 33]);
        *(v4u*)(WT + (size_t)(drow0 + n * dstride) * K + k0 + 8 * c) = o; }
    asm volatile("s_waitcnt lgkmcnt(0)" ::: "memory");
}

__global__ void __launch_bounds__(512) fwd_mega(Args a) {
    extern __shared__ __attribute__((aligned(16))) unsigned char lds_raw[];
    LAS unsigned char* lds = (LAS unsigned char*)lds_raw;
    cg::grid_group grid = cg::this_grid();
    const int tid = threadIdx.x, lane = tid & 63, wave = __builtin_amdgcn_readfirstlane(tid >> 6);
    const int G = gridDim.x, bx = blockIdx.x;
    const int vcu = (G % 8 == 0) ? (bx % 8) * (G / 8) + bx / 8 : bx;
    unsigned char* ws = a.ws;
    bf16 *Win_t = (bf16*)(ws + WS_WIN), *Wq_t = (bf16*)(ws + WS_WQ), *Wkv_t = (bf16*)(ws + WS_WKV), *WoA_t = (bf16*)(ws + WS_WOA), *WoB_t = (bf16*)(ws + WS_WOB),
         *Wout_t = (bf16*)(ws + WS_WOUT), *Wup_t = (bf16*)(ws + WS_WUP), *Wdn_t = (bf16*)(ws + WS_WDN);
    float* rope = (float*)(ws + WS_ROPE);
    float *ssqQ = (float*)(ws + WS_SSQQ), *ssqKV = (float*)(ws + WS_SSQKV), *ssqY = (float*)(ws + WS_SSQY), *ssqY2 = (float*)(ws + WS_SSQY2);
    bf16 *XN = (bf16*)(ws + WS_XN), *CQ = (bf16*)(ws + WS_CQ), *CKV = (bf16*)(ws + WS_CKV), *KR = (bf16*)(ws + WS_KR), *KS = (bf16*)(ws + WS_KS), *VS = (bf16*)(ws + WS_VS), *QS = (bf16*)(ws + WS_QS);
    bf16 *QN = (bf16*)(ws + WS_QN), *QR = (bf16*)(ws + WS_QR), *KN = (bf16*)(ws + WS_KN), *VV = (bf16*)(ws + WS_V), *MG = (bf16*)(ws + WS_MG), *GG = (bf16*)(ws + WS_G);
    bf16 *GT = (bf16*)(ws + WS_GT), *Y = (bf16*)(ws + WS_Y), *Y2 = (bf16*)(ws + WS_Y2), *H2 = (bf16*)(ws + WS_H2);
    float *X1 = (float*)(ws + WS_X1), *AH = (float*)(ws + WS_AH), *BH = (float*)(ws + WS_BH);
    const int gw = vcu * 8 + wave, NGW = G * 8;
    const int lo = a.ph_lo, hi = a.ph_hi;
#ifndef PHMASK
#define PHMASK 0xFFFF
#endif
#define IN(k) (((PHMASK >> (k)) & 1) && lo <= (k) && (k) < hi)
#define SEAM(k) do { if (IN(k) && IN((k) + 1)) { asm volatile("s_waitcnt vmcnt(0) lgkmcnt(0)" ::: "memory"); __syncthreads(); \
        if (wave == 0) { __builtin_amdgcn_fence(__ATOMIC_RELEASE, "agent"); asm volatile("s_waitcnt vmcnt(0)" ::: "memory"); }     \
        grid.sync(); \
        if (wave == 0) { __builtin_amdgcn_fence(__ATOMIC_ACQUIRE, "agent"); asm volatile("s_waitcnt vmcnt(0)" ::: "memory"); }     \
        __syncthreads(); } } while (0)

    if (IN(0)) {
        LAS float* scr = (LAS float*)(lds + wave * 16384);
        constexpr int I_IN = 32 * 234, I_Q = 8 * 96, I_KV = 4 * 128, I_O = 32 * 64, I_UP = 32 * 352, I_DN = 88 * 64;
        constexpr int NITEMS = I_IN + I_Q + I_KV + 3 * I_O + I_UP + I_DN;
        for (int it = gw; it < NITEMS; it += NGW) {
            int r = it;
            if (r < I_IN) { const int kb = r / 234, c = (r % 234) * 32; int d0, ds = 1;
                if (c < 768) d0 = c; else if (c < 832) { d0 = 768 + (c - 768) / 32; ds = 2; } else d0 = c + 192;
                tr_item(a.w_in, 2048, 7488, kb * 64, c, Win_t, d0, ds, nullptr, scr, lane); continue; } r -= I_IN;
            if (r < I_Q) { const int kb = r / 96, c = (r % 96) * 32, h = c / 192, w = c % 192; int d0, ds = 1;
                if (w < 128) d0 = 128 * h + w; else { d0 = 2048 + 64 * h + (w - 128) / 32; ds = 2; }
                tr_item(a.w_q_up, 512, 3072, kb * 64, c, Wq_t, d0, ds, a.q_norm, scr, lane); continue; } r -= I_Q;
            if (r < I_KV) { const int kb = r / 128, c = (r % 128) * 32, h = c / 256, w = c % 256;
                const int d0 = w < 128 ? 128 * h + w : 2048 + 128 * h + (w - 128);
                tr_item(a.w_kv_up, 256, 4096, kb * 64, c, Wkv_t, d0, 1, a.kv_norm, scr, lane); continue; } r -= I_KV;
            if (r < 3 * I_O) { const int wsel = r / I_O, q = r % I_O, kb = q / 64, c = (q % 64) * 32;
                tr_item(wsel == 0 ? a.w_o_mla : wsel == 1 ? a.w_o_swa : a.w_out, 2048, 2048, kb * 64, c, wsel == 0 ? WoA_t : wsel == 1 ? WoB_t : Wout_t, c, 1, nullptr, scr, lane); continue; } r -= 3 * I_O;
            if (r < I_UP) { const int kb = r / 352, c = (r % 352) * 32; int d0;
                if (c < DFF) d0 = 256 * (c / 128) + (c % 128); else { const int c2 = c - DFF; d0 = 256 * (c2 / 128) + 128 + (c2 % 128); }
                tr_item(a.w_up, 2048, 11264, kb * 64, c, Wup_t, d0, 1, nullptr, scr, lane); continue; } r -= I_UP;
            { const int kb = r / 64, c = (r % 64) * 32; tr_item(a.w_down, DFF, 2048, kb * 64, c, Wdn_t, c, 1, nullptr, scr, lane); }
        }
        for (int i = bx * 512 + tid; i < 192 * 2048 / 8; i += G * 512) *(v4u*)(Win_t + (size_t)832 * 2048 + (size_t)i * 8) = (v4u){0u, 0u, 0u, 0u};
        for (int i = bx * 512 + tid; i < SEQ * 32; i += G * 512) { const int pos = i >> 5, k = i & 31;
            const float inv = __builtin_amdgcn_exp2f(-(float)(2 * k) * (13.287712379549449f / 64.0f)); const float ang = (float)pos * inv;
            const double rev = (double)ang * 0.15915494309189535; const float fr = (float)(rev - __builtin_rint(rev));
            rope[2 * i] = __builtin_amdgcn_cosf(fr); rope[2 * i + 1] = __builtin_amdgcn_sinf(fr); }
        for (int m = gw; m < NTOK; m += NGW) {
            const f32x4* xr = (const f32x4*)(a.x + (size_t)m * DM) + lane; f32x4 v[8]; float s = 0.f;
#pragma unroll
            for (int j = 0; j < 8; ++j) { v[j] = xr[64 * j]; s += (v[j].x * v[j].x + v[j].y * v[j].y) + (v[j].z * v[j].z + v[j].w * v[j].w); }
            const float rs = 1.0f / sqrtf(wave_sum(s) * (1.f / DM) + EPS);
            unsigned long long* o8 = (unsigned long long*)(XN + (size_t)m * DM) + lane;
#pragma unroll
            for (int j = 0; j < 8; ++j) { const f32x4 g = *((const f32x4*)a.g_mix_pre + lane + 64 * j);
                o8[64 * j] = (unsigned long long)pk2(v[j].x * rs * g.x, v[j].y * rs * g.y) | ((unsigned long long)pk2(v[j].z * rs * g.z, v[j].w * rs * g.w) << 32); }
        }
    }
    SEAM(0);
    if (IN(1)) {
        pg8::Gemm g{XN, Win_t, NTOK, 3584, 2048}; pg8::StaticOrder S; S.init(NTOK, 3584, G, bx);
        ep::EpiIn E{CQ, CKV, KR, QS, KS, VS, ssqQ, ssqKV, rope};
        pg8::gemm_phase<ep::EpiIn, pg8::StaticOrder, true, true>(lds, g, S, E);
    }
    SEAM(1);
    if (IN(2)) {
        { pg8::Gemm g{CQ, Wq_t, NTOK, 3072, 512}; pg8::StaticOrder S; S.init(NTOK, 3072, G, bx);
          ep::EpiUp E{ssqQ, 8, 1.0f / 512.0f, QN, QR, 2048, 1024, 8, 1, rope, 0.07216878364870322f * 1.4426950408889634f};
          pg8::gemm_phase<ep::EpiUp, pg8::StaticOrder, true, true>(lds, g, S, E); }
        { pg8::Gemm g{CKV, Wkv_t, NTOK, 4096, 256}; pg8::StaticOrder S; S.init(NTOK, 4096, G, bx);
          ep::EpiUp E{ssqKV, 4, 1.0f / 256.0f, KN, VV, 2048, 2048, 8, 0, rope, 1.0f};
          pg8::gemm_phase<ep::EpiUp, pg8::StaticOrder, true, true>(lds, g, S, E); }
    }
    SEAM(2);
    if (IN(3)) {
        att::AttnP P{QN, QR, KN, KR, VV, QS, KS, VS, a.sinks, a.rel};
#ifndef NO_MLA
        for (int it = vcu; it < 1024; it += G) { const int bh = it >> 5, s = it & 31;
            att::attn_unit<true>(P, bh >> 4, bh & 15, 63 - s, (LAS char*)lds);
            att::attn_unit<true>(P, bh >> 4, bh & 15, s, (LAS char*)lds); }
#endif
#ifndef NO_SWA
        for (int it = vcu; it < 4096; it += G) { const int qb = it & 63, hq = (it >> 6) & 31, b = it >> 11;
            att::attn_unit<false>(P, b, hq, qb, (LAS char*)lds); }
#endif
    }
    SEAM(3);
    if (IN(4)) {
        pg8::Gemm g{XN, Win_t + (size_t)3584 * 2048, NTOK, 4096, 2048}; pg8::StaticOrder S; S.init(NTOK, 4096, G, bx);
        ep::EpiSig E{GT}; pg8::gemm_phase<ep::EpiSig, pg8::StaticOrder, true, true>(lds, g, S, E);
    }
    SEAM(4);
    if (IN(5)) {
        { pg8::Gemm g{QN, WoA_t, NTOK, 2048, 2048}; pg8::StaticOrder S; S.init(NTOK, 2048, G, bx);
          ep::EpiGate<false> E{GT, MG}; pg8::gemm_phase<ep::EpiGate<false>, pg8::StaticOrder, true, true>(lds, g, S, E); }
        { pg8::Gemm g{QS, WoB_t, NTOK, 2048, 2048}; pg8::StaticOrder S; S.init(NTOK, 2048, G, bx);
          ep::EpiGate<true> E{GT, MG}; pg8::gemm_phase<ep::EpiGate<true>, pg8::StaticOrder, true, true>(lds, g, S, E); }
    }
    SEAM(5);
    if (IN(6)) {
        pg8::Gemm g{MG, Wout_t, NTOK, 2048, 2048}; pg8::StaticOrder S; S.init(NTOK, 2048, G, bx);
        ep::EpiBfSsq E{Y, ssqY}; pg8::gemm_phase<ep::EpiBfSsq, pg8::StaticOrder, true, true>(lds, g, S, E);
    }
    SEAM(6);
    if (IN(7)) {
        for (int m = gw; m < NTOK; m += NGW) {
            float sy = ssqY[(size_t)m * 32 + (lane & 31)];
#pragma unroll
            for (int o = 1; o < 32; o <<= 1) sy += __shfl_xor(sy, o);
            const float rsy = 1.0f / sqrtf(sy * (1.f / DM) + EPS);
            const f32x4* xr = (const f32x4*)(a.x + (size_t)m * DM) + lane; const unsigned long long* yr = (const unsigned long long*)(Y + (size_t)m * DM) + lane;
            f32x4* outr = (f32x4*)(X1 + (size_t)m * DM) + lane; f32x4 v[8]; float s = 0.f;
#pragma unroll
            for (int j = 0; j < 8; ++j) { const f32x4 g = *((const f32x4*)a.g_mix_post + lane + 64 * j); const unsigned long long yw = yr[64 * j];
                const f32x4 yv = {__uint_as_float((unsigned)yw << 16), __uint_as_float((unsigned)yw & 0xffff0000u), __uint_as_float((unsigned)(yw >> 32) << 16), __uint_as_float((unsigned)(yw >> 32) & 0xffff0000u)};
                v[j] = xr[64 * j] + yv * rsy * g; outr[64 * j] = v[j];
                s += (v[j].x * v[j].x + v[j].y * v[j].y) + (v[j].z * v[j].z + v[j].w * v[j].w); }
            const float rs = 1.0f / sqrtf(wave_sum(s) * (1.f / DM) + EPS);
            unsigned long long* o8 = (unsigned long long*)(H2 + (size_t)m * DM) + lane;
#pragma unroll
            for (int j = 0; j < 8; ++j) { const f32x4 g = *((const f32x4*)a.g_ffn_pre + lane + 64 * j);
                o8[64 * j] = (unsigned long long)pk2(v[j].x * rs * g.x, v[j].y * rs * g.y) | ((unsigned long long)pk2(v[j].z * rs * g.z, v[j].w * rs * g.w) << 32); }
        }
    }
    SEAM(7);
    if (IN(8)) {
        pg8::Gemm g{H2, Wup_t, NTOK, 11264, 2048}; pg8::StaticOrder S; S.init(NTOK, 11264, G, bx);
        ep::EpiFfn E{GG, AH, BH, a.conv_w, a.conv_b}; pg8::gemm_phase<ep::EpiFfn, pg8::StaticOrder, true, true>(lds, g, S, E);
    }
    SEAM(8);
    if (IN(9)) {
        constexpr int NF4 = DFF / 4;
        for (int i = bx * 512 + tid; i < 1024 * NF4; i += G * 512) { const int f = (i % NF4) * 4, rj = i / NF4, jb = rj >> 1, ii = rj & 1; const bool first = (jb & 255) == 0;
            const f32x4 z = {0.f, 0.f, 0.f, 0.f};
            const f32x4 a0 = *(const f32x4*)(AH + ((size_t)jb * 4 + 2 + ii) * DFF + f);
            const f32x4 pm1 = first ? z : *(const f32x4*)(AH + ((size_t)(jb - 1) * 4 + 1) * DFF + f);
            const f32x4 pm2 = first ? z : *(const f32x4*)(AH + ((size_t)(jb - 1) * 4 + 0) * DFF + f);
            const f32x4 a1 = ii ? *(const f32x4*)(AH + ((size_t)jb * 4 + 2) * DFF + f) : pm1;
            const f32x4 a2 = ii ? pm1 : pm2;
            const f32x4 bv = *(const f32x4*)(BH + ((size_t)jb * 2 + ii) * DFF + f);
            const f32x4 c = *(const f32x4*)(a.conv_b + f) + *(const f32x4*)(a.conv_w + f) * a2 + *(const f32x4*)(a.conv_w + DFF + f) * a1 + *(const f32x4*)(a.conv_w + 2 * DFF + f) * a0;
            float o[4];
#pragma unroll
            for (int e = 0; e < 4; ++e) { const float x = c[e]; const float uu = 0.7978845608028654f * (x + 0.044715f * x * x * x);
                o[e] = x * __builtin_amdgcn_rcpf(1.f + __builtin_amdgcn_exp2f(-2.885390081777927f * uu)) * bv[e]; }
            *(unsigned long long*)(GG + ((size_t)jb * 64 + ii) * DFF + f) = (unsigned long long)pk2(o[0], o[1]) | ((unsigned long long)pk2(o[2], o[3]) << 32); }
    }
    SEAM(9);
    if (IN(10)) {
        pg8::Gemm g{GG, Wdn_t, NTOK, 2048, DFF}; pg8::StaticOrder S; S.init(NTOK, 2048, G, bx);
        ep::EpiBfSsq E{Y2, ssqY2}; pg8::gemm_phase<ep::EpiBfSsq, pg8::StaticOrder, true, true>(lds, g, S, E);
    }
    SEAM(10);
    if (IN(11)) {
        for (int m = gw; m < NTOK; m += NGW) {
            float sy = ssqY2[(size_t)m * 32 + (lane & 31)];
#pragma unroll
            for (int o = 1; o < 32; o <<= 1) sy += __shfl_xor(sy, o);
            const float rsy = 1.0f / sqrtf(sy * (1.f / DM) + EPS);
            const unsigned long long* yr = (const unsigned long long*)(Y2 + (size_t)m * DM) + lane; const f32x4* x1r = (const f32x4*)(X1 + (size_t)m * DM) + lane; f32x4* outr = (f32x4*)(a.out + (size_t)m * DM) + lane;
#pragma unroll
            for (int j = 0; j < 8; ++j) { const f32x4 g = *((const f32x4*)a.g_ffn_post + lane + 64 * j); const unsigned long long yw = yr[64 * j];
                const f32x4 yv = {__uint_as_float((unsigned)yw << 16), __uint_as_float((unsigned)yw & 0xffff0000u), __uint_as_float((unsigned)(yw >> 32) << 16), __uint_as_float((unsigned)(yw >> 32) & 0xffff0000u)};
                outr[64 * j] = x1r[64 * j] + yv * rsy * g; }
        }
    }
#undef IN
#undef SEAM
}

constexpr int LDS_BYTES = 147456;
extern "C" void kernel_launch(void* const* d_in, const int* in_sizes, int n_in, void* d_out, int out_size, void* d_ws, size_t ws_size, hipStream_t stream) {
    static int grid = 0;
    if (grid == 0) {
        if (n_in != 19 || in_sizes[0] != NTOK * DM || out_size != NTOK * DM || ws_size < WS_END) { fprintf(stderr, "kernel_launch: unexpected shapes (n_in %d, in0 %d, out %d, ws %zu)\n", n_in, n_in > 0 ? in_sizes[0] : -1, out_size, ws_size); grid = -1; return; }
        int dev = 0, cus = 0, per_cu = 0;
        hipGetDevice(&dev); hipDeviceGetAttribute(&cus, hipDeviceAttributeMultiprocessorCount, dev);
        if (hipFuncSetAttribute((const void*)fwd_mega, hipFuncAttributeMaxDynamicSharedMemorySize, LDS_BYTES) != hipSuccess) { fprintf(stderr, "kernel_launch: hipFuncSetAttribute failed\n"); grid = -1; return; }
        if (hipOccupancyMaxActiveBlocksPerMultiprocessor(&per_cu, (const void*)fwd_mega, 512, LDS_BYTES) != hipSuccess || per_cu < 1) { fprintf(stderr, "kernel_launch: occupancy query says %d\n", per_cu); per_cu = 1; }
        (void)hipGetLastError();
        grid = cus * 1;
        if (grid % 8 != 0 || grid <= 0) { fprintf(stderr, "kernel_launch: odd CU count %d\n", cus); }
    }
    if (grid < 0) return;
    Args a{};
    a.x = (const float*)d_in[0]; a.g_mix_pre = (const float*)d_in[1]; a.g_mix_post = (const float*)d_in[2]; a.g_ffn_pre = (const float*)d_in[3]; a.g_ffn_post = (const float*)d_in[4];
    a.w_in = (const float*)d_in[5]; a.q_norm = (const float*)d_in[6]; a.w_q_up = (const float*)d_in[7]; a.kv_norm = (const float*)d_in[8]; a.w_kv_up = (const float*)d_in[9];
    a.sinks = (const float*)d_in[10]; a.rel = (const float*)d_in[11]; a.w_o_mla = (const float*)d_in[12]; a.w_o_swa = (const float*)d_in[13]; a.w_out = (const float*)d_in[14];
    a.w_up = (const float*)d_in[15]; a.conv_w = (const float*)d_in[16]; a.conv_b = (const float*)d_in[17]; a.w_down = (const float*)d_in[18];
    a.out = (float*)d_out; a.ws = (unsigned char*)d_ws;
#ifndef NLAUNCH_SPLIT
#define NLAUNCH_SPLIT 0
#endif
    for (int ph = 0; ph < 12; ph += (NLAUNCH_SPLIT ? 1 : 12)) {
        a.ph_lo = ph; a.ph_hi = NLAUNCH_SPLIT ? ph + 1 : 12;
        void* args[] = {&a};
        hipError_t e = hipLaunchCooperativeKernel((const void*)fwd_mega, dim3(grid), dim3(512), args, LDS_BYTES, stream);
        if (e != hipSuccess) fprintf(stderr, "kernel_launch: cooperative launch failed: %s (grid %d)\n", hipGetErrorString(e), grid);
    }
}
```

```cpp
#include <hip/hip_runtime.h>
#include <hip/hip_cooperative_groups.h>
#include <cstdio>
#include <cstdint>
namespace cg = cooperative_groups;
namespace pg8 {
#define PG8_LAS __attribute__((address_space(3)))
typedef unsigned short bf16_t;
typedef short bf16x8 __attribute__((ext_vector_type(8)));
typedef float f32x4 __attribute__((ext_vector_type(4)));
typedef unsigned u32x4 __attribute__((ext_vector_type(4)));
constexpr int BM = 256, BK = 64, HALF = 128, HTB = HALF * BK * 2  , STAGE_BYTES = 8 * HTB, NXCD = 8, WGM = 8;

__host__ __device__ __forceinline__ int lds_byte(int r, int c) { const int st = (r >> 4) * 2 + (c >> 5), rr = r & 15, cc = c & 31, ob = rr * 64 + cc * 2; return st * 1024 + (ob ^ (((ob >> 9) & 1) << 5)); }
__host__ __device__ __forceinline__ void stage_rc(int b, int& R, int& C) { const int st = b / 1024, sb = b % 1024, swz = sb ^ (((sb >> 9) & 1) << 5); R = (st >> 1) * 16 + swz / 64; C = (st & 1) * 32 + (swz % 64) / 2; }
__host__ __device__ __forceinline__ int perm32(int rho) { const int n = rho >> 4, i = rho & 15; return 8 * (i >> 2) + 4 * n + (i & 3); }

struct Unit { int pm, pn; };
struct Gemm { const bf16_t* A; const bf16_t* Bt; int M, N, K; };

struct StaticOrder {
    int nM, nN, nwg, G, c;
    __host__ __device__ void init(int M, int N, int G_, int c_) { nM = M / BM; nN = N / BM; nwg = nM * nN; G = G_; c = c_; }
    __host__ __device__ bool next(int i, Unit& u) const {
        const long L = (long)i * G + c; if (L >= nwg) return false;
        int wgid = (int)L; { const int q = nwg / NXCD, r = nwg % NXCD, xcd = wgid % NXCD, off = wgid / NXCD; wgid = (xcd < r ? xcd * (q + 1) : r * (q + 1) + (xcd - r) * q) + off; }
        const int nig = WGM * nN, gid = wgid / nig, fm = gid * WGM, gsz = (nM - fm) < WGM ? (nM - fm) : WGM;
        u.pm = fm + ((wgid % nig) % gsz); u.pn = (wgid % nig) / gsz; return true;
    }
    __device__ __forceinline__ void a_ready(const Unit&) const {}
    __device__ __forceinline__ void done(const Unit&) const {}
};

typedef float f32x2_cv __attribute__((ext_vector_type(2))); typedef __bf16 bf16x2_cv __attribute__((ext_vector_type(2)));
__device__ __forceinline__ unsigned cvt_pk_bf16(float lo, float hi) { f32x2_cv v = {lo, hi}; bf16x2_cv b = __builtin_convertvector(v, bf16x2_cv); return __builtin_bit_cast(unsigned, b); }
template <class Epi, class Sched, bool ALIGN_EPI = false, bool SP2 = false>
__device__ __forceinline__ void gemm_phase(PG8_LAS unsigned char* lds, const Gemm g, const Sched& S, const Epi& E) {
    const int tid = threadIdx.x, wid = __builtin_amdgcn_readfirstlane(tid >> 6), lane = tid & 63, wr = wid >> 2, wc = wid & 3, fr = lane & 15, fq = lane >> 4;
    const int K = g.K, nt = K / BK;
    unsigned voffA[2], voffB[2];
#pragma unroll
    for (int i = 0; i < 2; ++i) { int R, C; stage_rc(tid * 16 + i * 8192, R, C); const int Rb = Epi::PERM ? ((R & ~31) + perm32(R & 31)) : R;
        voffA[i] = (unsigned)(R * K + C) * 2u; voffB[i] = (unsigned)(Rb * K + C) * 2u; }
    const size_t kstep = (size_t)(BK * 2);
    const size_t hstep = (size_t)HALF * K * 2;
    const size_t tstep = 2 * hstep;
    const unsigned ldsw = (unsigned)wid * 1024u;
    const int aoff = lds_byte(wr * 64 + fr, fq * 8), boff = lds_byte(wc * 32 + fr, fq * 8);
#define PG8_SA(b, h) (((b) * 2 + (h)) * HTB)
#define PG8_SB(b, h) ((4 + (b) * 2 + (h)) * HTB)
#define PG8_STAGE(bufoff, gbase, voff) do { _Pragma("unroll") for (int _i = 0; _i < 2; ++_i) \
        __builtin_amdgcn_global_load_lds((const unsigned*)((const char*)(gbase) + (voff)[_i]), (PG8_LAS unsigned*)(lds + (bufoff) + ldsw + _i * 8192), 16, 0, 0); } while (0)
#define PG8_LDA(dst, b, h) do { _Pragma("unroll") for (int m = 0; m < 4; ++m) _Pragma("unroll") for (int k = 0; k < 2; ++k) dst[m][k] = *(const PG8_LAS bf16x8*)(lds + PG8_SA(b, h) + aoff + m * 2048 + k * 1024); } while (0)
#define PG8_LDB(dst, b, h) do { _Pragma("unroll") for (int n = 0; n < 2; ++n) _Pragma("unroll") for (int k = 0; k < 2; ++k) dst[n][k] = *(const PG8_LAS bf16x8*)(lds + PG8_SB(b, h) + boff + n * 2048 + k * 1024); } while (0)
#define PG8_MMA(ai, bj, At, Bt) do { __builtin_amdgcn_s_setprio(1); _Pragma("unroll") for (int m = 0; m < 4; ++m) _Pragma("unroll") for (int n = 0; n < 2; ++n) _Pragma("unroll") for (int k = 0; k < 2; ++k) \
        acc[ai][bj][m][n] = __builtin_amdgcn_mfma_f32_16x16x32_bf16(Bt[n][k], At[m][k], acc[ai][bj][m][n], 0, 0, 0); __builtin_amdgcn_s_setprio(0); } while (0)
#define PG8_WAIT_V(n) asm volatile("s_waitcnt vmcnt(" #n ")" ::: "memory")
#define PG8_WAIT_L(n) asm volatile("s_waitcnt lgkmcnt(" #n ")" ::: "memory")
#define PG8_BAR __builtin_amdgcn_s_barrier()
#define PG8_SCHED __builtin_amdgcn_sched_barrier(0)
    Unit cur, nxt; int ui = 0;
    if (!S.next(0, cur)) return;
    f32x4 acc[2][2][4][2];
#pragma unroll
    for (int a = 0; a < 2; ++a)
#pragma unroll
        for (int b = 0; b < 2; ++b)
#pragma unroll
            for (int m = 0; m < 4; ++m)
#pragma unroll
                for (int n = 0; n < 2; ++n) acc[a][b][m][n] = (f32x4){0.f, 0.f, 0.f, 0.f};
    bf16x8 At[4][2], B0[2][2], B1[2][2];
    const char* cA = (const char*)g.A + (size_t)cur.pm * tstep; const char* cB = (const char*)g.Bt + (size_t)cur.pn * tstep;
    S.a_ready(cur);
    if constexpr (SP2) {
        PG8_STAGE(PG8_SB(0, 0), cB, voffB); PG8_STAGE(PG8_SB(0, 1), cB + hstep, voffB); PG8_STAGE(PG8_SA(0, 0), cA, voffA); PG8_STAGE(PG8_SA(0, 1), cA + hstep, voffA);
        PG8_STAGE(PG8_SB(1, 0), cB + kstep, voffB); PG8_STAGE(PG8_SA(1, 0), cA + kstep, voffA); PG8_STAGE(PG8_SB(1, 1), cB + hstep + kstep, voffB);
        PG8_WAIT_V(0); PG8_WAIT_L(0); PG8_BAR;
        if (wr == 1) PG8_BAR;
    } else {
        PG8_STAGE(PG8_SB(0, 0), cB, voffB); PG8_STAGE(PG8_SA(0, 0), cA, voffA); PG8_STAGE(PG8_SB(0, 1), cB + hstep, voffB); PG8_STAGE(PG8_SA(0, 1), cA + hstep, voffA);
        if (wr == 1) PG8_BAR;
        PG8_WAIT_V(4); PG8_BAR;
        PG8_STAGE(PG8_SB(1, 0), cB + kstep, voffB); PG8_STAGE(PG8_SA(1, 0), cA + kstep, voffA); PG8_STAGE(PG8_SB(1, 1), cB + hstep + kstep, voffB);
        PG8_WAIT_V(6); PG8_BAR;
    }
    for (;;) {
        const bool has_next = S.next(ui + 1, nxt);
        const char* nA = has_next ? (const char*)g.A + (size_t)nxt.pm * tstep : cA; const char* nB = has_next ? (const char*)g.Bt + (size_t)nxt.pn * tstep : cB;
        for (int t = 0; t < nt; t += 2) {
            const bool last = (t == nt - 2);
            const char* a1 = cA + (size_t)(t + 1) * kstep;
            const char* a2 = last ? nA : cA + (size_t)(t + 2) * kstep; const char* b2 = last ? nB : cB + (size_t)(t + 2) * kstep;
            const char* a3 = a2 + kstep; const char* b3 = b2 + kstep;
            if (last && has_next) S.a_ready(nxt);
            if constexpr (SP2) {
            PG8_LDB(B0, 0, 0); PG8_LDB(B1, 0, 1); PG8_SCHED; PG8_LDA(At, 0, 0); PG8_STAGE(PG8_SA(1, 1), a1 + hstep, voffA);
            PG8_WAIT_V(8); PG8_WAIT_L(0); PG8_BAR; PG8_MMA(0, 0, At, B0); PG8_MMA(0, 1, At, B1); PG8_BAR; PG8_SCHED;
            PG8_LDA(At, 0, 1); PG8_STAGE(PG8_SB(0, 0), b2, voffB); PG8_STAGE(PG8_SB(0, 1), b2 + hstep, voffB); PG8_STAGE(PG8_SA(0, 0), a2, voffA);
            PG8_WAIT_V(8); PG8_WAIT_L(0); PG8_BAR; PG8_MMA(1, 0, At, B0); PG8_MMA(1, 1, At, B1); PG8_BAR; PG8_SCHED;
            PG8_LDB(B0, 1, 0); PG8_LDB(B1, 1, 1); PG8_SCHED; PG8_LDA(At, 1, 0); PG8_STAGE(PG8_SA(0, 1), a2 + hstep, voffA);
            PG8_WAIT_V(8); PG8_WAIT_L(0); PG8_BAR; PG8_MMA(0, 0, At, B0); PG8_MMA(0, 1, At, B1); PG8_BAR; PG8_SCHED;
            PG8_LDA(At, 1, 1); PG8_STAGE(PG8_SB(1, 0), b3, voffB); PG8_STAGE(PG8_SB(1, 1), b3 + hstep, voffB); PG8_STAGE(PG8_SA(1, 0), a3, voffA);
            PG8_WAIT_V(8); PG8_WAIT_L(0); PG8_BAR; PG8_MMA(1, 0, At, B0); PG8_MMA(1, 1, At, B1); PG8_BAR; PG8_SCHED;
            } else {
            PG8_LDB(B0, 0, 0); PG8_SCHED; PG8_LDA(At, 0, 0); PG8_STAGE(PG8_SA(1, 1), a1 + hstep, voffA);
            PG8_WAIT_L(8); PG8_BAR; PG8_WAIT_L(0); PG8_MMA(0, 0, At, B0); PG8_BAR; PG8_SCHED;
            PG8_LDB(B1, 0, 1); PG8_STAGE(PG8_SB(0, 0), b2, voffB);
            PG8_BAR; PG8_WAIT_L(0); PG8_MMA(0, 1, At, B1); PG8_BAR;
            PG8_LDA(At, 0, 1); PG8_STAGE(PG8_SA(0, 0), a2, voffA);
            PG8_BAR; PG8_WAIT_L(0); PG8_MMA(1, 0, At, B0); PG8_BAR; PG8_SCHED;
            PG8_STAGE(PG8_SB(0, 1), b2 + hstep, voffB);
            PG8_WAIT_V(6); PG8_BAR; PG8_MMA(1, 1, At, B1); PG8_BAR;
            PG8_LDB(B0, 1, 0); PG8_SCHED; PG8_LDA(At, 1, 0); PG8_STAGE(PG8_SA(0, 1), a2 + hstep, voffA);
            PG8_WAIT_L(8); PG8_BAR; PG8_WAIT_L(0); PG8_MMA(0, 0, At, B0); PG8_BAR; PG8_SCHED;
            PG8_LDB(B1, 1, 1); PG8_STAGE(PG8_SB(1, 0), b3, voffB);
            PG8_BAR; PG8_WAIT_L(0); PG8_MMA(0, 1, At, B1); PG8_BAR;
            PG8_LDA(At, 1, 1); PG8_STAGE(PG8_SA(1, 0), a3, voffA);
            PG8_BAR; PG8_WAIT_L(0); PG8_MMA(1, 0, At, B0); PG8_BAR; PG8_SCHED;
            PG8_STAGE(PG8_SB(1, 1), b3 + hstep, voffB);
            PG8_WAIT_V(6); PG8_BAR; PG8_MMA(1, 1, At, B1); PG8_BAR;
            }
        }
        if constexpr (ALIGN_EPI) { if (wr == 0) PG8_BAR; }
        if constexpr (!Epi::AFTER_DRAIN) { E(acc, cur, wr, wc, fr, fq); S.done(cur); }
        if (!has_next) break;
#pragma unroll
        for (int a = 0; a < 2; ++a)
#pragma unroll
            for (int b = 0; b < 2; ++b)
#pragma unroll
                for (int m = 0; m < 4; ++m)
#pragma unroll
                    for (int n = 0; n < 2; ++n) acc[a][b][m][n] = (f32x4){0.f, 0.f, 0.f, 0.f};
        cur = nxt; cA = nA; cB = nB; ++ui;
        if constexpr (ALIGN_EPI) { if (wr == 1) PG8_BAR; }
    }
    PG8_WAIT_V(0);
    if constexpr (!ALIGN_EPI) { if (wr == 0) PG8_BAR; }
    PG8_BAR;
    if constexpr (Epi::AFTER_DRAIN) { E.fused(acc, cur, wr, wc, fr, fq, lds, wid, lane); S.done(cur); }
#undef PG8_SA
#undef PG8_SB
#undef PG8_STAGE
#undef PG8_LDA
#undef PG8_LDB
#undef PG8_MMA
#undef PG8_WAIT_V
#undef PG8_WAIT_L
#undef PG8_BAR
#undef PG8_SCHED
}
}
constexpr int SEQ = 16384, NTOK = 32768, DM = 2048, DFF = 5632;
constexpr float EPS = 1e-6f;
#define GAS __attribute__((address_space(1)))
#define LAS __attribute__((address_space(3)))

namespace ep {
using namespace pg8;
typedef float f32x2 __attribute__((ext_vector_type(2)));
__device__ __forceinline__ u32x4 pack8(const f32x4 a, const f32x4 b) { u32x4 w; w.x = cvt_pk_bf16(a[0], a[1]); w.y = cvt_pk_bf16(a[2], a[3]); w.z = cvt_pk_bf16(b[0], b[1]); w.w = cvt_pk_bf16(b[2], b[3]); return w; }
__device__ __forceinline__ float bflo(unsigned u) { return __uint_as_float(u << 16); }
__device__ __forceinline__ float bfhi(unsigned u) { return __uint_as_float(u & 0xffff0000u); }
__device__ __forceinline__ void unpack8(const u32x4 w, f32x4& a, f32x4& b) { a = (f32x4){bflo(w.x), bfhi(w.x), bflo(w.y), bfhi(w.y)}; b = (f32x4){bflo(w.z), bfhi(w.z), bflo(w.w), bfhi(w.w)}; }
__device__ __forceinline__ float sigmoidf_(float x) { return __builtin_amdgcn_rcpf(1.f + __builtin_amdgcn_exp2f(-1.4426950408889634f * x)); }
__device__ __forceinline__ float ssq4(const f32x4 x) { return (x[0] * x[0] + x[1] * x[1]) + (x[2] * x[2] + x[3] * x[3]); }
__device__ __forceinline__ void rope8(f32x4& v0, f32x4& v1, const f32x4 csA, const f32x4 csB) {
    const float a0 = v0[0] * csA[0] - v0[1] * csA[1], b0 = v0[1] * csA[0] + v0[0] * csA[1];
    const float a1 = v0[2] * csA[2] - v0[3] * csA[3], b1 = v0[3] * csA[2] + v0[2] * csA[3];
    const float a2 = v1[0] * csB[0] - v1[1] * csB[1], b2 = v1[1] * csB[0] + v1[0] * csB[1];
    const float a3 = v1[2] * csB[2] - v1[3] * csB[3], b3 = v1[3] * csB[2] + v1[2] * csB[3];
    v0 = (f32x4){a0, b0, a1, b1}; v1 = (f32x4){a2, b2, a3, b3};
}

struct EpiIn {
    static constexpr bool PERM = true, AFTER_DRAIN = false;
    bf16_t *CQ, *CKV, *KR, *QS, *KS, *VS; float *ssqQ, *ssqKV; const float* rope;
    __device__ __forceinline__ void operator()(const f32x4 (&acc)[2][2][4][2], const Unit& u, int wr, int wc, int fr, int fq) const {
        const int pn = u.pn, row0 = u.pm * BM + wr * 64 + fr, cw = wc * 32 + 8 * fq;
        if (pn < 3) {
            float* sq = pn < 2 ? ssqQ : ssqKV; const int nslot = pn < 2 ? 8 : 4, slot = (pn < 2 ? pn * 4 : 0) + wc, ldc = pn < 2 ? 512 : 256;
            bf16_t* base = pn < 2 ? CQ + pn * 256 : CKV;
#pragma unroll
            for (int ai = 0; ai < 2; ++ai)
#pragma unroll
                for (int m = 0; m < 4; ++m) { const int row = row0 + ai * HALF + m * 16;
                    float s = (ssq4(acc[ai][0][m][0]) + ssq4(acc[ai][0][m][1])) + (ssq4(acc[ai][1][m][0]) + ssq4(acc[ai][1][m][1]));
                    s += __shfl_xor(s, 16); s += __shfl_xor(s, 32);
                    if (fq == 0) sq[(size_t)row * nslot + slot] = s;
#pragma unroll
                    for (int bj = 0; bj < 2; ++bj) *(u32x4*)(base + (size_t)row * ldc + bj * HALF + cw) = pack8(acc[ai][bj][m][0], acc[ai][bj][m][1]); }
        } else if (pn == 3) {
            if (wc < 2) {
#pragma unroll
                for (int ai = 0; ai < 2; ++ai)
#pragma unroll
                    for (int m = 0; m < 4; ++m) { const int row = row0 + ai * HALF + m * 16; const int pos = row & (SEQ - 1);
                        const float* cs = rope + ((size_t)pos * 32 + 16 * wc + 4 * fq) * 2;
                        const f32x4 csA = *(const f32x4*)cs, csB = *(const f32x4*)(cs + 4);
                        f32x4 v0 = acc[ai][0][m][0], v1 = acc[ai][0][m][1]; rope8(v0, v1, csA, csB);
                        *(u32x4*)(KR + (size_t)row * 64 + cw) = pack8(v0, v1); }
            }
        } else if (pn < 14) {
            bf16_t* base; int ldc;
            if (pn < 12) { base = QS + (pn - 4) * 256; ldc = 2048; } else if (pn == 12) { base = KS; ldc = 256; } else { base = VS; ldc = 256; }
#pragma unroll
            for (int ai = 0; ai < 2; ++ai)
#pragma unroll
                for (int m = 0; m < 4; ++m) { const int row = row0 + ai * HALF + m * 16;
#pragma unroll
                    for (int bj = 0; bj < 2; ++bj) *(u32x4*)(base + (size_t)row * ldc + bj * HALF + cw) = pack8(acc[ai][bj][m][0], acc[ai][bj][m][1]); }
        }
    }
};

struct EpiSig {
    static constexpr bool PERM = true, AFTER_DRAIN = false;
    bf16_t* GT;
    __device__ __forceinline__ void operator()(const f32x4 (&acc)[2][2][4][2], const Unit& u, int wr, int wc, int fr, int fq) const {
        const int row0 = u.pm * BM + wr * 64 + fr, cw = wc * 32 + 8 * fq; bf16_t* base = GT + u.pn * 256;
#pragma unroll
        for (int ai = 0; ai < 2; ++ai)
#pragma unroll
            for (int m = 0; m < 4; ++m) { const int row = row0 + ai * HALF + m * 16;
#pragma unroll
                for (int bj = 0; bj < 2; ++bj) { f32x4 v0 = acc[ai][bj][m][0], v1 = acc[ai][bj][m][1];
#pragma unroll
                    for (int e = 0; e < 4; ++e) { v0[e] = sigmoidf_(v0[e]); v1[e] = sigmoidf_(v1[e]); }
                    *(u32x4*)(base + (size_t)row * 4096 + bj * HALF + cw) = pack8(v0, v1); } }
    }
};

struct EpiUp {
    static constexpr bool PERM = true, AFTER_DRAIN = false;
    const float* ssq; int nslot; float invK; bf16_t* O0; bf16_t* O1; int ld0, ld1, split; int rope1; const float* rope; float oscale;
    __device__ __forceinline__ void operator()(const f32x4 (&acc)[2][2][4][2], const Unit& u, int wr, int wc, int fr, int fq) const {
        const int pn = u.pn, row0 = u.pm * BM + wr * 64 + fr, cw = wc * 32 + 8 * fq;
        const int t = pn < split ? 0 : 1; bf16_t* base = t ? O1 + (pn - split) * 256 : O0 + pn * 256; const int ld = t ? ld1 : ld0;
        const bool dorope = (t == 1) && rope1;
#pragma unroll
        for (int ai = 0; ai < 2; ++ai)
#pragma unroll
            for (int m = 0; m < 4; ++m) { const int row = row0 + ai * HALF + m * 16;
                float s;
                if (nslot == 8) { const f32x4 a = *(const f32x4*)(ssq + (size_t)row * 8), b = *(const f32x4*)(ssq + (size_t)row * 8 + 4); s = ((a[0] + a[1]) + (a[2] + a[3])) + ((b[0] + b[1]) + (b[2] + b[3])); }
                else { const f32x4 a = *(const f32x4*)(ssq + (size_t)row * 4); s = (a[0] + a[1]) + (a[2] + a[3]); }
                const float rs = oscale / sqrtf(s * invK + EPS);
                f32x4 csA = {1.f, 0.f, 1.f, 0.f}, csB = {1.f, 0.f, 1.f, 0.f};
                if (dorope) { const int pos = row & (SEQ - 1); const float* cs = rope + ((size_t)pos * 32 + 16 * (wc & 1) + 4 * fq) * 2; csA = *(const f32x4*)cs; csB = *(const f32x4*)(cs + 4); }
#pragma unroll
                for (int bj = 0; bj < 2; ++bj) { f32x4 v0 = acc[ai][bj][m][0] * rs, v1 = acc[ai][bj][m][1] * rs;
                    if (dorope) rope8(v0, v1, csA, csB);
                    *(u32x4*)(base + (size_t)row * ld + bj * HALF + cw) = pack8(v0, v1); } }
    }
};

template <bool SECOND> struct EpiGate {
    static constexpr bool PERM = true, AFTER_DRAIN = false;
    const bf16_t* GT; bf16_t* MG;
    __device__ __forceinline__ void operator()(const f32x4 (&acc)[2][2][4][2], const Unit& u, int wr, int wc, int fr, int fq) const {
        const int row0 = u.pm * BM + wr * 64 + fr, col0 = u.pn * BM + wc * 32 + 8 * fq;
#pragma unroll
        for (int ai = 0; ai < 2; ++ai)
#pragma unroll
            for (int m = 0; m < 4; ++m) { const int row = row0 + ai * HALF + m * 16;
#pragma unroll
                for (int bj = 0; bj < 2; ++bj) { const int col = col0 + bj * HALF;
                    const u32x4 gw = *(const u32x4*)(GT + (size_t)row * 4096 + (SECOND ? 2048 : 0) + col); f32x4 g0, g1; unpack8(gw, g0, g1);
                    f32x4 v0 = acc[ai][bj][m][0] * g0, v1 = acc[ai][bj][m][1] * g1;
                    bf16_t* p = MG + (size_t)row * DM + col;
                    if (SECOND) { const u32x4 pw = *(const u32x4*)p; f32x4 p0, p1; unpack8(pw, p0, p1); v0 += p0; v1 += p1; }
                    *(u32x4*)p = pack8(v0, v1); } }
    }
};

struct EpiBfSsq {
    static constexpr bool PERM = true, AFTER_DRAIN = false;
    bf16_t* Y; float* ssq;
    __device__ __forceinline__ void operator()(const f32x4 (&acc)[2][2][4][2], const Unit& u, int wr, int wc, int fr, int fq) const {
        const int row0 = u.pm * BM + wr * 64 + fr, col0 = u.pn * BM + wc * 32 + 8 * fq;
#pragma unroll
        for (int ai = 0; ai < 2; ++ai)
#pragma unroll
            for (int m = 0; m < 4; ++m) { const int row = row0 + ai * HALF + m * 16;
                float s = (ssq4(acc[ai][0][m][0]) + ssq4(acc[ai][0][m][1])) + (ssq4(acc[ai][1][m][0]) + ssq4(acc[ai][1][m][1]));
                s += __shfl_xor(s, 16); s += __shfl_xor(s, 32);
                if (fq == 0) ssq[(size_t)row * 32 + u.pn * 4 + wc] = s;
#pragma unroll
                for (int bj = 0; bj < 2; ++bj) *(u32x4*)(Y + (size_t)row * DM + col0 + bj * HALF) = pack8(acc[ai][bj][m][0], acc[ai][bj][m][1]); }
    }
};

struct EpiFfn {
    static constexpr bool PERM = true, AFTER_DRAIN = false;
    bf16_t* G; float* AH; float* BH; const float* cw; const float* cb;
    __device__ __forceinline__ void operator()(const f32x4 (&acc)[2][2][4][2], const Unit& u, int wr, int wc, int fr, int fq) const {
        const int lane = threadIdx.x & 63;
        const int f0 = u.pn * 128 + wc * 32 + 8 * fq;
        f32x4 w0[2], w1[2], w2[2], bb[2];
#pragma unroll
        for (int n = 0; n < 2; ++n) { w0[n] = *(const f32x4*)(cw + f0 + 4 * n); w1[n] = *(const f32x4*)(cw + DFF + f0 + 4 * n); w2[n] = *(const f32x4*)(cw + 2 * DFF + f0 + 4 * n); bb[n] = *(const f32x4*)(cb + f0 + 4 * n); }
        const int src1 = (lane & 48) | ((fr - 1) & 15), src2 = (lane & 48) | ((fr - 2) & 15);
#pragma unroll
        for (int ai = 0; ai < 2; ++ai) {
            const int jb = u.pm * 4 + ai * 2 + wr;
            f32x4 p1[2], p2[2];
#pragma unroll
            for (int n = 0; n < 2; ++n) { p1[n] = (f32x4){0.f, 0.f, 0.f, 0.f}; p2[n] = p1[n]; }
#pragma unroll
            for (int m = 0; m < 4; ++m) {
                f32x4 o[2];
#pragma unroll
                for (int n = 0; n < 2; ++n) { f32x4 r1, r2;
#pragma unroll
                    for (int e = 0; e < 4; ++e) { const float a0 = acc[ai][0][m][n][e]; r1[e] = __shfl(a0, src1); r2[e] = __shfl(a0, src2); }
                    f32x4 a1, a2;
#pragma unroll
                    for (int e = 0; e < 4; ++e) { a1[e] = fr >= 1 ? r1[e] : p1[n][e]; a2[e] = fr >= 2 ? r2[e] : p2[n][e]; }
                    p1[n] = r1; p2[n] = r2;
                    const f32x4 c = bb[n] + w0[n] * a2 + w1[n] * a1 + w2[n] * acc[ai][0][m][n];
#pragma unroll
                    for (int e = 0; e < 4; ++e) { const float x = c[e]; const float uu = 0.7978845608028654f * (x + 0.044715f * x * x * x);
                        const float gl = x * __builtin_amdgcn_rcpf(1.f + __builtin_amdgcn_exp2f(-2.885390081777927f * uu)); o[n][e] = gl * acc[ai][1][m][n][e]; } }
                const int row = u.pm * BM + ai * HALF + wr * 64 + m * 16 + fr;
                if (!(m == 0 && fr < 2)) *(u32x4*)(G + (size_t)row * DFF + f0) = pack8(o[0], o[1]);
                if (m == 0 && fr < 2) { float* ah = AH + ((size_t)jb * 4 + 2 + fr) * DFF + f0; *(f32x4*)ah = acc[ai][0][0][0]; *(f32x4*)(ah + 4) = acc[ai][0][0][1];
                    float* bh = BH + ((size_t)jb * 2 + fr) * DFF + f0; *(f32x4*)bh = acc[ai][1][0][0]; *(f32x4*)(bh + 4) = acc[ai][1][0][1]; }
                if (m == 3 && fr >= 14) { float* ah = AH + ((size_t)jb * 4 + (fr - 14)) * DFF + f0; *(f32x4*)ah = acc[ai][0][3][0]; *(f32x4*)(ah + 4) = acc[ai][0][3][1]; }
            }
        }
    }
};
}
namespace att {
typedef short bf16x8 __attribute__((ext_vector_type(8)));
typedef short s16x4 __attribute__((ext_vector_type(4)));
typedef float f32x16 __attribute__((ext_vector_type(16)));
typedef float f32x4 __attribute__((ext_vector_type(4)));
typedef unsigned u32x4 __attribute__((ext_vector_type(4)));
typedef unsigned short bf16_t;
#define SBAR() __builtin_amdgcn_sched_barrier(0)
#define KSWZ(row, colB) ((row) * 256 + ((colB) ^ (((row) & 7) << 4)))
#define KSWZ64(row, chunk) ((row) * 128 + ((((chunk) ^ ((row) & 7))) << 4))
template <int NCB> __device__ __forceinline__ int v_st(int k, int c) { const int kk = (k & ~0xC) | ((k & 4) << 1) | ((k & 8) >> 1); return ((kk >> 3) * NCB + (c >> 5)) * 512 + ((kk & 7) * 32 + (c & 31)) * 2; }
__device__ __forceinline__ int v_rd_base(int lane) { return ((lane & 3) << 3) | (((lane >> 2) & 3) << 6) | (((lane >> 4) & 1) << 5) | (((lane >> 5) & 1) << 8); }
__device__ __forceinline__ int crow(int r, int hi) { return (r & 3) + 8 * (r >> 2) + 4 * hi; }
typedef float f32x2_cv __attribute__((ext_vector_type(2))); typedef __bf16 bf16x2_cv __attribute__((ext_vector_type(2)));
__device__ __forceinline__ unsigned cvtpk(float lo, float hi) { f32x2_cv v = {lo, hi}; bf16x2_cv b = __builtin_convertvector(v, bf16x2_cv); return __builtin_bit_cast(unsigned, b); }
__device__ __forceinline__ void mask_tile(f32x16& p0, f32x16& p1, int dq, unsigned W) {
    const float NEG = -__builtin_inff();
#pragma unroll
    for (int r = 0; r < 16; ++r) { const int c = (r & 3) + 8 * (r >> 2);
        if ((unsigned)(dq - c) >= W) p0[r] = NEG;
        if ((unsigned)(dq - c - 32) >= W) p1[r] = NEG; }
}
constexpr float THR = 8.f;
template <int SCALE_E6> __device__ __forceinline__ void partialSM(f32x16& p0, f32x16& p1, float& m_reg, float& mn, float& alpha) {
    constexpr float SCALE = SCALE_E6 * 1e-9f; constexpr float C2 = 1.4426950408889634f * SCALE;
    float pmax = p0[0];
#pragma unroll
    for (int r = 1; r < 16; ++r) pmax = fmaxf(pmax, p0[r]);
#pragma unroll
    for (int r = 0; r < 16; ++r) pmax = fmaxf(pmax, p1[r]);
    { auto rr = __builtin_amdgcn_permlane32_swap(__float_as_uint(pmax), __float_as_uint(pmax), false, false);
      pmax = fmaxf(__uint_as_float(rr[0]), __uint_as_float(rr[1])); }
    if (__builtin_expect(__all((pmax - m_reg) * SCALE <= THR), 1)) { mn = m_reg; alpha = 1.f; }
    else { mn = fmaxf(m_reg, pmax); alpha = __builtin_amdgcn_exp2f((m_reg - mn) * C2); m_reg = mn; }
    const float mnL = -mn * C2;
#pragma unroll
    for (int r = 0; r < 16; ++r) p0[r] = fmaf(p0[r], C2, mnL);
#pragma unroll
    for (int r = 0; r < 16; ++r) p1[r] = fmaf(p1[r], C2, mnL);
#pragma unroll
    for (int r = 0; r < 16; ++r) p0[r] = __builtin_amdgcn_exp2f(p0[r]);
}
__device__ __forceinline__ void partialSM_pre(f32x16& p0, f32x16& p1, float& m_reg, float& alpha) {
    constexpr float THR2 = THR * 1.4426950408889634f;
    float pmax = p0[0];
#pragma unroll
    for (int r = 1; r < 16; ++r) pmax = fmaxf(pmax, p0[r]);
#pragma unroll
    for (int r = 0; r < 16; ++r) pmax = fmaxf(pmax, p1[r]);
    { auto rr = __builtin_amdgcn_permlane32_swap(__float_as_uint(pmax), __float_as_uint(pmax), false, false);
      pmax = fmaxf(__uint_as_float(rr[0]), __uint_as_float(rr[1])); }
    if (__builtin_expect(__all(pmax <= THR2), 1)) { alpha = 1.f; }
    else { const float d = fmaxf(pmax, 0.f); m_reg += d; alpha = __builtin_amdgcn_exp2f(-d);
#pragma unroll
        for (int r = 0; r < 16; ++r) { p0[r] -= d; p1[r] -= d; } }
#pragma unroll
    for (int r = 0; r < 16; ++r) p0[r] = __builtin_amdgcn_exp2f(p0[r]);
}
__device__ __forceinline__ void finishSM(f32x16& p0, f32x16& p1, float alpha, float& l_reg, bf16x8& pa0, bf16x8& pa1, bf16x8& pa2, bf16x8& pa3) {
#pragma unroll
    for (int r = 0; r < 16; ++r) p1[r] = __builtin_amdgcn_exp2f(p1[r]);
    float ps = 0;
#pragma unroll
    for (int r = 0; r < 16; ++r) ps += p0[r];
#pragma unroll
    for (int r = 0; r < 16; ++r) ps += p1[r];
    { auto rr = __builtin_amdgcn_permlane32_swap(__float_as_uint(ps), __float_as_uint(ps), false, false);
      ps = __uint_as_float(rr[0]) + __uint_as_float(rr[1]); }
    l_reg = l_reg * alpha + ps;
#define PK4(P, B_, OUT) do { unsigned a0 = cvtpk(P[B_+0], P[B_+1]), a1 = cvtpk(P[B_+2], P[B_+3]);                          \
        unsigned b0 = cvtpk(P[B_+4], P[B_+5]), b1 = cvtpk(P[B_+6], P[B_+7]);                                             \
        auto r0 = __builtin_amdgcn_permlane32_swap(a0, b0, false, false); auto r1 = __builtin_amdgcn_permlane32_swap(a1, b1, false, false); \
        u32x4 w = {r0[0], r1[0], r0[1], r1[1]}; OUT = *reinterpret_cast<bf16x8*>(&w); } while (0)
    PK4(p0, 0, pa0); PK4(p0, 8, pa1); PK4(p1, 0, pa2); PK4(p1, 8, pa3);
#undef PK4
}
__device__ __forceinline__ void qk128(f32x16& p0, f32x16& p1, const LAS char* kl, int r32, int hi, const bf16x8* qr) {
    const LAS char* kb[4];
#pragma unroll
    for (int dd = 0; dd < 4; ++dd) kb[dd] = kl + KSWZ(r32, (dd * 16 + hi * 8) * 2);
#pragma unroll
    for (int d0 = 0; d0 < 8; ++d0) { const LAS char* a = kb[d0 & 3] + (d0 >> 2) * 128;
        const bf16x8 b0 = *reinterpret_cast<const LAS bf16x8*>(a);
        const bf16x8 b1 = *reinterpret_cast<const LAS bf16x8*>(a + 32 * 256);
        p0 = __builtin_amdgcn_mfma_f32_32x32x16_bf16(b0, qr[d0], p0, 0, 0, 0);
        p1 = __builtin_amdgcn_mfma_f32_32x32x16_bf16(b1, qr[d0], p1, 0, 0, 0); }
}
__device__ __forceinline__ void qk64(f32x16& p0, f32x16& p1, const LAS char* kl, int r32, int hi, const bf16x8* qr) {
#pragma unroll
    for (int ks = 0; ks < 4; ++ks) { const LAS char* a = kl + KSWZ64(r32, 2 * ks + hi);
        const bf16x8 b0 = *reinterpret_cast<const LAS bf16x8*>(a);
        const bf16x8 b1 = *reinterpret_cast<const LAS bf16x8*>(a + 32 * 128);
        p0 = __builtin_amdgcn_mfma_f32_32x32x16_bf16(b0, qr[ks], p0, 0, 0, 0);
        p1 = __builtin_amdgcn_mfma_f32_32x32x16_bf16(b1, qr[ks], p1, 0, 0, 0); }
}
__device__ __forceinline__ void qk_mla(f32x16& p0, f32x16& p1, int kaddr, int r32, int hi, const bf16x8* qr) {
    const int rb = kaddr + r32 * 256, sw = (r32 & 7) << 4, h16 = hi * 16;
    const int rr = kaddr + 16384 + r32 * 128;
#define KRD(dst, base, off) asm volatile("ds_read_b128 %0, %1 offset:%2" : "=&v"(dst) : "v"(base), "i"(off) : "memory")
#define WLK(n) do { asm volatile("s_waitcnt lgkmcnt(" #n ")" ::: "memory"); SBAR(); } while (0)
#define RDN(S, dd, off) do { const int a_ = rb + (((dd) * 32 + h16) ^ sw); KRD(S##0, a_, off); KRD(S##1, a_, 8192 + (off)); } while (0)
#define RDR(S, ks) do { const int a_ = rr + (((((ks) * 2 + hi)) ^ (r32 & 7)) << 4); KRD(S##0, a_, 0); KRD(S##1, a_, 4096); } while (0)
#define MM1(S, d) do { p0 = __builtin_amdgcn_mfma_f32_32x32x16_bf16(S##0, qr[d], p0, 0, 0, 0); p1 = __builtin_amdgcn_mfma_f32_32x32x16_bf16(S##1, qr[d], p1, 0, 0, 0); } while (0)
    bf16x8 A0, A1, B0, B1;
    RDN(A, 0, 0); RDN(B, 1, 0);
    WLK(2); MM1(A, 0); RDN(A, 2, 0);
    WLK(2); MM1(B, 1); RDN(B, 3, 0);
    WLK(2); MM1(A, 2); RDN(A, 0, 128);
    WLK(2); MM1(B, 3); RDN(B, 1, 128);
    WLK(2); MM1(A, 4); RDN(A, 2, 128);
    WLK(2); MM1(B, 5); RDN(B, 3, 128);
    WLK(2); MM1(A, 6); RDR(A, 0);
    WLK(2); MM1(B, 7); RDR(B, 1);
    WLK(2); MM1(A, 8); RDR(A, 2);
    WLK(2); MM1(B, 9); RDR(B, 3);
    WLK(2); MM1(A, 10);
    WLK(0); MM1(B, 11);
#undef MM1
#undef RDR
#undef RDN
#undef WLK
#undef KRD
}
template <int NCB> __device__ __forceinline__ void pv_tile(f32x16* o, int vb, bf16x8 pa0, bf16x8 pa1, bf16x8 pa2, bf16x8 pa3) {
#define TRRD(dst, off) asm volatile("ds_read_b64_tr_b16 %0, %1 offset:%2" : "=&v"(dst) : "v"(vb), "i"(off) : "memory")
    constexpr int KS_ = NCB * 1024;
#define PV_RD(S, d0) do { constexpr int b_ = (d0) * 512; TRRD(S##l0, b_); TRRD(S##h0, b_ + KS_ / 2); TRRD(S##l1, b_ + KS_); TRRD(S##h1, b_ + KS_ + KS_ / 2); TRRD(S##l2, b_ + 2 * KS_); TRRD(S##h2, b_ + 2 * KS_ + KS_ / 2); TRRD(S##l3, b_ + 3 * KS_); TRRD(S##h3, b_ + 3 * KS_ + KS_ / 2); } while (0)
#define PV_MM(S, d0) do { \
        o[d0] = __builtin_amdgcn_mfma_f32_32x32x16_bf16(pa0, (bf16x8){S##l0[0], S##l0[1], S##l0[2], S##l0[3], S##h0[0], S##h0[1], S##h0[2], S##h0[3]}, o[d0], 0, 0, 0);   \
        o[d0] = __builtin_amdgcn_mfma_f32_32x32x16_bf16(pa1, (bf16x8){S##l1[0], S##l1[1], S##l1[2], S##l1[3], S##h1[0], S##h1[1], S##h1[2], S##h1[3]}, o[d0], 0, 0, 0);   \
        o[d0] = __builtin_amdgcn_mfma_f32_32x32x16_bf16(pa2, (bf16x8){S##l2[0], S##l2[1], S##l2[2], S##l2[3], S##h2[0], S##h2[1], S##h2[2], S##h2[3]}, o[d0], 0, 0, 0);   \
        o[d0] = __builtin_amdgcn_mfma_f32_32x32x16_bf16(pa3, (bf16x8){S##l3[0], S##l3[1], S##l3[2], S##l3[3], S##h3[0], S##h3[1], S##h3[2], S##h3[3]}, o[d0], 0, 0, 0); } while (0)
#define WL(n) do { asm volatile("s_waitcnt lgkmcnt(" #n ")" ::: "memory"); SBAR(); } while (0)
    s16x4 Al0, Al1, Al2, Al3, Ah0, Ah1, Ah2, Ah3, Bl0, Bl1, Bl2, Bl3, Bh0, Bh1, Bh2, Bh3;
    PV_RD(A, 0); PV_RD(B, 1); WL(8); PV_MM(A, 0);
    if constexpr (NCB == 4) { PV_RD(A, 2); WL(8); PV_MM(B, 1); PV_RD(B, 3); WL(8); PV_MM(A, 2); WL(0); PV_MM(B, 3); }
    else { WL(0); PV_MM(B, 1); }
#undef WL
#undef PV_MM
#undef PV_RD
#undef TRRD
}

struct AttnP {
    bf16_t* QN; const bf16_t* QR; const bf16_t* KN; const bf16_t* KR; const bf16_t* V;
    bf16_t* QS; const bf16_t* KS; const bf16_t* VS;
    const float* sinks; const float* rel;
};
__device__ const unsigned char T5B[128] = {0, 1, 2, 3, 4, 5, 6, 7, 8, 9, 10, 11, 12, 13, 14, 15, 16, 16, 16, 17, 17, 18, 18, 18, 19, 19, 19, 20, 20, 20, 20, 21, 21, 21, 21, 22, 22, 22, 22, 22, 23, 23, 23, 23, 23, 23, 24, 24, 24, 24, 24, 24, 25, 25, 25, 25, 25, 25, 25, 26, 26, 26, 26, 26, 26, 26, 26, 27, 27, 27, 27, 27, 27, 27, 27, 27, 27, 28, 28, 28, 28, 28, 28, 28, 28, 28, 28, 29, 29, 29, 29, 29, 29, 29, 29, 29, 29, 29, 29, 30, 30, 30, 30, 30, 30, 30, 30, 30, 30, 30, 30, 30, 30, 31, 31, 31, 31, 31, 31, 31, 31, 31, 31, 31, 31, 31, 31, 31};

template <bool MLA> __device__ __forceinline__ void attn_unit(const AttnP& P, int b, int hh, int qb, LAS char* lds) {
    constexpr int DV = MLA ? 128 : 64, NCB = DV / 32, NQF = MLA ? 12 : 4;
    constexpr int KBYTES = MLA ? 24576 : 8192, VBYTES = 64 * DV * 2;
    constexpr int SC9 = MLA ? 72168784 : 125000000;
    constexpr float SCALE = SC9 * 1e-9f;
    constexpr int W = MLA ? (1 << 30) : 128;
    const int tid = threadIdx.x, wid = __builtin_amdgcn_readfirstlane(tid >> 6), lane = tid & 63, r32 = lane & 31, hi = lane >> 5;
    constexpr int NB = MLA ? 2 : 6;
    LAS char* V_lds = lds; LAS char* K_lds = lds + NB * VBYTES;
    LAS float* ws = (LAS float*)(lds + NB * VBYTES + NB * KBYTES) + wid * 64; LAS float* li_l = ws; LAS float* al_l = ws + 32;
    LAS float* bias_l = (LAS float*)(lds + NB * VBYTES + NB * KBYTES + 2048);
    const int q0 = qb * 256; const size_t rowbase = (size_t)b * SEQ;
    const int jt0 = MLA ? 0 : (q0 == 0 ? 0 : -2);
    const int NT = MLA ? 4 * qb + 4 : 4 - jt0;
    const int kbase0 = MLA ? 0 : q0 + 64 * jt0;
    const int qlo = q0 + wid * 32, qm = qlo + r32 - 4 * hi;
    bf16x8 qr[NQF];
    const size_t qrow = rowbase + qlo + r32;
    if constexpr (MLA) {
#pragma unroll
        for (int d0 = 0; d0 < 8; ++d0) qr[d0] = *(const bf16x8*)(P.QN + qrow * 2048 + hh * 128 + d0 * 16 + hi * 8);
#pragma unroll
        for (int d0 = 0; d0 < 4; ++d0) qr[8 + d0] = *(const bf16x8*)(P.QR + qrow * 1024 + hh * 64 + d0 * 16 + hi * 8);
    } else {
#pragma unroll
        for (int d0 = 0; d0 < 4; ++d0) qr[d0] = *(const bf16x8*)(P.QS + qrow * 2048 + hh * 64 + d0 * 16 + hi * 8);
        if (tid < 128) bias_l[tid] = P.rel[(int)T5B[tid] * 32 + hh] * (1.0f / SCALE);
    }
    bf16x8 sk0, sv0;
    const int sr8 = tid >> 3, ch8 = tid & 7;
    const bf16_t* Kg; const bf16_t* Vg; const bf16_t* Rg = nullptr;
    unsigned okA = 0, okB = 0, orp = 0, ovA = 0, ovB = 0;
    if constexpr (MLA) {
        Kg = P.KN + rowbase * 2048 + hh * 128; Vg = P.V + rowbase * 2048 + hh * 128; Rg = P.KR + rowbase * 64;
        { const int rA = 4 * wid + (lane >> 4), rB = rA + 32, cp = lane & 15; okA = (unsigned)(rA * 2048 + ((cp ^ (rA & 7)) << 3)); okB = (unsigned)(rB * 2048 + ((cp ^ (rB & 7)) << 3)); }
        { const int rr = 8 * wid + (lane >> 3), cp = lane & 7; orp = (unsigned)(rr * 64 + ((cp ^ (rr & 7)) << 3)); }
        { const int stA = 2 * wid + (lane >> 5), stB = stA + 16; const int kl = (lane & 31) >> 2, c8 = 8 * (lane & 3);
          const int kkA = (stA >> 2) * 8 + kl, kkB = (stB >> 2) * 8 + kl;
          const int kA = (kkA & ~0xC) | ((kkA & 4) << 1) | ((kkA & 8) >> 1), kB = (kkB & ~0xC) | ((kkB & 4) << 1) | ((kkB & 8) >> 1);
          ovA = (unsigned)(kA * 2048 + 32 * (stA & 3) + c8); ovB = (unsigned)(kB * 2048 + 32 * (stB & 3) + c8); }
    } else { Kg = P.KS + (rowbase + sr8) * 256 + (hh >> 3) * 64 + ch8 * 8; Vg = P.VS + (rowbase + sr8) * 256 + (hh >> 3) * 64 + ch8 * 8; }
    const int kws = KSWZ64(sr8, ch8), vst0 = v_st<NCB>(sr8, ch8 * 8);
#define GLDS(gp, lp) __builtin_amdgcn_global_load_lds((const unsigned*)(gp), (LAS unsigned*)(lp), 16, 0, 0)
#define LOADT(t, bf) do { const size_t k0_ = (size_t)(kbase0 + 64 * (t)); \
        if constexpr (MLA) { LAS char* kd_ = K_lds + (bf) * KBYTES + wid * 1024; LAS char* vd_ = V_lds + (bf) * VBYTES + wid * 1024; \
            const bf16_t* kp_ = Kg + k0_ * 2048; const bf16_t* vp_ = Vg + k0_ * 2048; const bf16_t* rp_ = Rg + k0_ * 64; \
            GLDS(kp_ + okA, kd_); GLDS(kp_ + okB, kd_ + 8192); GLDS(rp_ + orp, kd_ + 16384); GLDS(vp_ + ovA, vd_); GLDS(vp_ + ovB, vd_ + 8192); } \
        else { sk0 = *(const bf16x8*)(Kg + k0_ * 256); sv0 = *(const bf16x8*)(Vg + k0_ * 256); } } while (0)
#define WRITET(bf) do { if constexpr (!MLA) { *(LAS bf16x8*)(K_lds + (bf) * KBYTES + kws) = sk0; *(LAS bf16x8*)(V_lds + (bf) * VBYTES + vst0) = sv0; } } while (0)
    float m_reg = MLA ? 0.f : P.sinks[hh] * (1.0f / SCALE), l_reg = MLA ? 0.f : 1.f;
    f32x16 o[NCB];
#pragma unroll
    for (int d = 0; d < NCB; ++d) o[d] = f32x16{};
    const int vb0 = (int)(uintptr_t)V_lds + v_rd_base(lane);
    if constexpr (MLA) { LOADT(0, 0); asm volatile("s_waitcnt vmcnt(0)" ::: "memory"); __syncthreads(); }
    else {
        bf16x8 skk[6], svv[6];
#pragma unroll
        for (int t = 0; t < 6; ++t) if (t < NT) { const size_t k0_ = (size_t)(kbase0 + 64 * t); skk[t] = *(const bf16x8*)(Kg + k0_ * 256); svv[t] = *(const bf16x8*)(Vg + k0_ * 256); }
        asm volatile("s_waitcnt vmcnt(0)" ::: "memory");
#pragma unroll
        for (int t = 0; t < 6; ++t) if (t < NT) { *(LAS bf16x8*)(K_lds + t * KBYTES + kws) = skk[t]; *(LAS bf16x8*)(V_lds + t * VBYTES + vst0) = svv[t]; }
        __syncthreads();
    }
    for (int t = 0; t < NT; ++t) {
        const int buf = MLA ? (t & 1) : t;
        if constexpr (MLA) { if (t + 1 < NT) LOADT(t + 1, buf ^ 1); }
        const int kb = kbase0 + 64 * t;
        const bool act = (kb <= qlo + 31) && (MLA || kb + 63 >= qlo - (W - 1));
        if (act) {
            f32x16 p0 = f32x16{}, p1 = f32x16{};
            if constexpr (MLA) {
#pragma unroll
                for (int r = 0; r < 16; ++r) { p0[r] = -m_reg; p1[r] = -m_reg; } }
            if constexpr (MLA) { qk_mla(p0, p1, (int)(uintptr_t)K_lds + buf * KBYTES, r32, hi, qr); }
            else { qk64(p0, p1, K_lds + buf * KBYTES, r32, hi, qr); }
            const int dq = qm - kb;
            if constexpr (!MLA) {
#pragma unroll
                for (int r = 0; r < 16; ++r) { const int c = (r & 3) + 8 * (r >> 2); p0[r] += bias_l[(dq - c) & 127]; p1[r] += bias_l[(dq - c - 32) & 127]; }
            }
            if (kb + 63 > qlo || (!MLA && kb <= qlo + 31 - W)) mask_tile(p0, p1, dq, (unsigned)W);
            float mn, alpha; bf16x8 pa0, pa1, pa2, pa3;
            if constexpr (MLA) { partialSM_pre(p0, p1, m_reg, alpha); (void)mn; } else { partialSM<SC9>(p0, p1, m_reg, mn, alpha); }
            finishSM(p0, p1, alpha, l_reg, pa0, pa1, pa2, pa3);
            if (__any(alpha < 1.f)) { if (hi == 0) al_l[r32] = alpha; asm volatile("s_waitcnt lgkmcnt(0)" ::: "memory");
#pragma unroll
                for (int d_ = 0; d_ < NCB; ++d_)
#pragma unroll
                    for (int r = 0; r < 16; ++r) o[d_][r] *= al_l[crow(r, hi)]; }
            SBAR();
            pv_tile<NCB>(o, vb0 + buf * VBYTES, pa0, pa1, pa2, pa3);
        }
        if constexpr (MLA) { if (t + 1 < NT) { asm volatile("s_waitcnt vmcnt(0)" ::: "memory"); } __syncthreads(); }
    }
    if (hi == 0) li_l[r32] = l_reg; asm volatile("s_waitcnt lgkmcnt(0)" ::: "memory");
    bf16_t* Ow = (MLA ? P.QN + (rowbase + qlo) * 2048 + hh * 128 : P.QS + (rowbase + qlo) * 2048 + hh * 64);
#pragma unroll
    for (int r = 0; r < 16; ++r) { const int orow = crow(r, hi); const float rl = __builtin_amdgcn_rcpf(li_l[orow]);
#pragma unroll
        for (int d0 = 0; d0 < NCB; ++d0) { const float v = o[d0][r] * rl; const float vn = __shfl_xor(v, 1);
            if ((r32 & 1) == 0) *(unsigned*)(Ow + (size_t)orow * 2048 + d0 * 32 + r32) = cvtpk(v, vn); } }
    __syncthreads();
#undef LOADT
#undef WRITET
#undef GLDS
}
#undef SBAR
}
typedef unsigned short bf16;
typedef unsigned v4u __attribute__((ext_vector_type(4)));
typedef float f32x4 __attribute__((ext_vector_type(4)));
constexpr size_t MiB = 1u << 20;
constexpr size_t WS_WIN = 1 * MiB, WS_WQ = 31 * MiB, WS_WKV = 34 * MiB, WS_WOA = 36 * MiB, WS_WOB = 44 * MiB, WS_WOUT = 52 * MiB, WS_WUP = 60 * MiB, WS_WDN = 104 * MiB;
constexpr size_t WS_ROPE = 126 * MiB;
constexpr size_t WS_SSQQ = 130 * MiB, WS_SSQKV = 131 * MiB, WS_SSQY = 132 * MiB, WS_SSQY2 = 136 * MiB;
constexpr size_t WS_XN = 140 * MiB;
constexpr size_t WS_CQ = 268 * MiB, WS_CKV = 300 * MiB, WS_KR = 316 * MiB, WS_KS = 320 * MiB, WS_VS = 336 * MiB, WS_QS = 352 * MiB;
constexpr size_t WS_QN = 480 * MiB, WS_QR = 608 * MiB, WS_KN = 672 * MiB, WS_V = 800 * MiB;
constexpr size_t WS_GT = 608 * MiB, WS_MG = 864 * MiB;
constexpr size_t WS_Y = 140 * MiB, WS_X1 = 768 * MiB, WS_H2 = 640 * MiB;
constexpr size_t WS_G = 140 * MiB, WS_AH = 492 * MiB, WS_BH = 536 * MiB;
constexpr size_t WS_Y2 = 640 * MiB, WS_END = 1024 * MiB;

struct Args {
    const float *x, *g_mix_pre, *g_mix_post, *g_ffn_pre, *g_ffn_post, *w_in, *q_norm, *w_q_up, *kv_norm, *w_kv_up, *sinks, *rel, *w_o_mla, *w_o_swa, *w_out, *w_up, *conv_w, *conv_b, *w_down;
    float* out; unsigned char* ws; int ph_lo, ph_hi;
};

__device__ __forceinline__ unsigned f2bf(float f) { unsigned u = __builtin_bit_cast(unsigned, f); return (u + 0x7fffu + ((u >> 16) & 1u)) >> 16; }
__device__ __forceinline__ unsigned pk2(float lo, float hi) { return f2bf(lo) | (f2bf(hi) << 16); }
__device__ __forceinline__ float wave_sum(float v) {
#pragma unroll
    for (int o = 1; o < 64; o <<= 1) v += __shfl_xor(v, o);
    return v;
}
__device__ __forceinline__ void tr_item(const float* W, int K, int Nsrc, int k0, int nsrc0, bf16* WT, int drow0, int dstride, const float* gain, LAS float* scr, int lane) {
#pragma unroll 8
    for (int i = 0; i < 32; ++i) { const int kk = 2 * i + (lane >> 5); float v = W[(size_t)(k0 + kk) * Nsrc + nsrc0 + (lane & 31)]; if (gain) v *= gain[k0 + kk]; scr[kk * 33 + (lane & 31)] = v; }
    asm volatile("s_waitcnt lgkmcnt(0)" ::: "memory");
    const int c = lane & 7;
#pragma unroll
    for (int j = 0; j < 4; ++j) { const int n = (lane >> 3) + 8 * j; const LAS float* s = scr + (8 * c) * 33 + n;
        v4u o; o.x = pk2(s[0 * 33], s[1 * 33]); o.y = pk2(s[2 * 33], s[3 * 33]); o.z = pk2(s[4 * 33], s[5 * 33]); o.w = pk2(s[6 * 33], s[7 * 33]);
        *(v4u*)(WT + (size_t)(drow0 + n * dstride) * K + k0 + 8 * c) = o; }
    asm volatile("s_waitcnt lgkmcnt(0)" ::: "memory");
}

__global__ void __launch_bounds__(512) fwd_mega(Args a) {
    extern __shared__ __attribute__((aligned(16))) unsigned char lds_raw[];
    LAS unsigned char* lds = (LAS unsigned char*)lds_raw;
    cg::grid_group grid = cg::this_grid();
    const int tid = threadIdx.x, lane = tid & 63, wave = __builtin_amdgcn_readfirstlane(tid >> 6);
    const int G = gridDim.x, bx = blockIdx.x;
    const int vcu = (G % 8 == 0) ? (bx % 8) * (G / 8) + bx / 8 : bx;
    unsigned char* ws = a.ws;
    bf16 *Win_t = (bf16*)(ws + WS_WIN), *Wq_t = (bf16*)(ws + WS_WQ), *Wkv_t = (bf16*)(ws + WS_WKV), *WoA_t = (bf16*)(ws + WS_WOA), *WoB_t = (bf16*)(ws + WS_WOB),
         *Wout_t = (bf16*)(ws + WS_WOUT), *Wup_t = (bf16*)(ws + WS_WUP), *Wdn_t = (bf16*)(ws + WS_WDN);
    float* rope = (float*)(ws + WS_ROPE);
    float *ssqQ = (float*)(ws + WS_SSQQ), *ssqKV = (float*)(ws + WS_SSQKV), *ssqY = (float*)(ws + WS_SSQY), *ssqY2 = (float*)(ws + WS_SSQY2);
    bf16 *XN = (bf16*)(ws + WS_XN), *CQ = (bf16*)(ws + WS_CQ), *CKV = (bf16*)(ws + WS_CKV), *KR = (bf16*)(ws + WS_KR), *KS = (bf16*)(ws + WS_KS), *VS = (bf16*)(ws + WS_VS), *QS = (bf16*)(ws + WS_QS);
    bf16 *QN = (bf16*)(ws + WS_QN), *QR = (bf16*)(ws + WS_QR), *KN = (bf16*)(ws + WS_KN), *VV = (bf16*)(ws + WS_V), *MG = (bf16*)(ws + WS_MG), *GG = (bf16*)(ws + WS_G);
    bf16 *GT = (bf16*)(ws + WS_GT), *Y = (bf16*)(ws + WS_Y), *Y2 = (bf16*)(ws + WS_Y2), *H2 = (bf16*)(ws + WS_H2);
    float *X1 = (float*)(ws + WS_X1), *AH = (float*)(ws + WS_AH), *BH = (float*)(ws + WS_BH);
    const int gw = vcu * 8 + wave, NGW = G * 8;
    const int lo = a.ph_lo, hi = a.ph_hi;
#ifndef PHMASK
#define PHMASK 0xFFFF
#endif
#define IN(k) (((PHMASK >> (k)) & 1) && lo <= (k) && (k) < hi)
#define SEAM(k) do { if (IN(k) && IN((k) + 1)) { asm volatile("s_waitcnt vmcnt(0) lgkmcnt(0)" ::: "memory"); __syncthreads(); \
        if (wave == 0) { __builtin_amdgcn_fence(__ATOMIC_RELEASE, "agent"); asm volatile("s_waitcnt vmcnt(0)" ::: "memory"); }     \
        grid.sync(); \
        if (wave == 0) { __builtin_amdgcn_fence(__ATOMIC_ACQUIRE, "agent"); asm volatile("s_waitcnt vmcnt(0)" ::: "memory"); }     \
        __syncthreads(); } } while (0)

    if (IN(0)) {
        LAS float* scr = (LAS float*)(lds + wave * 16384);
        constexpr int I_IN = 32 * 234, I_Q = 8 * 96, I_KV = 4 * 128, I_O = 32 * 64, I_UP = 32 * 352, I_DN = 88 * 64;
        constexpr int NITEMS = I_IN + I_Q + I_KV + 3 * I_O + I_UP + I_DN;
        for (int it = gw; it < NITEMS; it += NGW) {
            int r = it;
            if (r < I_IN) { const int kb = r / 234, c = (r % 234) * 32; int d0, ds = 1;
                if (c < 768) d0 = c; else if (c < 832) { d0 = 768 + (c - 768) / 32; ds = 2; } else d0 = c + 192;
                tr_item(a.w_in, 2048, 7488, kb * 64, c, Win_t, d0, ds, nullptr, scr, lane); continue; } r -= I_IN;
            if (r < I_Q) { const int kb = r / 96, c = (r % 96) * 32, h = c / 192, w = c % 192; int d0, ds = 1;
                if (w < 128) d0 = 128 * h + w; else { d0 = 2048 + 64 * h + (w - 128) / 32; ds = 2; }
                tr_item(a.w_q_up, 512, 3072, kb * 64, c, Wq_t, d0, ds, a.q_norm, scr, lane); continue; } r -= I_Q;
            if (r < I_KV) { const int kb = r / 128, c = (r % 128) * 32, h = c / 256, w = c % 256;
                const int d0 = w < 128 ? 128 * h + w : 2048 + 128 * h + (w - 128);
                tr_item(a.w_kv_up, 256, 4096, kb * 64, c, Wkv_t, d0, 1, a.kv_norm, scr, lane); continue; } r -= I_KV;
            if (r < 3 * I_O) { const int wsel = r / I_O, q = r % I_O, kb = q / 64, c = (q % 64) * 32;
                tr_item(wsel == 0 ? a.w_o_mla : wsel == 1 ? a.w_o_swa : a.w_out, 2048, 2048, kb * 64, c, wsel == 0 ? WoA_t : wsel == 1 ? WoB_t : Wout_t, c, 1, nullptr, scr, lane); continue; } r -= 3 * I_O;
            if (r < I_UP) { const int kb = r / 352, c = (r % 352) * 32; int d0;
                if (c < DFF) d0 = 256 * (c / 128) + (c % 128); else { const int c2 = c - DFF; d0 = 256 * (c2 / 128) + 128 + (c2 % 128); }
                tr_item(a.w_up, 2048, 11264, kb * 64, c, Wup_t, d0, 1, nullptr, scr, lane); continue; } r -= I_UP;
            { const int kb = r / 64, c = (r % 64) * 32; tr_item(a.w_down, DFF, 2048, kb * 64, c, Wdn_t, c, 1, nullptr, scr, lane); }
        }
        for (int i = bx * 512 + tid; i < 192 * 2048 / 8; i += G * 512) *(v4u*)(Win_t + (size_t)832 * 2048 + (size_t)i * 8) = (v4u){0u, 0u, 0u, 0u};
        for (int i = bx * 512 + tid; i < SEQ * 32; i += G * 512) { const int pos = i >> 5, k = i & 31;
            const float inv = __builtin_amdgcn_exp2f(-(float)(2 * k) * (13.287712379549449f / 64.0f)); const float ang = (float)pos * inv;
            const double rev = (double)ang * 0.15915494309189535; const float fr = (float)(rev - __builtin_rint(rev));
            rope[2 * i] = __builtin_amdgcn_cosf(fr); rope[2 * i + 1] = __builtin_amdgcn_sinf(fr); }
        for (int m = gw; m < NTOK; m += NGW) {
            const f32x4* xr = (const f32x4*)(a.x + (size_t)m * DM) + lane; f32x4 v[8]; float s = 0.f;
#pragma unroll
            for (int j = 0; j < 8; ++j) { v[j] = xr[64 * j]; s += (v[j].x * v[j].x + v[j].y * v[j].y) + (v[j].z * v[j].z + v[j].w * v[j].w); }
            const float rs = 1.0f / sqrtf(wave_sum(s) * (1.f / DM) + EPS);
            unsigned long long* o8 = (unsigned long long*)(XN + (size_t)m * DM) + lane;
#pragma unroll
            for (int j = 0; j < 8; ++j) { const f32x4 g = *((const f32x4*)a.g_mix_pre + lane + 64 * j);
                o8[64 * j] = (unsigned long long)pk2(v[j].x * rs * g.x, v[j].y * rs * g.y) | ((unsigned long long)pk2(v[j].z * rs * g.z, v[j].w * rs * g.w) << 32); }
        }
    }
    SEAM(0);
    if (IN(1)) {
        pg8::Gemm g{XN, Win_t, NTOK, 3584, 2048}; pg8::StaticOrder S; S.init(NTOK, 3584, G, bx);
        ep::EpiIn E{CQ, CKV, KR, QS, KS, VS, ssqQ, ssqKV, rope};
        pg8::gemm_phase<ep::EpiIn, pg8::StaticOrder, true, true>(lds, g, S, E);
    }
    SEAM(1);
    if (IN(2)) {
        { pg8::Gemm g{CQ, Wq_t, NTOK, 3072, 512}; pg8::StaticOrder S; S.init(NTOK, 3072, G, bx);
          ep::EpiUp E{ssqQ, 8, 1.0f / 512.0f, QN, QR, 2048, 1024, 8, 1, rope, 0.07216878364870322f * 1.4426950408889634f};
          pg8::gemm_phase<ep::EpiUp, pg8::StaticOrder, true, true>(lds, g, S, E); }
        { pg8::Gemm g{CKV, Wkv_t, NTOK, 4096, 256}; pg8::StaticOrder S; S.init(NTOK, 4096, G, bx);
          ep::EpiUp E{ssqKV, 4, 1.0f / 256.0f, KN, VV, 2048, 2048, 8, 0, rope, 1.0f};
          pg8::gemm_phase<ep::EpiUp, pg8::StaticOrder, true, true>(lds, g, S, E); }
    }
    SEAM(2);
    if (IN(3)) {
        att::AttnP P{QN, QR, KN, KR, VV, QS, KS, VS, a.sinks, a.rel};
#ifndef NO_MLA
        for (int it = vcu; it < 1024; it += G) { const int bh = it >> 5, s = it & 31;
            att::attn_unit<true>(P, bh >> 4, bh & 15, 63 - s, (LAS char*)lds);
            att::attn_unit<true>(P, bh >> 4, bh & 15, s, (LAS char*)lds); }
#endif
#ifndef NO_SWA
        for (int it = vcu; it < 4096; it += G) { const int qb = it & 63, hq = (it >> 6) & 31, b = it >> 11;
            att::attn_unit<false>(P, b, hq, qb, (LAS char*)lds); }
#endif
    }
    SEAM(3);
    if (IN(4)) {
        pg8::Gemm g{XN, Win_t + (size_t)3584 * 2048, NTOK, 4096, 2048}; pg8::StaticOrder S; S.init(NTOK, 4096, G, bx);
        ep::EpiSig E{GT}; pg8::gemm_phase<ep::EpiSig, pg8::StaticOrder, true, true>(lds, g, S, E);
    }
    SEAM(4);
    if (IN(5)) {
        { pg8::Gemm g{QN, WoA_t, NTOK, 2048, 2048}; pg8::StaticOrder S; S.init(NTOK, 2048, G, bx);
          ep::EpiGate<false> E{GT, MG}; pg8::gemm_phase<ep::EpiGate<false>, pg8::StaticOrder, true, true>(lds, g, S, E); }
        { pg8::Gemm g{QS, WoB_t, NTOK, 2048, 2048}; pg8::StaticOrder S; S.init(NTOK, 2048, G, bx);
          ep::EpiGate<true> E{GT, MG}; pg8::gemm_phase<ep::EpiGate<true>, pg8::StaticOrder, true, true>(lds, g, S, E); }
    }
    SEAM(5);
    if (IN(6)) {
        pg8::Gemm g{MG, Wout_t, NTOK, 2048, 2048}; pg8::StaticOrder S; S.init(NTOK, 2048, G, bx);
        ep::EpiBfSsq E{Y, ssqY}; pg8::gemm_phase<ep::EpiBfSsq, pg8::StaticOrder, true, true>(lds, g, S, E);
    }
    SEAM(6);
    if (IN(7)) {
        for (int m = gw; m < NTOK; m += NGW) {
            float sy = ssqY[(size_t)m * 32 + (lane & 31)];
#pragma unroll
            for (int o = 1; o < 32; o <<= 1) sy += __shfl_xor(sy, o);
            const float rsy = 1.0f / sqrtf(sy * (1.f / DM) + EPS);
            const f32x4* xr = (const f32x4*)(a.x + (size_t)m * DM) + lane; const unsigned long long* yr = (const unsigned long long*)(Y + (size_t)m * DM) + lane;
            f32x4* outr = (f32x4*)(X1 + (size_t)m * DM) + lane; f32x4 v[8]; float s = 0.f;
#pragma unroll
            for (int j = 0; j < 8; ++j) { const f32x4 g = *((const f32x4*)a.g_mix_post + lane + 64 * j); const unsigned long long yw = yr[64 * j];
                const f32x4 yv = {__uint_as_float((unsigned)yw << 16), __uint_as_float((unsigned)yw & 0xffff0000u), __uint_as_float((unsigned)(yw >> 32) << 16), __uint_as_float((unsigned)(yw >> 32) & 0xffff0000u)};
                v[j] = xr[64 * j] + yv * rsy * g; outr[64 * j] = v[j];
                s += (v[j].x * v[j].x + v[j].y * v[j].y) + (v[j].z * v[j].z + v[j].w * v[j].w); }
            const float rs = 1.0f / sqrtf(wave_sum(s) * (1.f / DM) + EPS);
            unsigned long long* o8 = (unsigned long long*)(H2 + (size_t)m * DM) + lane;
#pragma unroll
            for (int j = 0; j < 8; ++j) { const f32x4 g = *((const f32x4*)a.g_ffn_pre + lane + 64 * j);
                o8[64 * j] = (unsigned long long)pk2(v[j].x * rs * g.x, v[j].y * rs * g.y) | ((unsigned long long)pk2(v[j].z * rs * g.z, v[j].w * rs * g.w) << 32); }
        }
    }
    SEAM(7);
    if (IN(8)) {
        pg8::Gemm g{H2, Wup_t, NTOK, 11264, 2048}; pg8::StaticOrder S; S.init(NTOK, 11264, G, bx);
        ep::EpiFfn E{GG, AH, BH, a.conv_w, a.conv_b}; pg8::gemm_phase<ep::EpiFfn, pg8::StaticOrder, true, true>(lds, g, S, E);
    }
    SEAM(8);
    if (IN(9)) {
        constexpr int NF4 = DFF / 4;
        for (int i = bx * 512 + tid; i < 1024 * NF4; i += G * 512) { const int f = (i % NF4) * 4, rj = i / NF4, jb = rj >> 1, ii = rj & 1; const bool first = (jb & 255) == 0;
            const f32x4 z = {0.f, 0.f, 0.f, 0.f};
            const f32x4 a0 = *(const f32x4*)(AH + ((size_t)jb * 4 + 2 + ii) * DFF + f);
            const f32x4 pm1 = first ? z : *(const f32x4*)(AH + ((size_t)(jb - 1) * 4 + 1) * DFF + f);
            const f32x4 pm2 = first ? z : *(const f32x4*)(AH + ((size_t)(jb - 1) * 4 + 0) * DFF + f);
            const f32x4 a1 = ii ? *(const f32x4*)(AH + ((size_t)jb * 4 + 2) * DFF + f) : pm1;
            const f32x4 a2 = ii ? pm1 : pm2;
            const f32x4 bv = *(const f32x4*)(BH + ((size_t)jb * 2 + ii) * DFF + f);
            const f32x4 c = *(const f32x4*)(a.conv_b + f) + *(const f32x4*)(a.conv_w + f) * a2 + *(const f32x4*)(a.conv_w + DFF + f) * a1 + *(const f32x4*)(a.conv_w + 2 * DFF + f) * a0;
            float o[4];
#pragma unroll
            for (int e = 0; e < 4; ++e) { const float x = c[e]; const float uu = 0.7978845608028654f * (x + 0.044715f * x * x * x);
                o[e] = x * __builtin_amdgcn_rcpf(1.f + __builtin_amdgcn_exp2f(-2.885390081777927f * uu)) * bv[e]; }
            *(unsigned long long*)(GG + ((size_t)jb * 64 + ii) * DFF + f) = (unsigned long long)pk2(o[0], o[1]) | ((unsigned long long)pk2(o[2], o[3]) << 32); }
    }
    SEAM(9);
    if (IN(10)) {
        pg8::Gemm g{GG, Wdn_t, NTOK, 2048, DFF}; pg8::StaticOrder S; S.init(NTOK, 2048, G, bx);
        ep::EpiBfSsq E{Y2, ssqY2}; pg8::gemm_phase<ep::EpiBfSsq, pg8::StaticOrder, true, true>(lds, g, S, E);
    }
    SEAM(10);
    if (IN(11)) {
        for (int m = gw; m < NTOK; m += NGW) {
            float sy = ssqY2[(size_t)m * 32 + (lane & 31)];
#pragma unroll
            for (int o = 1; o < 32; o <<= 1) sy += __shfl_xor(sy, o);
            const float rsy = 1.0f / sqrtf(sy * (1.f / DM) + EPS);
            const unsigned long long* yr = (const unsigned long long*)(Y2 + (size_t)m * DM) + lane; const f32x4* x1r = (const f32x4*)(X1 + (size_t)m * DM) + lane; f32x4* outr = (f32x4*)(a.out + (size_t)m * DM) + lane;
#pragma unroll
            for (int j = 0; j < 8; ++j) { const f32x4 g = *((const f32x4*)a.g_ffn_post + lane + 64 * j); const unsigned long long yw = yr[64 * j];
                const f32x4 yv = {__uint_as_float((unsigned)yw << 16), __uint_as_float((unsigned)yw & 0xffff0000u), __uint_as_float((unsigned)(yw >> 32) << 16), __uint_as_float((unsigned)(yw >> 32) & 0xffff0000u)};
                outr[64 * j] = x1r[64 * j] + yv * rsy * g; }
        }
    }
#undef IN
#undef SEAM
}

constexpr int LDS_BYTES = 147456;
extern "C" void kernel_launch(void* const* d_in, const int* in_sizes, int n_in, void* d_out, int out_size, void* d_ws, size_t ws_size, hipStream_t stream) {
    static int grid = 0;
    if (grid == 0) {
        if (n_in != 19 || in_sizes[0] != NTOK * DM || out_size != NTOK * DM || ws_size < WS_END) { fprintf(stderr, "kernel_launch: unexpected shapes (n_in %d, in0 %d, out %d, ws %zu)\n", n_in, n_in > 0 ? in_sizes[0] : -1, out_size, ws_size); grid = -1; return; }
        int dev = 0, cus = 0, per_cu = 0;
        hipGetDevice(&dev); hipDeviceGetAttribute(&cus, hipDeviceAttributeMultiprocessorCount, dev);
        if (hipFuncSetAttribute((const void*)fwd_mega, hipFuncAttributeMaxDynamicSharedMemorySize, LDS_BYTES) != hipSuccess) { fprintf(stderr, "kernel_launch: hipFuncSetAttribute failed\n"); grid = -1; return; }
        if (hipOccupancyMaxActiveBlocksPerMultiprocessor(&per_cu, (const void*)fwd_mega, 512, LDS_BYTES) != hipSuccess || per_cu < 1) { fprintf(stderr, "kernel_launch: occupancy query says %d\n", per_cu); per_cu = 1; }
        (void)hipGetLastError();
        grid = cus * 1;
        if (grid % 8 != 0 || grid <= 0) { fprintf(stderr, "kernel_launch: odd CU count %d\n", cus); }
    }
    if (grid < 0) return;
    Args a{};
    a.x = (const float*)d_in[0]; a.g_mix_pre = (const float*)d_in[1]; a.g_mix_post = (const float*)d_in[2]; a.g_ffn_pre = (const float*)d_in[3]; a.g_ffn_post = (const float*)d_in[4];
    a.w_in = (const float*)d_in[5]; a.q_norm = (const float*)d_in[6]; a.w_q_up = (const float*)d_in[7]; a.kv_norm = (const float*)d_in[8]; a.w_kv_up = (const float*)d_in[9];
    a.sinks = (const float*)d_in[10]; a.rel = (const float*)d_in[11]; a.w_o_mla = (const float*)d_in[12]; a.w_o_swa = (const float*)d_in[13]; a.w_out = (const float*)d_in[14];
    a.w_up = (const float*)d_in[15]; a.conv_w = (const float*)d_in[16]; a.conv_b = (const float*)d_in[17]; a.w_down = (const float*)d_in[18];
    a.out = (float*)d_out; a.ws = (unsigned char*)d_ws;
#ifndef NLAUNCH_SPLIT
#define NLAUNCH_SPLIT 0
#endif
    for (int ph = 0; ph < 12; ph += (NLAUNCH_SPLIT ? 1 : 12)) {
        a.ph_lo = ph; a.ph_hi = NLAUNCH_SPLIT ? ph + 1 : 12;
        void* args[] = {&a};
        hipError_t e = hipLaunchCooperativeKernel((const void*)fwd_mega, dim3(grid), dim3(512), args, LDS_BYTES, stream);
        if (e != hipSuccess) fprintf(stderr, "kernel_launch: cooperative launch failed: %s (grid %d)\n", hipGetErrorString(e), grid);
    }
}
```
